# Optimizing an MI355X kernel written in HIP

```python
import math
import jax, jax.numpy as jnp
from jax import lax
import numpy as np

D_MODEL = 1024
BATCH = 8
SEQ = 4096
DEPTH = 4

A_HEADS = 8
A_KV_HEADS = 2
A_HEAD_DIM = 64
A_GROUP = A_HEADS // A_KV_HEADS
WINDOW = 128
BLOCK = 128
NUM_BUCKETS = 32
MAX_DISTANCE = 128
R_HEADS = 4
R_QK_DIM = 128
R_V_DIM = 256
CHUNK = 128
ROPE_BASE = 10000.0
D_FF = 2816
CONV_WIDTH = 3
EPS = 1e-6
NEG_INF = -1e30

A_Q = A_HEADS * A_HEAD_DIM
A_KV = A_KV_HEADS * A_HEAD_DIM
R_QK = R_HEADS * R_QK_DIM
R_V = R_HEADS * R_V_DIM
IN_SIZES = (A_Q, A_KV, A_KV, R_QK, R_QK, R_V, R_V, D_MODEL, D_MODEL)
D_IN = sum(IN_SIZES)

kernel_name = "hybrid_swa_sink_retention_convffn_trunk"


def rmsnorm(x, g):
    xf = x.astype(jnp.float32)
    y = xf * lax.rsqrt(jnp.mean(xf * xf, axis=-1, keepdims=True) + EPS)
    return (y * g.astype(jnp.float32)).astype(x.dtype)


def t5_band_buckets():
    i = np.arange(BLOCK)[:, None]
    j = np.arange(2 * BLOCK)[None, :]
    dist = BLOCK + i - j
    n = np.maximum(dist, 0)
    max_exact = NUM_BUCKETS // 2
    large = max_exact + (np.log(np.maximum(n, 1) / max_exact) / math.log(MAX_DISTANCE / max_exact)
                         * (NUM_BUCKETS - max_exact)).astype(np.int32)
    large = np.minimum(large, NUM_BUCKETS - 1)
    bucket = np.where(n < max_exact, n, large).astype(np.int32)
    valid = (dist >= 0) & (dist < WINDOW)
    return bucket, valid


def sliding_window_attention(q, k, v, sinks, rel_table):
    b, s, _ = q.shape
    nb = s // BLOCK
    qb = q.reshape(b, nb, BLOCK, A_KV_HEADS, A_GROUP, A_HEAD_DIM)
    kb = k.reshape(b, nb, BLOCK, A_KV_HEADS, A_HEAD_DIM)
    vb = v.reshape(b, nb, BLOCK, A_KV_HEADS, A_HEAD_DIM)
    pad = ((0, 0), (1, 0), (0, 0), (0, 0), (0, 0))
    k_band = jnp.concatenate([jnp.pad(kb[:, :-1], pad), kb], axis=2)
    v_band = jnp.concatenate([jnp.pad(vb[:, :-1], pad), vb], axis=2)
    scores = jnp.einsum('bnqkgd,bnskd->bkgnqs', qb, k_band).astype(jnp.float32) * (A_HEAD_DIM ** -0.5)
    bucket, valid = t5_band_buckets()
    bias = rel_table.astype(jnp.float32)[jnp.asarray(bucket)]
    bias = jnp.transpose(bias, (2, 0, 1)).reshape(A_KV_HEADS, A_GROUP, BLOCK, 2 * BLOCK)
    block_idx = jnp.arange(nb)[:, None, None]
    key_in_cur = (jnp.arange(2 * BLOCK) >= BLOCK)[None, None, :]
    mask = jnp.asarray(valid)[None] & ((block_idx > 0) | key_in_cur)
    scores = jnp.where(mask[None, None, None], scores + bias[None, :, :, None], NEG_INF)
    sink = sinks.astype(jnp.float32).reshape(A_KV_HEADS, A_GROUP)[None, :, :, None, None, None]
    m = jnp.maximum(jnp.max(scores, axis=-1, keepdims=True), sink)
    p = jnp.exp(scores - m)
    probs = p / (jnp.sum(p, axis=-1, keepdims=True) + jnp.exp(sink - m))
    out = jnp.einsum('bkgnqs,bnskd->bnqkgd', probs.astype(v.dtype), v_band)
    return out.reshape(b, s, A_Q)


def rotate(x, pos):
    half = x.shape[-1] // 2
    freqs = ROPE_BASE ** (-jnp.arange(half, dtype=jnp.float32) / half)
    ang = pos.astype(jnp.float32)[:, None] * freqs[None, :]
    cos = jnp.cos(ang)[None, :, None, :]
    sin = jnp.sin(ang)[None, :, None, :]
    x1, x2 = x[..., :half], x[..., half:]
    return jnp.concatenate([x1 * cos - x2 * sin, x1 * sin + x2 * cos], axis=-1).astype(x.dtype)


def retention(q, k, v, g, norm_gain):
    b, s, _ = q.shape
    nc = s // CHUNK
    pos = jnp.arange(s)
    q = rotate(q.reshape(b, s, R_HEADS, R_QK_DIM), pos)
    k = rotate(k.reshape(b, s, R_HEADS, R_QK_DIM), pos) * (R_QK_DIM ** -0.5)
    vh = v.reshape(b, s, R_HEADS, R_V_DIM)
    to_chunks = lambda t: jnp.transpose(t.reshape(b, nc, CHUNK, R_HEADS, t.shape[-1]), (0, 3, 1, 2, 4))
    qc, kc, vc = to_chunks(q), to_chunks(k), to_chunks(vh)
    log_gamma = jnp.log(1.0 - 2.0 ** (-5.0 - jnp.arange(R_HEADS, dtype=jnp.float32)))
    idx = jnp.arange(CHUNK, dtype=jnp.float32)
    rel = idx[:, None] - idx[None, :]
    decay_intra = jnp.where(rel >= 0, jnp.exp(log_gamma[:, None, None] * jnp.maximum(rel, 0.0)), 0.0)
    qk = jnp.einsum('bhncd,bhnsd->bhncs', qc, kc) * decay_intra[None, :, None]
    y_intra = jnp.einsum('bhncs,bhnse->bhnce', qk, vc)
    zeta = jnp.exp(log_gamma[:, None] * (CHUNK - 1 - idx)[None, :])
    kv_chunks = jnp.einsum('bhncd,bhnce->nbhde', kc * zeta[None, :, None, :, None], vc)
    gamma_c = jnp.exp(log_gamma * CHUNK)[None, :, None, None]

    def step(state, kv):
        return gamma_c * state + kv, state

    init = jnp.zeros(kv_chunks.shape[1:], kv_chunks.dtype)
    _, state_prev = lax.scan(step, init, kv_chunks)
    xi = jnp.exp(log_gamma[:, None] * (idx + 1.0)[None, :])
    y_cross = jnp.einsum('bhncd,nbhde->bhnce', qc, state_prev) * xi[None, :, None, :, None]
    y = jnp.transpose(y_intra + y_cross, (0, 2, 3, 1, 4)).reshape(b, s, R_HEADS, R_V_DIM)
    yf = y.astype(jnp.float32)
    mu = jnp.mean(yf, axis=-1, keepdims=True)
    var = jnp.mean((yf - mu) ** 2, axis=-1, keepdims=True)
    yn = ((yf - mu) * lax.rsqrt(var + EPS)).reshape(b, s, R_V) * norm_gain.astype(jnp.float32)
    return (jax.nn.silu(g.astype(jnp.float32)) * yn).astype(v.dtype)


def conv_ffn(h, w_up, conv_w, conv_b, w_down):
    s = h.shape[1]
    u = h @ w_up
    a, val = u[..., :D_FF], u[..., D_FF:]
    a_pad = jnp.pad(a, ((0, 0), (CONV_WIDTH - 1, 0), (0, 0)))
    a_conv = conv_b + sum(conv_w[t] * a_pad[:, t:t + s] for t in range(CONV_WIDTH))
    return (jax.nn.gelu(a_conv) * val) @ w_down


def setup_inputs(seed: int = 0) -> dict:
    key = jax.random.key(seed)
    ks = jax.random.split(key, 20)
    nrm = lambda k, shape, scale: jax.random.normal(k, shape, jnp.float32) * scale
    gain = lambda k, shape: 1.0 + 0.05 * jax.random.normal(k, shape, jnp.float32)
    return {
        "x": nrm(ks[0], (BATCH, SEQ, D_MODEL), 1.0),
        "norm_pre_mix": gain(ks[1], (DEPTH, D_MODEL)),
        "w_in": nrm(ks[2], (DEPTH, D_MODEL, D_IN), D_MODEL ** -0.5),
        "sinks": nrm(ks[3], (DEPTH, A_HEADS), 0.5),
        "rel_bias": nrm(ks[4], (NUM_BUCKETS, A_HEADS), 0.5),
        "ret_norm": gain(ks[5], (DEPTH, R_V)),
        "w_out_a": nrm(ks[6], (DEPTH, A_Q, D_MODEL), A_Q ** -0.5),
        "w_out_r": nrm(ks[7], (DEPTH, R_V, D_MODEL), R_V ** -0.5),
        "w_out": nrm(ks[8], (DEPTH, D_MODEL, D_MODEL), D_MODEL ** -0.5),
        "norm_post_mix": gain(ks[9], (DEPTH, D_MODEL)),
        "norm_pre_ffn": gain(ks[10], (DEPTH, D_MODEL)),
        "w_up": nrm(ks[11], (DEPTH, D_MODEL, 2 * D_FF), D_MODEL ** -0.5),
        "conv_w": nrm(ks[12], (DEPTH, CONV_WIDTH, D_FF), CONV_WIDTH ** -0.5),
        "conv_b": nrm(ks[13], (DEPTH, D_FF), 0.02),
        "w_down": nrm(ks[14], (DEPTH, D_FF, D_MODEL), D_FF ** -0.5),
        "norm_post_ffn": gain(ks[15], (DEPTH, D_MODEL)),
    }


def reference(x, norm_pre_mix, w_in, sinks, rel_bias, ret_norm, w_out_a, w_out_r, w_out,
              norm_post_mix, norm_pre_ffn, w_up, conv_w, conv_b, w_down, norm_post_ffn):
    split_points = list(np.cumsum(IN_SIZES)[:-1])
    for l in range(DEPTH):
        h = rmsnorm(x, norm_pre_mix[l])
        proj = h @ w_in[l]
        qa, ka, va, qr, kr, vr, gr, gate_a, gate_r = jnp.split(proj, split_points, axis=-1)
        y_a = sliding_window_attention(qa, ka, va, sinks[l], rel_bias) @ w_out_a[l]
        y_r = retention(qr, kr, vr, gr, ret_norm[l]) @ w_out_r[l]
        merged = jax.nn.sigmoid(gate_a) * y_a + jax.nn.sigmoid(gate_r) * y_r
        x = x + rmsnorm(merged @ w_out[l], norm_post_mix[l])
        h = rmsnorm(x, norm_pre_ffn[l])
        x = x + rmsnorm(conv_ffn(h, w_up[l], conv_w[l], conv_b[l], w_down[l]), norm_post_ffn[l])
    return x
```

```cpp
#include <hip/hip_runtime.h>
#include <cstdio>
#include <cstdint>
#include <cmath>
#define MK_ONE_LAUNCH 0
namespace pg8 {
#define PG8_LAS __attribute__((address_space(3)))
typedef unsigned short bf16_t;
typedef short bf16x8 __attribute__((ext_vector_type(8)));
typedef float f32x4 __attribute__((ext_vector_type(4)));
typedef unsigned u32x4 __attribute__((ext_vector_type(4)));
constexpr int BM = 256, BK = 64, HALF = 128, HTB = HALF * BK * 2  , STAGE_BYTES = 8 * HTB, NXCD = 8, WGM = 8;

__host__ __device__ __forceinline__ int lds_byte(int r, int c) { const int st = (r >> 4) * 2 + (c >> 5), rr = r & 15, cc = c & 31, ob = rr * 64 + cc * 2; return st * 1024 + (ob ^ (((ob >> 9) & 1) << 5)); }
__host__ __device__ __forceinline__ void stage_rc(int b, int& R, int& C) { const int st = b / 1024, sb = b % 1024, swz = sb ^ (((sb >> 9) & 1) << 5); R = (st >> 1) * 16 + swz / 64; C = (st & 1) * 32 + (swz % 64) / 2; }
__host__ __device__ __forceinline__ int perm32(int rho) { const int n = rho >> 4, i = rho & 15; return 8 * (i >> 2) + 4 * n + (i & 3); }

struct Unit { int pm, pn; };
struct Gemm { const bf16_t* A; const bf16_t* Bt; int M, N, K; };

struct StaticOrder {
    int nM, nN, nwg, G, c;
    __host__ __device__ void init(int M, int N, int G_, int c_) { nM = M / BM; nN = N / BM; nwg = nM * nN; G = G_; c = c_; }
    __host__ __device__ bool next(int i, Unit& u) const {
        const long L = (long)i * G + c; if (L >= nwg) return false;
        int wgid = (int)L; { const int q = nwg / NXCD, r = nwg % NXCD, xcd = wgid % NXCD, off = wgid / NXCD; wgid = (xcd < r ? xcd * (q + 1) : r * (q + 1) + (xcd - r) * q) + off; }
        const int nig = WGM * nN, gid = wgid / nig, fm = gid * WGM, gsz = (nM - fm) < WGM ? (nM - fm) : WGM;
        u.pm = fm + ((wgid % nig) % gsz); u.pn = (wgid % nig) / gsz; return true;
    }
    __device__ __forceinline__ void a_ready(const Unit&) const {}
    __device__ __forceinline__ void done(const Unit&) const {}
};

__device__ __forceinline__ unsigned cvt_pk_bf16(float lo, float hi) { unsigned r; asm volatile("v_cvt_pk_bf16_f32 %0, %1, %2" : "=v"(r) : "v"(lo), "v"(hi)); return r; }
typedef float f32x2 __attribute__((ext_vector_type(2)));
__device__ __forceinline__ f32x2 gelu_pk(f32x2 v) {
    const f32x2 av = __builtin_elementwise_abs(v), d = av * 0.2316418882f + 1.0f;
    f32x2 t; t.x = __builtin_amdgcn_rcpf(d.x); t.y = __builtin_amdgcn_rcpf(d.y);
    f32x2 q = t * 0.5307027145f + (-0.7265760135f); q = q * t + 0.7107068705f; q = q * t + (-0.142248368f); q = q * t + 0.127414796f; q = q * t;
    const f32x2 s = (v * v) * (-0.72134752044f);
    f32x2 e; e.x = __builtin_amdgcn_exp2f(s.x); e.y = __builtin_amdgcn_exp2f(s.y);
    const f32x2 m = v * (q * e), r = v - m;
    f32x2 o; o.x = v.x < 0.f ? m.x : r.x; o.y = v.y < 0.f ? m.y : r.y; return o;
}

template <int ACT  > struct EpiBf16 {
    static constexpr bool PERM = true, AFTER_DRAIN = false; static_assert(ACT == 0 || ACT == 1, "EpiBf16: ACT is 0 (none) or 1 (gelu_pk)");
    bf16_t* O; int ldc; const float* bias; int split_cols; size_t split_stride; float scale0;
    __device__ __forceinline__ void operator()(const f32x4 (&acc)[2][2][4][2], const Unit& u, int wr, int wc, int fr, int fq) const {
        const int row0 = u.pm * BM + wr * 64 + fr; int colt = u.pn * BM; bf16_t* base = O;
        float sc = 1.f; if (split_cols) { const int t = colt / split_cols; base += (size_t)t * split_stride; colt -= t * split_cols; if (t == 0) sc = scale0; }
        const int col0 = colt + wc * 32 + 8 * fq, bcol0 = u.pn * BM + wc * 32 + 8 * fq;
        f32x4 bv[2][2];
#pragma unroll
        for (int bj = 0; bj < 2; ++bj)
#pragma unroll
            for (int n = 0; n < 2; ++n) bv[bj][n] = bias ? *(const f32x4*)(bias + bcol0 + bj * HALF + 4 * n) : (f32x4){0.f, 0.f, 0.f, 0.f};
#pragma unroll
        for (int ai = 0; ai < 2; ++ai)
#pragma unroll
            for (int m = 0; m < 4; ++m) { bf16_t* rowp = base + (size_t)(row0 + ai * HALF + m * 16) * ldc + col0;
#pragma unroll
                for (int bj = 0; bj < 2; ++bj) { f32x4 v0 = acc[ai][bj][m][0] + bv[bj][0], v1 = acc[ai][bj][m][1] + bv[bj][1];
                    if (ACT == 1) { f32x2 a = gelu_pk((f32x2){v0[0], v0[1]}), b = gelu_pk((f32x2){v0[2], v0[3]}), c = gelu_pk((f32x2){v1[0], v1[1]}), d = gelu_pk((f32x2){v1[2], v1[3]});
                        v0 = (f32x4){a.x, a.y, b.x, b.y}; v1 = (f32x4){c.x, c.y, d.x, d.y}; }
                    v0 = v0 * sc; v1 = v1 * sc; u32x4 w; w.x = cvt_pk_bf16(v0[0], v0[1]); w.y = cvt_pk_bf16(v0[2], v0[3]); w.z = cvt_pk_bf16(v1[0], v1[1]); w.w = cvt_pk_bf16(v1[2], v1[3]);
                    *(u32x4*)(rowp + bj * HALF) = w; } }
    }
};

template <class Epi, class Sched, bool ALIGN_EPI = false, bool SP2 = false>
__device__ __forceinline__ void gemm_phase(PG8_LAS unsigned char* lds, const Gemm g, const Sched& S, const Epi& E) {
    int tid_o = threadIdx.x; asm volatile("" : "+v"(tid_o));
    const int tid = tid_o, wid = __builtin_amdgcn_readfirstlane(tid >> 6), lane = tid & 63, wr = wid >> 2, wc = wid & 3, fr = lane & 15, fq = lane >> 4;
    const int K = g.K, nt = K / BK;
    unsigned voffA[2], voffB[2];
#pragma unroll
    for (int i = 0; i < 2; ++i) { int R, C; stage_rc(tid * 16 + i * 8192, R, C); const int Rb = Epi::PERM ? ((R & ~31) + perm32(R & 31)) : R;
        voffA[i] = (unsigned)(R * K + C) * 2u; voffB[i] = (unsigned)(Rb * K + C) * 2u; }
    const size_t kstep = (size_t)(BK * 2);
    const size_t hstep = (size_t)HALF * K * 2;
    const size_t tstep = 2 * hstep;
    const unsigned ldsw = (unsigned)wid * 1024u;
    const int aoff = lds_byte(wr * 64 + fr, fq * 8), boff = lds_byte(wc * 32 + fr, fq * 8);
#define PG8_SA(b, h) (((b) * 2 + (h)) * HTB)
#define PG8_SB(b, h) ((4 + (b) * 2 + (h)) * HTB)
#define PG8_STAGE(bufoff, gbase, voff) do { _Pragma("unroll") for (int _i = 0; _i < 2; ++_i) \
        __builtin_amdgcn_global_load_lds((const unsigned*)((const char*)(gbase) + (voff)[_i]), (PG8_LAS unsigned*)(lds + (bufoff) + ldsw + _i * 8192), 16, 0, 0); } while (0)
#define PG8_LDA(dst, b, h) do { _Pragma("unroll") for (int m = 0; m < 4; ++m) _Pragma("unroll") for (int k = 0; k < 2; ++k) dst[m][k] = *(const PG8_LAS bf16x8*)(lds + PG8_SA(b, h) + aoff + m * 2048 + k * 1024); } while (0)
#define PG8_LDB(dst, b, h) do { _Pragma("unroll") for (int n = 0; n < 2; ++n) _Pragma("unroll") for (int k = 0; k < 2; ++k) dst[n][k] = *(const PG8_LAS bf16x8*)(lds + PG8_SB(b, h) + boff + n * 2048 + k * 1024); } while (0)
#define PG8_MMA(ai, bj, At, Bt) do { __builtin_amdgcn_s_setprio(1); _Pragma("unroll") for (int m = 0; m < 4; ++m) _Pragma("unroll") for (int n = 0; n < 2; ++n) _Pragma("unroll") for (int k = 0; k < 2; ++k) \
        acc[ai][bj][m][n] = __builtin_amdgcn_mfma_f32_16x16x32_bf16(Bt[n][k], At[m][k], acc[ai][bj][m][n], 0, 0, 0); __builtin_amdgcn_s_setprio(0); } while (0)
#define PG8_WAIT_V(n) asm volatile("s_waitcnt vmcnt(" #n ")" ::: "memory")
#define PG8_WAIT_L(n) asm volatile("s_waitcnt lgkmcnt(" #n ")" ::: "memory")
#define PG8_BAR __builtin_amdgcn_s_barrier()
#define PG8_SCHED __builtin_amdgcn_sched_barrier(0)
    Unit cur, nxt; int ui = 0;
    if (!S.next(0, cur)) return;
    f32x4 acc[2][2][4][2];
#pragma unroll
    for (int a = 0; a < 2; ++a)
#pragma unroll
        for (int b = 0; b < 2; ++b)
#pragma unroll
            for (int m = 0; m < 4; ++m)
#pragma unroll
                for (int n = 0; n < 2; ++n) acc[a][b][m][n] = (f32x4){0.f, 0.f, 0.f, 0.f};
    bf16x8 At[4][2], B0[2][2], B1[2][2];
    const char* cA = (const char*)g.A + (size_t)cur.pm * tstep; const char* cB = (const char*)g.Bt + (size_t)cur.pn * tstep;
    S.a_ready(cur);
    if constexpr (SP2) {
        PG8_STAGE(PG8_SB(0, 0), cB, voffB); PG8_STAGE(PG8_SB(0, 1), cB + hstep, voffB); PG8_STAGE(PG8_SA(0, 0), cA, voffA); PG8_STAGE(PG8_SA(0, 1), cA + hstep, voffA);
        if (wr == 1) PG8_BAR;
        PG8_WAIT_V(2); PG8_BAR;
        PG8_STAGE(PG8_SB(1, 0), cB + kstep, voffB); PG8_STAGE(PG8_SA(1, 0), cA + kstep, voffA); PG8_STAGE(PG8_SB(1, 1), cB + hstep + kstep, voffB);
        PG8_WAIT_V(6); PG8_BAR;
    } else {
        PG8_STAGE(PG8_SB(0, 0), cB, voffB); PG8_STAGE(PG8_SA(0, 0), cA, voffA); PG8_STAGE(PG8_SB(0, 1), cB + hstep, voffB); PG8_STAGE(PG8_SA(0, 1), cA + hstep, voffA);
        if (wr == 1) PG8_BAR;
        PG8_WAIT_V(4); PG8_BAR;
        PG8_STAGE(PG8_SB(1, 0), cB + kstep, voffB); PG8_STAGE(PG8_SA(1, 0), cA + kstep, voffA); PG8_STAGE(PG8_SB(1, 1), cB + hstep + kstep, voffB);
        PG8_WAIT_V(6); PG8_BAR;
    }
    for (;;) {
        const bool has_next = S.next(ui + 1, nxt);
        const char* nA = has_next ? (const char*)g.A + (size_t)nxt.pm * tstep : cA; const char* nB = has_next ? (const char*)g.Bt + (size_t)nxt.pn * tstep : cB;
        for (int t = 0; t < nt; t += 2) {
            const bool last = (t == nt - 2);
            const char* a1 = cA + (size_t)(t + 1) * kstep;
            const char* a2 = last ? nA : cA + (size_t)(t + 2) * kstep; const char* b2 = last ? nB : cB + (size_t)(t + 2) * kstep;
            const char* a3 = a2 + kstep; const char* b3 = b2 + kstep;
            if (last && has_next) S.a_ready(nxt);
            if constexpr (SP2) {
            PG8_LDB(B0, 0, 0); PG8_LDB(B1, 0, 1); PG8_SCHED; PG8_LDA(At, 0, 0); PG8_STAGE(PG8_SA(1, 1), a1 + hstep, voffA);
            PG8_WAIT_V(8); PG8_WAIT_L(0); PG8_BAR; PG8_MMA(0, 0, At, B0); PG8_MMA(0, 1, At, B1); PG8_BAR; PG8_SCHED;
            PG8_LDA(At, 0, 1); PG8_STAGE(PG8_SB(0, 0), b2, voffB); PG8_STAGE(PG8_SB(0, 1), b2 + hstep, voffB); PG8_STAGE(PG8_SA(0, 0), a2, voffA);
            PG8_WAIT_V(8); PG8_WAIT_L(0); PG8_BAR; PG8_MMA(1, 0, At, B0); PG8_MMA(1, 1, At, B1); PG8_BAR; PG8_SCHED;
            PG8_LDB(B0, 1, 0); PG8_LDB(B1, 1, 1); PG8_SCHED; PG8_LDA(At, 1, 0); PG8_STAGE(PG8_SA(0, 1), a2 + hstep, voffA);
            PG8_WAIT_V(8); PG8_WAIT_L(0); PG8_BAR; PG8_MMA(0, 0, At, B0); PG8_MMA(0, 1, At, B1); PG8_BAR; PG8_SCHED;
            PG8_LDA(At, 1, 1); PG8_STAGE(PG8_SB(1, 0), b3, voffB); PG8_STAGE(PG8_SB(1, 1), b3 + hstep, voffB); PG8_STAGE(PG8_SA(1, 0), a3, voffA);
            PG8_WAIT_V(8); PG8_WAIT_L(0); PG8_BAR; PG8_MMA(1, 0, At, B0); PG8_MMA(1, 1, At, B1); PG8_BAR; PG8_SCHED;
            } else {
            PG8_LDB(B0, 0, 0); PG8_SCHED; PG8_LDA(At, 0, 0); PG8_STAGE(PG8_SA(1, 1), a1 + hstep, voffA);
            PG8_WAIT_L(8); PG8_BAR; PG8_WAIT_L(0); PG8_MMA(0, 0, At, B0); PG8_BAR; PG8_SCHED;
            PG8_LDB(B1, 0, 1); PG8_STAGE(PG8_SB(0, 0), b2, voffB);
            PG8_BAR; PG8_WAIT_L(0); PG8_MMA(0, 1, At, B1); PG8_BAR;
            PG8_LDA(At, 0, 1); PG8_STAGE(PG8_SA(0, 0), a2, voffA);
            PG8_BAR; PG8_WAIT_L(0); PG8_MMA(1, 0, At, B0); PG8_BAR; PG8_SCHED;
            PG8_STAGE(PG8_SB(0, 1), b2 + hstep, voffB);
            PG8_WAIT_V(6); PG8_BAR; PG8_MMA(1, 1, At, B1); PG8_BAR;
            PG8_LDB(B0, 1, 0); PG8_SCHED; PG8_LDA(At, 1, 0); PG8_STAGE(PG8_SA(0, 1), a2 + hstep, voffA);
            PG8_WAIT_L(8); PG8_BAR; PG8_WAIT_L(0); PG8_MMA(0, 0, At, B0); PG8_BAR; PG8_SCHED;
            PG8_LDB(B1, 1, 1); PG8_STAGE(PG8_SB(1, 0), b3, voffB);
            PG8_BAR; PG8_WAIT_L(0); PG8_MMA(0, 1, At, B1); PG8_BAR;
            PG8_LDA(At, 1, 1); PG8_STAGE(PG8_SA(1, 0), a3, voffA);
            PG8_BAR; PG8_WAIT_L(0); PG8_MMA(1, 0, At, B0); PG8_BAR; PG8_SCHED;
            PG8_STAGE(PG8_SB(1, 1), b3 + hstep, voffB);
            PG8_WAIT_V(6); PG8_BAR; PG8_MMA(1, 1, At, B1); PG8_BAR;
            }
        }
        if constexpr (ALIGN_EPI) { if (wr == 0) PG8_BAR; }
        if constexpr (!Epi::AFTER_DRAIN) { E(acc, cur, wr, wc, fr, fq); S.done(cur); }
        if (!has_next) break;
#pragma unroll
        for (int a = 0; a < 2; ++a)
#pragma unroll
            for (int b = 0; b < 2; ++b)
#pragma unroll
                for (int m = 0; m < 4; ++m)
#pragma unroll
                    for (int n = 0; n < 2; ++n) acc[a][b][m][n] = (f32x4){0.f, 0.f, 0.f, 0.f};
        cur = nxt; cA = nA; cB = nB; ++ui;
        if constexpr (ALIGN_EPI) { if (wr == 1) PG8_BAR; }
    }
    PG8_WAIT_V(0);
    if constexpr (!ALIGN_EPI) { if (wr == 0) PG8_BAR; }
    PG8_BAR;
    if constexpr (Epi::AFTER_DRAIN) { E.fused(acc, cur, wr, wc, fr, fq, lds, wid, lane); S.done(cur); }
#undef PG8_SA
#undef PG8_SB
#undef PG8_STAGE
#undef PG8_LDA
#undef PG8_LDB
#undef PG8_MMA
#undef PG8_WAIT_V
#undef PG8_WAIT_L
#undef PG8_BAR
#undef PG8_SCHED
}
}
namespace pg8 {
__device__ __forceinline__ float bfbits2f(unsigned b16) { return __uint_as_float(b16 << 16); }
__device__ __forceinline__ float sigmoidf_(float x) { return 1.0f / (1.0f + __expf(-x)); }
struct EpiGateA {
    static constexpr bool PERM = true, AFTER_DRAIN = false;
    bf16_t* O; int ldc; const bf16_t* gate; int ldg;
    __device__ __forceinline__ void operator()(const f32x4 (&acc)[2][2][4][2], const Unit& u, int wr, int wc, int fr, int fq) const {
        const int row0 = u.pm * BM + wr * 64 + fr, col0 = u.pn * BM + wc * 32 + 8 * fq;
#pragma unroll
        for (int ai = 0; ai < 2; ++ai)
#pragma unroll
            for (int m = 0; m < 4; ++m) { const size_t r = (size_t)(row0 + ai * HALF + m * 16);
#pragma unroll
                for (int bj = 0; bj < 2; ++bj) { const int c = col0 + bj * HALF;
                    const u32x4 gv = *(const u32x4*)(gate + r * ldg + c);
                    const f32x4 v0 = acc[ai][bj][m][0], v1 = acc[ai][bj][m][1];
                    float o[8];
                    o[0] = v0[0] * sigmoidf_(bfbits2f(gv.x & 0xffffu)); o[1] = v0[1] * sigmoidf_(bfbits2f(gv.x >> 16));
                    o[2] = v0[2] * sigmoidf_(bfbits2f(gv.y & 0xffffu)); o[3] = v0[3] * sigmoidf_(bfbits2f(gv.y >> 16));
                    o[4] = v1[0] * sigmoidf_(bfbits2f(gv.z & 0xffffu)); o[5] = v1[1] * sigmoidf_(bfbits2f(gv.z >> 16));
                    o[6] = v1[2] * sigmoidf_(bfbits2f(gv.w & 0xffffu)); o[7] = v1[3] * sigmoidf_(bfbits2f(gv.w >> 16));
                    u32x4 w; w.x = cvt_pk_bf16(o[0], o[1]); w.y = cvt_pk_bf16(o[2], o[3]); w.z = cvt_pk_bf16(o[4], o[5]); w.w = cvt_pk_bf16(o[6], o[7]);
                    *(u32x4*)(O + r * ldc + c) = w; }
                if (m == 3) asm volatile("" ::: "memory"); }
    }
};
struct EpiGateR {
    static constexpr bool PERM = true, AFTER_DRAIN = false;
    bf16_t* O; int ldc; const bf16_t* gate; int ldg;
    __device__ __forceinline__ void operator()(const f32x4 (&acc)[2][2][4][2], const Unit& u, int wr, int wc, int fr, int fq) const {
        const int row0 = u.pm * BM + wr * 64 + fr, col0 = u.pn * BM + wc * 32 + 8 * fq;
#pragma unroll
        for (int ai = 0; ai < 2; ++ai)
#pragma unroll
            for (int m = 0; m < 4; ++m) { const size_t r = (size_t)(row0 + ai * HALF + m * 16);
#pragma unroll
                for (int bj = 0; bj < 2; ++bj) { const int c = col0 + bj * HALF;
                    const u32x4 gv = *(const u32x4*)(gate + r * ldg + c);
                    const u32x4 tv = *(const u32x4*)(O + r * ldc + c);
                    const f32x4 v0 = acc[ai][bj][m][0], v1 = acc[ai][bj][m][1];
                    float o[8];
                    o[0] = bfbits2f(tv.x & 0xffffu) + v0[0] * sigmoidf_(bfbits2f(gv.x & 0xffffu)); o[1] = bfbits2f(tv.x >> 16) + v0[1] * sigmoidf_(bfbits2f(gv.x >> 16));
                    o[2] = bfbits2f(tv.y & 0xffffu) + v0[2] * sigmoidf_(bfbits2f(gv.y & 0xffffu)); o[3] = bfbits2f(tv.y >> 16) + v0[3] * sigmoidf_(bfbits2f(gv.y >> 16));
                    o[4] = bfbits2f(tv.z & 0xffffu) + v1[0] * sigmoidf_(bfbits2f(gv.z & 0xffffu)); o[5] = bfbits2f(tv.z >> 16) + v1[1] * sigmoidf_(bfbits2f(gv.z >> 16));
                    o[6] = bfbits2f(tv.w & 0xffffu) + v1[2] * sigmoidf_(bfbits2f(gv.w & 0xffffu)); o[7] = bfbits2f(tv.w >> 16) + v1[3] * sigmoidf_(bfbits2f(gv.w >> 16));
                    u32x4 w; w.x = cvt_pk_bf16(o[0], o[1]); w.y = cvt_pk_bf16(o[2], o[3]); w.z = cvt_pk_bf16(o[4], o[5]); w.w = cvt_pk_bf16(o[6], o[7]);
                    *(u32x4*)(O + r * ldc + c) = w; }
                if (m == 3) asm volatile("" ::: "memory"); }
    }
};
struct EpiF32 {
    static constexpr bool PERM = true, AFTER_DRAIN = false;
    float* O; int ldc;
    __device__ __forceinline__ void operator()(const f32x4 (&acc)[2][2][4][2], const Unit& u, int wr, int wc, int fr, int fq) const {
        const int row0 = u.pm * BM + wr * 64 + fr, col0 = u.pn * BM + wc * 32 + 8 * fq;
#pragma unroll
        for (int ai = 0; ai < 2; ++ai)
#pragma unroll
            for (int m = 0; m < 4; ++m) { float* rowp = O + (size_t)(row0 + ai * HALF + m * 16) * ldc + col0;
#pragma unroll
                for (int bj = 0; bj < 2; ++bj) { *(f32x4*)(rowp + bj * HALF) = acc[ai][bj][m][0]; *(f32x4*)(rowp + bj * HALF + 4) = acc[ai][bj][m][1]; } }
    }
};
}

constexpr int NWAVES = 8;
constexpr int D = 1024, BATCH = 8, SEQ = 4096, DEPTH = 4;
constexpr int M = BATCH * SEQ, MH = M / 2;
constexpr int DIN = 5888, DFF = 2816, NUP = 2 * DFF;
constexpr int C_QA = 0, C_KA = 512, C_VA = 640, C_QR = 768, C_KR = 1280, C_VR = 1792, C_GR = 2816, C_GA = 3840, C_GT = 4864;
constexpr float EPS = 1e-6f;
#ifndef MK_ONE_LAUNCH
#define MK_ONE_LAUNCH 0
#endif
constexpr int PH_PER = 12;
constexpr int N_PHASES = 1 + DEPTH * 2 * PH_PER;

constexpr size_t MiB = 1u << 20;
constexpr size_t WS_CTL = 0, CTL_ZERO_BYTES = 1 * MiB;
constexpr size_t WS_BIAS = 1 * MiB;
constexpr size_t WS_COS = 2 * MiB, WS_SIN = 3 * MiB;
constexpr size_t WS_W = 4 * MiB;
constexpr size_t W_IN = 0, W_OA = W_IN + (size_t)DIN * D, W_OR = W_OA + (size_t)D * 512, W_O = W_OR + (size_t)D * D, W_UP = W_O + (size_t)D * D, W_DN = W_UP + (size_t)NUP * D, W_LAYER = W_DN + (size_t)D * DFF;
static_assert(W_LAYER * 2 == 33 * MiB, "weights per layer");
constexpr size_t WS_RA = WS_W + 4 * 33 * MiB;
constexpr size_t WS_RB = WS_RA + 184 * MiB;
constexpr size_t WS_XN = WS_RB;
constexpr size_t WS_AOA = WS_XN + 32 * MiB;
constexpr size_t WS_AOR = WS_AOA + 16 * MiB;
constexpr size_t WS_KV = WS_AOR + 32 * MiB;
constexpr size_t WS_MG = WS_KV + 32 * MiB;
constexpr size_t WS_G = WS_AOA;
constexpr size_t WS_END = WS_MG + 32 * MiB;
static_assert((size_t)MH * DIN * 2 == 184 * MiB && WS_G + (size_t)MH * DFF * 2 <= WS_END, "ws map");
constexpr int CW_BAR = 4096;

constexpr int RING_BYTES = 131072;
constexpr int LDS_BYTES = 147456;
constexpr int MISC_OFF = 143360;

#define GAS __attribute__((address_space(1)))
#define LAS __attribute__((address_space(3)))
typedef unsigned short bf16;
typedef unsigned v4u __attribute__((ext_vector_type(4)));
typedef float f32x4 __attribute__((ext_vector_type(4)));
typedef short bf16x8 __attribute__((ext_vector_type(8)));
typedef GAS unsigned gu32;
typedef GAS unsigned long long gu64;
#define RLX_AGENT __ATOMIC_RELAXED, __HIP_MEMORY_SCOPE_AGENT
#define LDS_WAIT() asm volatile("s_waitcnt lgkmcnt(0)" ::: "memory")
#define VM_WAIT() asm volatile("s_waitcnt vmcnt(0)" ::: "memory")
__device__ __forceinline__ unsigned long long rt() { return __builtin_amdgcn_s_memrealtime(); }
__device__ __forceinline__ unsigned f2bf(float f) { unsigned u = __builtin_bit_cast(unsigned, f); return (u + 0x7fffu + ((u >> 16) & 1u)) >> 16; }
__device__ __forceinline__ unsigned pk2(float lo, float hi) { return f2bf(lo) | (f2bf(hi) << 16); }

#define XB_TMO      128
#define XB_XCNT(j)  (256  + 64 * (j))
#define XB_XSUB(j)  (1280 + 64 * (j))
#define XB_XGEN(j)  (2304 + 64 * (j))
#define XB_TOP      3328
#define XB_TOPGEN   3392
#define XCD_BAR_WORDS 3456
#define XB_SPIN_CAP (1u << 18)

__device__ __forceinline__ unsigned xb_ld(unsigned* p)              { return __hip_atomic_load(p, __ATOMIC_RELAXED, __HIP_MEMORY_SCOPE_AGENT); }
__device__ __forceinline__ unsigned xb_add(unsigned* p, unsigned v) { return __hip_atomic_fetch_add(p, v, __ATOMIC_RELAXED, __HIP_MEMORY_SCOPE_AGENT); }
__device__ __forceinline__ unsigned xb_xcc_id() { return (unsigned)__builtin_amdgcn_s_getreg((3 << 11) | 20) & 0xFu; }
#define XB_SPIN(cond, bar) do { unsigned _sp = 0; while (cond) { __builtin_amdgcn_s_sleep(1); \
    if ((++_sp & 255u) == 0u) { if (xb_ld(&(bar)[XB_TMO])) break; if (_sp > XB_SPIN_CAP) { atomicAdd(&(bar)[XB_TMO], 1u); break; } } } } while (0)

struct XcdBarrier {
    unsigned* bar; unsigned x;
    volatile LAS unsigned* st;
};

__device__ __forceinline__ XcdBarrier xcd_barrier_post(unsigned* bar, volatile LAS unsigned* st) {
    XcdBarrier b; b.bar = bar; b.x = xb_xcc_id(); b.st = st;
    if (threadIdx.x == 0) (void)xb_add(&bar[XB_XCNT(b.x)], 1u);
    return b;
}
__device__ __forceinline__ void xcd_barrier_complete(unsigned* bar, unsigned x, unsigned& nloc, unsigned& nx) {
    const unsigned G = gridDim.x * gridDim.y * gridDim.z;
    unsigned sum, cnt, mine, sp = 0u;
    for (;;) {
        sum = 0u; cnt = 0u; mine = 0u;
#pragma unroll
        for (unsigned j = 0; j < 16; ++j) { const unsigned c = xb_ld(&bar[XB_XCNT(j)]); sum += c; cnt += (c > 0u) ? 1u : 0u; mine = (j == x) ? c : mine; }
        if (sum == G) break;
        __builtin_amdgcn_s_sleep(1);
        if ((++sp & 255u) == 0u) { if (xb_ld(&bar[XB_TMO])) break; if (sp > XB_SPIN_CAP) { atomicAdd(&bar[XB_TMO], 1u); break; } }
    }
    nloc = mine > 0u ? mine : 1u; nx = cnt > 0u ? cnt : 1u;
}

__device__ __forceinline__ void xcd_barrier(const XcdBarrier& b) {
    asm volatile("s_waitcnt vmcnt(0)" ::: "memory");
    __syncthreads();
    if (threadIdx.x == 0) {
        unsigned* bar = b.bar;
        __builtin_amdgcn_s_waitcnt(0);
        unsigned nloc = b.st[0], nx = b.st[1];
        if (nloc == 0u) { xcd_barrier_complete(bar, b.x, nloc, nx); b.st[0] = nloc; b.st[1] = nx; }
        const unsigned old = xb_add(&bar[XB_XSUB(b.x)], 1u);
        const unsigned gen = old / nloc;
        if (old + 1u == (gen + 1u) * nloc) {
            __builtin_amdgcn_fence(__ATOMIC_RELEASE, "agent");
            asm volatile("s_waitcnt vmcnt(0)" ::: "memory");
            const unsigned og = xb_add(&bar[XB_TOP], 1u);
            const unsigned tg = og / nx;
            if (og + 1u == (tg + 1u) * nx) xb_add(&bar[XB_TOPGEN], 1u);
            else XB_SPIN(xb_ld(&bar[XB_TOPGEN]) == tg, bar);
            __builtin_amdgcn_fence(__ATOMIC_ACQUIRE, "agent");
            xb_add(&bar[XB_XGEN(b.x)], 1u);
            asm volatile("s_waitcnt vmcnt(0)" ::: "memory");
        } else {
            XB_SPIN(xb_ld(&bar[XB_XGEN(b.x)]) == gen, bar);
            __builtin_amdgcn_fence(__ATOMIC_ACQUIRE, "agent");
            asm volatile("s_waitcnt vmcnt(0)" ::: "memory");
        }
    }
    __syncthreads();
}
typedef unsigned u32x2 __attribute__((ext_vector_type(2)));
typedef unsigned short u16;
#define MFMA16(a, b, c) __builtin_amdgcn_mfma_f32_16x16x32_bf16((a), (b), (c), 0, 0, 0)
__device__ __forceinline__ float bf2f(unsigned b) { return __uint_as_float(b << 16); }
__device__ __forceinline__ float wave_sum(float v) {
#pragma unroll
    for (int o = 1; o < 64; o <<= 1) v += __shfl_xor(v, o);
    return v;
}
__device__ __forceinline__ float sigm(float x) { return 1.0f / (1.0f + __expf(-x)); }
__device__ __forceinline__ float tanh_fast(float x) { const float e = __expf(-2.0f * fabsf(x)); const float t = (1.0f - e) / (1.0f + e); return x < 0.f ? -t : t; }
__device__ __forceinline__ float gelu_tanh(float x) { const float u = 0.7978845608028654f * (x + 0.044715f * x * x * x); return 0.5f * x * (1.0f + tanh_fast(u)); }

__device__ __forceinline__ void p0_transpose_item(const float* W, int K, int N, bf16* WT, LAS float* scr, int item, int lane) {
    const int nblk = N / 32, kb = item / nblk, nb = item % nblk, k0 = 64 * kb, n0 = 32 * nb;
#pragma unroll 8
    for (int i = 0; i < 32; ++i) { const int kk = 2 * i + (lane >> 5); scr[kk * 33 + (lane & 31)] = W[(size_t)(k0 + kk) * N + n0 + (lane & 31)]; }
    LDS_WAIT(); asm volatile("" ::: "memory");
    const int c = lane & 7;
#pragma unroll
    for (int j = 0; j < 4; ++j) { const int n = (lane >> 3) + 8 * j; const LAS float* s = scr + (8 * c) * 33 + n;
        v4u o; o.x = pk2(s[0 * 33], s[1 * 33]); o.y = pk2(s[2 * 33], s[3 * 33]); o.z = pk2(s[4 * 33], s[5 * 33]); o.w = pk2(s[6 * 33], s[7 * 33]);
        *(GAS v4u*)(WT + (size_t)(n0 + n) * K + k0 + 8 * c) = o; }
    LDS_WAIT(); asm volatile("" ::: "memory");
}
__device__ __forceinline__ void p0_matrix(const float* W, int K, int N, bf16* WT, LAS float* scr, int gw, int NGW, int lane) {
    const int nitems = (K / 64) * (N / 32);
    for (int it = gw; it < nitems; it += NGW) p0_transpose_item(W, K, N, WT, scr, it, lane);
}

__device__ __forceinline__ void rms_rows(const float* x, const float* g, bf16* xn, int gw, int NGW, int lane) {
    f32x4 gg[4];
#pragma unroll
    for (int j = 0; j < 4; ++j) gg[j] = *((const f32x4*)g + lane + 64 * j);
    for (int m = gw; m < MH; m += NGW) {
        const GAS f32x4* xr = (const GAS f32x4*)(x + (size_t)m * D) + lane;
        f32x4 v[4]; float s = 0.f;
#pragma unroll
        for (int j = 0; j < 4; ++j) { v[j] = xr[64 * j]; s += (v[j].x * v[j].x + v[j].y * v[j].y) + (v[j].z * v[j].z + v[j].w * v[j].w); }
        const float r = 1.0f / sqrtf(wave_sum(s) * (1.f / D) + EPS);
        GAS u32x2* o = (GAS u32x2*)(xn + (size_t)m * D) + lane;
#pragma unroll
        for (int j = 0; j < 4; ++j) { u32x2 w; w.x = pk2(v[j].x * r * gg[j].x, v[j].y * r * gg[j].y); w.y = pk2(v[j].z * r * gg[j].z, v[j].w * r * gg[j].w); o[64 * j] = w; }
    }
}
__device__ __forceinline__ void resid_rows(const float* z, const float* xsrc, float* xdst, const float* gpost, const float* gnext, bf16* xn, int gw, int NGW, int lane) {
    for (int m = gw; m < MH; m += NGW) {
        const GAS f32x4* zr = (const GAS f32x4*)(z + (size_t)m * D) + lane;
        const GAS f32x4* xr = (const GAS f32x4*)(xsrc + (size_t)m * D) + lane;
        f32x4 v[4], xv[4]; float s = 0.f;
#pragma unroll
        for (int j = 0; j < 4; ++j) { v[j] = zr[64 * j]; xv[j] = xr[64 * j]; s += (v[j].x * v[j].x + v[j].y * v[j].y) + (v[j].z * v[j].z + v[j].w * v[j].w); }
        const float r = 1.0f / sqrtf(wave_sum(s) * (1.f / D) + EPS);
        float s2 = 0.f;
        GAS f32x4* xo = (GAS f32x4*)(xdst + (size_t)m * D) + lane;
#pragma unroll
        for (int j = 0; j < 4; ++j) { const f32x4 gp = *((const f32x4*)gpost + lane + 64 * j); v[j] = xv[j] + v[j] * r * gp; xo[64 * j] = v[j];
            s2 += (v[j].x * v[j].x + v[j].y * v[j].y) + (v[j].z * v[j].z + v[j].w * v[j].w); }
        if (gnext) {
            const float r2 = 1.0f / sqrtf(wave_sum(s2) * (1.f / D) + EPS);
            GAS u32x2* o = (GAS u32x2*)(xn + (size_t)m * D) + lane;
#pragma unroll
            for (int j = 0; j < 4; ++j) { const f32x4 gn = *((const f32x4*)gnext + lane + 64 * j); u32x2 w; w.x = pk2(v[j].x * r2 * gn.x, v[j].y * r2 * gn.y); w.y = pk2(v[j].z * r2 * gn.z, v[j].w * r2 * gn.w); o[64 * j] = w; }
        }
    }
}
__device__ __forceinline__ void conv_phase(const bf16* U, bf16* G, const float* cw, const float* cb, int gt, int NGT) {
    constexpr int CG = DFF / 8, NIT = (MH / 32) * CG;
    for (int it = gt; it < NIT; it += NGT) {
        const int cg = it % CG, rg = it / CG, c0 = cg * 8, t0 = rg * 32;
        float w0[8], w1[8], w2[8], bb[8];
#pragma unroll
        for (int e = 0; e < 8; ++e) { w0[e] = cw[c0 + e]; w1[e] = cw[DFF + c0 + e]; w2[e] = cw[2 * DFF + c0 + e]; bb[e] = cb[c0 + e]; }
        float a2[8], a1[8];
        if ((t0 & (SEQ - 1)) == 0) {
#pragma unroll
            for (int e = 0; e < 8; ++e) { a2[e] = 0.f; a1[e] = 0.f; }
        } else {
            const v4u p2 = *(const GAS v4u*)(U + (size_t)(t0 - 2) * NUP + c0), p1 = *(const GAS v4u*)(U + (size_t)(t0 - 1) * NUP + c0);
            a2[0] = bf2f(p2.x & 0xffffu); a2[1] = bf2f(p2.x >> 16); a2[2] = bf2f(p2.y & 0xffffu); a2[3] = bf2f(p2.y >> 16); a2[4] = bf2f(p2.z & 0xffffu); a2[5] = bf2f(p2.z >> 16); a2[6] = bf2f(p2.w & 0xffffu); a2[7] = bf2f(p2.w >> 16);
            a1[0] = bf2f(p1.x & 0xffffu); a1[1] = bf2f(p1.x >> 16); a1[2] = bf2f(p1.y & 0xffffu); a1[3] = bf2f(p1.y >> 16); a1[4] = bf2f(p1.z & 0xffffu); a1[5] = bf2f(p1.z >> 16); a1[6] = bf2f(p1.w & 0xffffu); a1[7] = bf2f(p1.w >> 16);
        }
#pragma unroll 4
        for (int t = 0; t < 32; ++t) {
            const v4u pa = *(const GAS v4u*)(U + (size_t)(t0 + t) * NUP + c0), pv = *(const GAS v4u*)(U + (size_t)(t0 + t) * NUP + DFF + c0);
            float a0[8], vv[8], o[8];
            a0[0] = bf2f(pa.x & 0xffffu); a0[1] = bf2f(pa.x >> 16); a0[2] = bf2f(pa.y & 0xffffu); a0[3] = bf2f(pa.y >> 16); a0[4] = bf2f(pa.z & 0xffffu); a0[5] = bf2f(pa.z >> 16); a0[6] = bf2f(pa.w & 0xffffu); a0[7] = bf2f(pa.w >> 16);
            vv[0] = bf2f(pv.x & 0xffffu); vv[1] = bf2f(pv.x >> 16); vv[2] = bf2f(pv.y & 0xffffu); vv[3] = bf2f(pv.y >> 16); vv[4] = bf2f(pv.z & 0xffffu); vv[5] = bf2f(pv.z >> 16); vv[6] = bf2f(pv.w & 0xffffu); vv[7] = bf2f(pv.w >> 16);
#pragma unroll
            for (int e = 0; e < 8; ++e) { const float ac = bb[e] + w0[e] * a2[e] + w1[e] * a1[e] + w2[e] * a0[e]; o[e] = gelu_tanh(ac) * vv[e]; a2[e] = a1[e]; a1[e] = a0[e]; }
            v4u w; w.x = pk2(o[0], o[1]); w.y = pk2(o[2], o[3]); w.z = pk2(o[4], o[5]); w.w = pk2(o[6], o[7]);
            *(GAS v4u*)(G + (size_t)(t0 + t) * DFF + c0) = w;
        }
    }
}
__device__ __forceinline__ void scan_phase(bf16* KV, int gt, int NGT) {
    constexpr int NIT = 16 * (256 * 128 / 4);
    for (int it = gt; it < NIT; it += NGT) {
        const int p = it / 8192, idx = it % 8192, h = p & 3;
        const float gc = __expf(128.0f * __logf(1.0f - exp2f(-5.0f - (float)h)));
        GAS u32x2* base = (GAS u32x2*)(KV + (size_t)p * 32 * 32768) + idx;
        u32x2 ld[32];
#pragma unroll
        for (int n = 0; n < 32; ++n) ld[n] = base[(size_t)n * 8192];
        float s0 = 0.f, s1 = 0.f, s2 = 0.f, s3 = 0.f;
#pragma unroll
        for (int n = 0; n < 32; ++n) {
            u32x2 w; w.x = pk2(s0, s1); w.y = pk2(s2, s3); base[(size_t)n * 8192] = w;
            s0 = gc * s0 + bf2f(ld[n].x & 0xffffu); s1 = gc * s1 + bf2f(ld[n].x >> 16); s2 = gc * s2 + bf2f(ld[n].y & 0xffffu); s3 = gc * s3 + bf2f(ld[n].y >> 16);
        }
    }
}

__device__ __forceinline__ void attn_unit(LAS unsigned char* lds, const bf16* proj, bf16* aoa, const float* biastab, const float* sinks_l, int unit, int tid, int wave, int lane) {
    constexpr int KST = 144, VST = 136, K_OFF = 0, V_OFF = 256 * KST, B_OFF = V_OFF + 256 * VST;
    const int kh = unit & 1, n = (unit >> 1) & 31, bb = unit >> 6;
    const int rb = bb * SEQ + 128 * n;
    for (int it = tid; it < 2048; it += 512) {
        const int j = it >> 3, ch = it & 7;
        v4u kv = (v4u){0u, 0u, 0u, 0u}, vv = (v4u){0u, 0u, 0u, 0u};
        if (n > 0 || j >= 128) { const bf16* src = proj + (size_t)(rb - 128 + j) * DIN; kv = *(const GAS v4u*)(src + C_KA + kh * 64 + ch * 8); vv = *(const GAS v4u*)(src + C_VA + kh * 64 + ch * 8); }
        *(LAS v4u*)(lds + K_OFF + j * KST + ch * 16) = kv;
        *(LAS u32x2*)(lds + V_OFF + j * VST + ch * 16) = (u32x2){vv.x, vv.y};
        *(LAS u32x2*)(lds + V_OFF + j * VST + ch * 16 + 8) = (u32x2){vv.z, vv.w};
    }
    { LAS float* bl = (LAS float*)(lds + B_OFF); bl[tid] = biastab[(kh * 4 + (tid >> 7)) * 128 + (tid & 127)]; }
    __syncthreads();
    const int g = wave >> 1, qh = wave & 1, head = kh * 4 + g;
    const float sink = sinks_l[head];
    const int c = lane & 15, q = lane >> 4;
    const LAS float* bl = (const LAS float*)(lds + B_OFF) + g * 128;
    for (int qs = 0; qs < 4; ++qs) {
        const int i0 = 64 * qh + 16 * qs, i = i0 + c;
        const bf16* qsrc = proj + (size_t)(rb + i) * DIN + C_QA + head * 64 + 8 * q;
        const bf16x8 qf0 = *(const GAS bf16x8*)(qsrc), qf1 = *(const GAS bf16x8*)(qsrc + 32);
        f32x4 s[9];
#pragma unroll
        for (int kt = 0; kt < 9; ++kt) {
            const LAS unsigned char* kp = lds + K_OFF + (i0 + 16 * kt + c) * KST + 16 * q;
            const bf16x8 k0 = *(const LAS bf16x8*)kp, k1 = *(const LAS bf16x8*)(kp + 64);
            f32x4 a = (f32x4){0.f, 0.f, 0.f, 0.f};
            a = MFMA16(k0, qf0, a); a = MFMA16(k1, qf1, a); s[kt] = a;
        }
        float mx = -3.0e38f;
#pragma unroll
        for (int kt = 0; kt < 9; ++kt)
#pragma unroll
            for (int r = 0; r < 4; ++r) {
                const int j = i0 + 16 * kt + 4 * q + r, dist = 128 + i - j;
                const bool ok = (dist >= 0) && (dist < 128) && (n > 0 || j >= 128);
                const float v = ok ? s[kt][r] * 0.125f + bl[dist & 127] : -1.0e30f;
                s[kt][r] = v; mx = fmaxf(mx, v);
            }
        mx = fmaxf(mx, __shfl_xor(mx, 16)); mx = fmaxf(mx, __shfl_xor(mx, 32)); mx = fmaxf(mx, sink);
        float sum = 0.f;
#pragma unroll
        for (int kt = 0; kt < 9; ++kt)
#pragma unroll
            for (int r = 0; r < 4; ++r) { const float p = __expf(s[kt][r] - mx); s[kt][r] = p; sum += p; }
        sum += __shfl_xor(sum, 16); sum += __shfl_xor(sum, 32);
        const float inv = 1.0f / (sum + __expf(sink - mx));
        f32x4 o[4];
#pragma unroll
        for (int dt = 0; dt < 4; ++dt) o[dt] = (f32x4){0.f, 0.f, 0.f, 0.f};
#pragma unroll
        for (int p = 0; p < 5; ++p) {
            const f32x4 ta = s[2 * p], tb = (2 * p + 1 < 9) ? s[2 * p + 1 < 9 ? 2 * p + 1 : 8] : (f32x4){0.f, 0.f, 0.f, 0.f};
            v4u pw; pw.x = pk2(ta[0], ta[1]); pw.y = pk2(ta[2], ta[3]); pw.z = pk2(tb[0], tb[1]); pw.w = pk2(tb[2], tb[3]);
            const bf16x8 pb = __builtin_bit_cast(bf16x8, pw);
#pragma unroll
            for (int dt = 0; dt < 4; ++dt) {
                bf16x8 va;
#pragma unroll
                for (int j = 0; j < 8; ++j) { int key = i0 + 32 * p + (j < 4 ? 4 * q + j : 16 + 4 * q + (j - 4)); key = key > 255 ? 255 : key;
                    va[j] = (short)*(const LAS u16*)(lds + V_OFF + key * VST + (16 * dt + c) * 2); }
                o[dt] = MFMA16(va, pb, o[dt]);
            }
        }
        bf16* orow = aoa + (size_t)(rb + i) * 512 + head * 64 + 4 * q;
#pragma unroll
        for (int dt = 0; dt < 4; ++dt) { u32x2 w; w.x = pk2(o[dt][0] * inv, o[dt][1] * inv); w.y = pk2(o[dt][2] * inv, o[dt][3] * inv); *(GAS u32x2*)(orow + 16 * dt) = w; }
    }
    __syncthreads();
}

__device__ __forceinline__ void stage_rot(LAS unsigned char* img, const bf16* src, const float* cp, const float* sp, float sc, int s, int i8) {
    const v4u x1 = *(const GAS v4u*)(src), x2 = *(const GAS v4u*)(src + 64);
    const f32x4 c0 = *(const GAS f32x4*)(cp), c1 = *(const GAS f32x4*)(cp + 4), s0 = *(const GAS f32x4*)(sp), s1 = *(const GAS f32x4*)(sp + 4);
    float a[8], b[8], cc[8], ss[8], o1[8], o2[8];
    a[0] = bf2f(x1.x & 0xffffu); a[1] = bf2f(x1.x >> 16); a[2] = bf2f(x1.y & 0xffffu); a[3] = bf2f(x1.y >> 16); a[4] = bf2f(x1.z & 0xffffu); a[5] = bf2f(x1.z >> 16); a[6] = bf2f(x1.w & 0xffffu); a[7] = bf2f(x1.w >> 16);
    b[0] = bf2f(x2.x & 0xffffu); b[1] = bf2f(x2.x >> 16); b[2] = bf2f(x2.y & 0xffffu); b[3] = bf2f(x2.y >> 16); b[4] = bf2f(x2.z & 0xffffu); b[5] = bf2f(x2.z >> 16); b[6] = bf2f(x2.w & 0xffffu); b[7] = bf2f(x2.w >> 16);
    cc[0] = c0.x; cc[1] = c0.y; cc[2] = c0.z; cc[3] = c0.w; cc[4] = c1.x; cc[5] = c1.y; cc[6] = c1.z; cc[7] = c1.w;
    ss[0] = s0.x; ss[1] = s0.y; ss[2] = s0.z; ss[3] = s0.w; ss[4] = s1.x; ss[5] = s1.y; ss[6] = s1.z; ss[7] = s1.w;
#pragma unroll
    for (int e = 0; e < 8; ++e) { o1[e] = (a[e] * cc[e] - b[e] * ss[e]) * sc; o2[e] = (a[e] * ss[e] + b[e] * cc[e]) * sc; }
    v4u w1, w2; w1.x = pk2(o1[0], o1[1]); w1.y = pk2(o1[2], o1[3]); w1.z = pk2(o1[4], o1[5]); w1.w = pk2(o1[6], o1[7]);
    w2.x = pk2(o2[0], o2[1]); w2.y = pk2(o2[2], o2[3]); w2.z = pk2(o2[4], o2[5]); w2.w = pk2(o2[6], o2[7]);
    *(LAS v4u*)(img + s * 272 + i8 * 16) = w1; *(LAS v4u*)(img + s * 272 + 128 + i8 * 16) = w2;
}
__device__ __forceinline__ void stage_v(LAS unsigned char* img, const bf16* proj, int rb, int h, int tid) {
    for (int it = tid; it < 4096; it += 512) { const int s = it >> 5, ch = it & 31;
        const v4u v = *(const GAS v4u*)(proj + (size_t)(rb + s) * DIN + C_VR + h * 256 + 8 * ch);
        *(LAS u32x2*)(img + s * 520 + ch * 16) = (u32x2){v.x, v.y}; *(LAS u32x2*)(img + s * 520 + ch * 16 + 8) = (u32x2){v.z, v.w}; }
}
__device__ __forceinline__ void kv_unit(LAS unsigned char* lds, const bf16* proj, bf16* kvbuf, const float* costab, const float* sintab, int unit, int tid, int wave, int lane) {
    constexpr int KZ_OFF = 0, V_OFF = 128 * 272;
    const int n = unit & 31, h = (unit >> 5) & 3, bb = unit >> 7;
    const int rb = bb * SEQ + 128 * n;
    const float lg = __logf(1.0f - exp2f(-5.0f - (float)h));
    for (int it = tid; it < 1024; it += 512) { const int s = it >> 3, i8 = it & 7;
        stage_rot(lds + KZ_OFF, proj + (size_t)(rb + s) * DIN + C_KR + h * 128 + 8 * i8, costab + (size_t)(128 * n + s) * 64 + 8 * i8, sintab + (size_t)(128 * n + s) * 64 + 8 * i8,
                  0.08838834764831845f * __expf(lg * (float)(127 - s)), s, i8); }
    stage_v(lds + V_OFF, proj, rb, h, tid);
    __syncthreads();
    const int c = lane & 15, q = lane >> 4;
    f32x4 acc[2][8];
#pragma unroll
    for (int ei = 0; ei < 2; ++ei)
#pragma unroll
        for (int dt = 0; dt < 8; ++dt) acc[ei][dt] = (f32x4){0.f, 0.f, 0.f, 0.f};
#pragma unroll
    for (int ks = 0; ks < 4; ++ks) {
        bf16x8 bfr[2];
#pragma unroll
        for (int ei = 0; ei < 2; ++ei)
#pragma unroll
            for (int j = 0; j < 8; ++j) bfr[ei][j] = (short)*(const LAS u16*)(lds + V_OFF + (32 * ks + 8 * q + j) * 520 + (16 * (2 * wave + ei) + c) * 2);
#pragma unroll
        for (int dt = 0; dt < 8; ++dt) {
            bf16x8 af;
#pragma unroll
            for (int j = 0; j < 8; ++j) af[j] = (short)*(const LAS u16*)(lds + KZ_OFF + (32 * ks + 8 * q + j) * 272 + (16 * dt + c) * 2);
#pragma unroll
            for (int ei = 0; ei < 2; ++ei) acc[ei][dt] = MFMA16(af, bfr[ei], acc[ei][dt]);
        }
    }
#pragma unroll
    for (int ei = 0; ei < 2; ++ei) { const int e = 16 * (2 * wave + ei) + c; bf16* dst = kvbuf + ((size_t)unit * 256 + e) * 128 + 4 * q;
#pragma unroll
        for (int dt = 0; dt < 8; ++dt) { u32x2 w; w.x = pk2(acc[ei][dt][0], acc[ei][dt][1]); w.y = pk2(acc[ei][dt][2], acc[ei][dt][3]); *(GAS u32x2*)(dst + 16 * dt) = w; } }
    __syncthreads();
}
__device__ __forceinline__ void ret_unit(LAS unsigned char* lds, const bf16* proj, const bf16* kvbuf, bf16* aor, const float* costab, const float* sintab, const float* rnorm_l, int unit, int tid, int wave, int lane) {
    constexpr int Q_OFF = 0, K_OFF = 128 * 272, V_OFF = 2 * 128 * 272;
    const int n = unit & 31, h = (unit >> 5) & 3, bb = unit >> 7;
    const int rb = bb * SEQ + 128 * n;
    const float lg = __logf(1.0f - exp2f(-5.0f - (float)h));
    for (int it = tid; it < 2048; it += 512) { const int which = it >> 10, s = (it >> 3) & 127, i8 = it & 7;
        const float* cp = costab + (size_t)(128 * n + s) * 64 + 8 * i8; const float* sp = sintab + (size_t)(128 * n + s) * 64 + 8 * i8;
        if (which == 0) stage_rot(lds + Q_OFF, proj + (size_t)(rb + s) * DIN + C_QR + h * 128 + 8 * i8, cp, sp, 1.0f, s, i8);
        else stage_rot(lds + K_OFF, proj + (size_t)(rb + s) * DIN + C_KR + h * 128 + 8 * i8, cp, sp, 0.08838834764831845f, s, i8); }
    stage_v(lds + V_OFF, proj, rb, h, tid);
    __syncthreads();
    const int c = lane & 15, q = lane >> 4, cl = 16 * wave + c;
    bf16x8 qf[4];
#pragma unroll
    for (int ks = 0; ks < 4; ++ks) qf[ks] = *(const LAS bf16x8*)(lds + Q_OFF + cl * 272 + (32 * ks + 8 * q) * 2);
    f32x4 sT[8];
#pragma unroll
    for (int st = 0; st < 8; ++st) {
        f32x4 a = (f32x4){0.f, 0.f, 0.f, 0.f};
        if (st <= wave) {
#pragma unroll
            for (int ks = 0; ks < 4; ++ks) { const bf16x8 kf = *(const LAS bf16x8*)(lds + K_OFF + (16 * st + c) * 272 + (32 * ks + 8 * q) * 2); a = MFMA16(kf, qf[ks], a); }
#pragma unroll
            for (int r = 0; r < 4; ++r) { const int s = 16 * st + 4 * q + r; a[r] = (cl >= s) ? a[r] * __expf(lg * (float)(cl - s)) : 0.f; }
        }
        sT[st] = a;
    }
    f32x4 o[16];
    const bf16* stp = kvbuf + (size_t)unit * 256 * 128 + (size_t)c * 128 + 8 * q;
#pragma unroll
    for (int et = 0; et < 16; ++et) {
        f32x4 a = (f32x4){0.f, 0.f, 0.f, 0.f};
#pragma unroll
        for (int ks = 0; ks < 4; ++ks) { const bf16x8 sf = *(const GAS bf16x8*)(stp + (size_t)et * 16 * 128 + 32 * ks); a = MFMA16(sf, qf[ks], a); }
        o[et] = a;
    }
    const float xi = __expf(lg * (float)(cl + 1));
#pragma unroll
    for (int et = 0; et < 16; ++et) o[et] = o[et] * xi;
#pragma unroll
    for (int p = 0; p < 4; ++p) {
        if (2 * p <= wave) {
            const f32x4 ta = sT[2 * p], tb = sT[2 * p + 1];
            v4u pw; pw.x = pk2(ta[0], ta[1]); pw.y = pk2(ta[2], ta[3]); pw.z = pk2(tb[0], tb[1]); pw.w = pk2(tb[2], tb[3]);
            const bf16x8 pb = __builtin_bit_cast(bf16x8, pw);
#pragma unroll
            for (int et = 0; et < 16; ++et) {
                bf16x8 va;
#pragma unroll
                for (int j = 0; j < 8; ++j) { const int s = 32 * p + (j < 4 ? 4 * q + j : 16 + 4 * q + (j - 4)); va[j] = (short)*(const LAS u16*)(lds + V_OFF + s * 520 + (16 * et + c) * 2); }
                o[et] = MFMA16(va, pb, o[et]);
            }
        }
    }
    float sm = 0.f;
#pragma unroll
    for (int et = 0; et < 16; ++et) sm += (o[et][0] + o[et][1]) + (o[et][2] + o[et][3]);
    sm += __shfl_xor(sm, 16); sm += __shfl_xor(sm, 32);
    const float mu = sm * (1.0f / 256.0f);
    float vs = 0.f;
#pragma unroll
    for (int et = 0; et < 16; ++et) { const f32x4 d = o[et] - mu; vs += (d[0] * d[0] + d[1] * d[1]) + (d[2] * d[2] + d[3] * d[3]); }
    vs += __shfl_xor(vs, 16); vs += __shfl_xor(vs, 32);
    const float rs = 1.0f / sqrtf(vs * (1.0f / 256.0f) + EPS);
    const size_t tok = (size_t)(rb + cl);
    const bf16* grow = proj + tok * DIN + C_GR + h * 256 + 4 * q;
    bf16* orow = aor + tok * 1024 + h * 256 + 4 * q;
    const float* gn = rnorm_l + h * 256 + 4 * q;
#pragma unroll
    for (int et = 0; et < 16; ++et) {
        const u32x2 gv = *(const GAS u32x2*)(grow + 16 * et); const f32x4 gg = *(const GAS f32x4*)(gn + 16 * et);
        const float g0 = bf2f(gv.x & 0xffffu), g1 = bf2f(gv.x >> 16), g2 = bf2f(gv.y & 0xffffu), g3 = bf2f(gv.y >> 16);
        const float y0 = (o[et][0] - mu) * rs * gg.x * g0 * sigm(g0), y1 = (o[et][1] - mu) * rs * gg.y * g1 * sigm(g1), y2 = (o[et][2] - mu) * rs * gg.z * g2 * sigm(g2), y3 = (o[et][3] - mu) * rs * gg.w * g3 * sigm(g3);
        u32x2 w; w.x = pk2(y0, y1); w.y = pk2(y2, y3); *(GAS u32x2*)(orow + 16 * et) = w;
    }
    __syncthreads();
}

struct Args { const float* in[16]; float* out; unsigned char* ws; int ph_lo, ph_hi; };
__global__ void __launch_bounds__(NWAVES * 64, 2) skel_fwd(Args args) {
    extern __shared__ __attribute__((aligned(16))) unsigned char lds_raw[];
    LAS unsigned char* lds = (LAS unsigned char*)lds_raw;
    volatile LAS unsigned* MISC = (volatile LAS unsigned*)(lds + MISC_OFF);
    const int G = gridDim.x, bx = blockIdx.x;
    const int NGW = G * NWAVES, NGT = G * NWAVES * 64;
#define PH_IDS int tid = threadIdx.x; asm volatile("" : "+v"(tid)); const int lane = tid & 63, wave = __builtin_amdgcn_readfirstlane(tid >> 6), gw = bx * NWAVES + wave, gt = bx * (NWAVES * 64) + tid; (void)lane; (void)wave; (void)gw; (void)gt;
    unsigned char* ws = args.ws;
    gu32* ctl = (gu32*)(ws + WS_CTL);
    const int lo = args.ph_lo, hi = args.ph_hi;
    if (threadIdx.x < 64) MISC[threadIdx.x] = 0u;
    __syncthreads();
    XcdBarrier bar; bar.bar = (unsigned*)(ctl + CW_BAR); bar.x = 0; bar.st = nullptr;
    if (hi - lo > 1) bar = xcd_barrier_post((unsigned*)(ctl + CW_BAR), MISC + 8);
#ifndef PHMASK
#define PHMASK 0xFFFF
#endif
#define PHM(b) ((PHMASK >> (b)) & 1)
#define IN(k) (lo <= (k) && (k) < hi)
#define SEAM(k) do { if ((k) + 1 < hi) xcd_barrier(bar); } while (0)

    const float* x_in = args.in[0]; float* xout = args.out;
    bf16* wbase = (bf16*)(ws + WS_W);
    float* biastab = (float*)(ws + WS_BIAS); float* costab = (float*)(ws + WS_COS); float* sintab = (float*)(ws + WS_SIN);
    bf16* PROJ = (bf16*)(ws + WS_RA); float* Z = (float*)(ws + WS_RA); bf16* U = (bf16*)(ws + WS_RA);
    bf16* XN = (bf16*)(ws + WS_XN); bf16* AOA = (bf16*)(ws + WS_AOA); bf16* AOR = (bf16*)(ws + WS_AOR); bf16* KV = (bf16*)(ws + WS_KV); bf16* MG = (bf16*)(ws + WS_MG); bf16* GB = (bf16*)(ws + WS_G);

    if (PHM(0) && IN(0)) { PH_IDS
        LAS float* scr = (LAS float*)(lds + wave * 16384);
        for (int l = 0; l < DEPTH; ++l) {
            bf16* wl = wbase + (size_t)l * W_LAYER;
            p0_matrix(args.in[2] + (size_t)l * D * DIN, D, DIN, wl + W_IN, scr, gw, NGW, lane);
            p0_matrix(args.in[6] + (size_t)l * 512 * D, 512, D, wl + W_OA, scr, gw, NGW, lane);
            p0_matrix(args.in[7] + (size_t)l * D * D, D, D, wl + W_OR, scr, gw, NGW, lane);
            p0_matrix(args.in[8] + (size_t)l * D * D, D, D, wl + W_O, scr, gw, NGW, lane);
            p0_matrix(args.in[11] + (size_t)l * D * NUP, D, NUP, wl + W_UP, scr, gw, NGW, lane);
            p0_matrix(args.in[14] + (size_t)l * DFF * D, DFF, D, wl + W_DN, scr, gw, NGW, lane);
        }
        for (int t = gt; t < 1024; t += NGT) { const int head = t >> 7, dist = t & 127;
            int bucket = dist; if (dist >= 16) { bucket = 16 + (int)(log2f((float)dist * (1.0f / 16.0f)) * (16.0f / 3.0f)); bucket = bucket > 31 ? 31 : bucket; }
            biastab[t] = args.in[4][bucket * 8 + head]; }
        for (int t = gt; t < SEQ * 64; t += NGT) { const int pos = t >> 6, i = t & 63;
            const float fr = exp2f(-(float)i * (13.287712379549449f / 64.0f)); const float ang = (float)pos * fr;
            const double k = rint((double)ang * 0.15915494309189535); const float rr = (float)((double)ang - k * 6.283185307179586);
            costab[t] = __cosf(rr); sintab[t] = __sinf(rr); }
        SEAM(0);
    }

    for (int l = 0; l < DEPTH; ++l) {
        const bf16* wl = wbase + (size_t)l * W_LAYER;
        for (int hf = 0; hf < 2; ++hf) {
            const int pb = 1 + (l * 2 + hf) * PH_PER;
            const size_t xoff = (size_t)hf * MH * D;
            const float* xsrc = (l == 0 ? x_in : (const float*)xout) + xoff;
            float* xdst = xout + xoff;
            if (PHM(1) && IN(pb + 0)) { PH_IDS rms_rows(xsrc, args.in[1] + l * D, XN, gw, NGW, lane); SEAM(pb + 0); }
            if (PHM(2) && IN(pb + 1)) {
                pg8::Gemm g{XN, wl + W_IN, MH, DIN, D}; pg8::StaticOrder S; S.init(MH, DIN, G, bx);
                pg8::EpiBf16<0> E{PROJ, DIN, nullptr, 0, 0, 1.f};
                pg8::gemm_phase<pg8::EpiBf16<0>, pg8::StaticOrder, true, true>(lds, g, S, E);
                SEAM(pb + 1);
            }
            if (PHM(3) && IN(pb + 2)) { PH_IDS
                for (int u = bx; u < 256 + 512; u += G) {
                    if (u < 256) attn_unit(lds, PROJ, AOA, biastab, args.in[3] + l * 8, u, tid, wave, lane);
                    else kv_unit(lds, PROJ, KV, costab, sintab, u - 256, tid, wave, lane);
                }
                SEAM(pb + 2);
            }
            if (PHM(4) && IN(pb + 3)) { PH_IDS scan_phase(KV, gt, NGT); SEAM(pb + 3); }
            if (PHM(5) && IN(pb + 4)) { PH_IDS
                for (int u = bx; u < 512; u += G) ret_unit(lds, PROJ, KV, AOR, costab, sintab, args.in[5] + l * 1024, u, tid, wave, lane);
                SEAM(pb + 4);
            }
            if (PHM(6) && IN(pb + 5)) {
                { pg8::Gemm g{AOA, wl + W_OA, MH, D, 512}; pg8::StaticOrder S; S.init(MH, D, G, bx);
                  pg8::EpiGateA E{MG, D, PROJ + C_GA, DIN};
                  pg8::gemm_phase<pg8::EpiGateA, pg8::StaticOrder, true, true>(lds, g, S, E); }
                asm volatile("s_waitcnt vmcnt(0)" ::: "memory"); __syncthreads();
                { pg8::Gemm g{AOR, wl + W_OR, MH, D, D}; pg8::StaticOrder S; S.init(MH, D, G, bx);
                  pg8::EpiGateR E{MG, D, PROJ + C_GT, DIN};
                  pg8::gemm_phase<pg8::EpiGateR, pg8::StaticOrder, true, true>(lds, g, S, E); }
                SEAM(pb + 5);
            }
            if (PHM(7) && IN(pb + 6)) {
                pg8::Gemm g{MG, wl + W_O, MH, D, D}; pg8::StaticOrder S; S.init(MH, D, G, bx);
                pg8::EpiF32 E{Z, D};
                pg8::gemm_phase<pg8::EpiF32, pg8::StaticOrder, true, true>(lds, g, S, E);
                SEAM(pb + 6);
            }
            if (PHM(8) && IN(pb + 7)) { PH_IDS resid_rows(Z, xsrc, xdst, args.in[9] + l * D, args.in[10] + l * D, XN, gw, NGW, lane); SEAM(pb + 7); }
            if (PHM(9) && IN(pb + 8)) {
                pg8::Gemm g{XN, wl + W_UP, MH, NUP, D}; pg8::StaticOrder S; S.init(MH, NUP, G, bx);
                pg8::EpiBf16<0> E{U, NUP, nullptr, 0, 0, 1.f};
                pg8::gemm_phase<pg8::EpiBf16<0>, pg8::StaticOrder, true, true>(lds, g, S, E);
                SEAM(pb + 8);
            }
            if (PHM(10) && IN(pb + 9)) { PH_IDS conv_phase(U, GB, args.in[12] + (size_t)l * 3 * DFF, args.in[13] + (size_t)l * DFF, gt, NGT); SEAM(pb + 9); }
            if (PHM(11) && IN(pb + 10)) {
                pg8::Gemm g{GB, wl + W_DN, MH, D, DFF}; pg8::StaticOrder S; S.init(MH, D, G, bx);
                pg8::EpiF32 E{Z, D};
                pg8::gemm_phase<pg8::EpiF32, pg8::StaticOrder, true, true>(lds, g, S, E);
                SEAM(pb + 10);
            }
            if (PHM(12) && IN(pb + 11)) { PH_IDS resid_rows(Z, xdst, xdst, args.in[15] + l * D, nullptr, XN, gw, NGW, lane); SEAM(pb + 11); }
        }
    }
#undef IN
#undef SEAM
}

extern "C" void kernel_launch(void* const* d_in, const int* in_sizes, int n_in, void* d_out, int out_size, void* d_ws, size_t ws_size, hipStream_t stream) {
    static int grid = 0;
    if (grid == 0) {
        if (n_in != 16 || in_sizes[0] != M * D || out_size != M * D || ws_size < WS_END) { fprintf(stderr, "kernel_launch: unexpected shapes / workspace (n_in %d, ws %zu < %zu)\n", n_in, ws_size, (size_t)WS_END); grid = -1; return; }
        int dev = 0, cus = 0, per_cu = 0;
        if (hipGetDevice(&dev) != hipSuccess || hipDeviceGetAttribute(&cus, hipDeviceAttributeMultiprocessorCount, dev) != hipSuccess) { grid = -1; return; }
        if (hipFuncSetAttribute((const void*)skel_fwd, hipFuncAttributeMaxDynamicSharedMemorySize, LDS_BYTES) != hipSuccess) { fprintf(stderr, "kernel_launch: hipFuncSetAttribute failed\n"); grid = -1; return; }
        if (hipOccupancyMaxActiveBlocksPerMultiprocessor(&per_cu, (const void*)skel_fwd, NWAVES * 64, LDS_BYTES) != hipSuccess || per_cu < 1) fprintf(stderr, "kernel_launch: occupancy query reports %d\n", per_cu);
        (void)hipGetLastError();
        grid = cus;
    }
    if (grid < 0) return;
    (void)hipMemsetAsync((char*)d_ws + WS_CTL, 0, CTL_ZERO_BYTES, stream);
    Args a{};
    for (int i = 0; i < 16; ++i) a.in[i] = (const float*)d_in[i];
    a.out = (float*)d_out; a.ws = (unsigned char*)d_ws;
#if MK_ONE_LAUNCH
    a.ph_lo = 0; a.ph_hi = N_PHASES;
    hipLaunchKernelGGL(skel_fwd, dim3(grid), dim3(NWAVES * 64), LDS_BYTES, stream, a);
#else
    for (int p = 0; p < N_PHASES; ++p) { a.ph_lo = p; a.ph_hi = p + 1; hipLaunchKernelGGL(skel_fwd, dim3(grid), dim3(NWAVES * 64), LDS_BYTES, stream, a); }
#endif
}
```

```cpp
#include <hip/hip_runtime.h>
#include <cstdio>
#include <cstdint>
#include <cmath>
#define MK_ONE_LAUNCH 1
#define PG_ALIGN_P1 true
#define PG_ALIGN_UP true
#define PG_NST 16
#define PG_SP2_P1 true
#define PG_I8_P1 true
#define PG_I8_UP true
__device__ __forceinline__ float gsel4(int h, float a, float b, float c, float d) { return h == 0 ? a : (h == 1 ? b : (h == 2 ? c : d)); }
#define GAMMA_OF(h) gsel4((h), 0.96875f, 0.984375f, 0.9921875f, 0.99609375f)
#define LOG2_GAMMA_OF(h) gsel4((h), -0.04580368961312479f, -0.02272007650008353f, -0.011315313227834146f, -0.005646563141142063f)
#define GAMMA127_OF(h) gsel4((h), 0.01773731465374751f, 0.13532968927456346f, 0.3693230522678801f, 0.6083133121044885f)
#define GAMMA128_OF(h) gsel4((h), 0.017183023570817902f, 0.1332151628796484f, 0.3664377159220373f, 0.6059370882290803f)
namespace pg8 {
#define PG8_LAS __attribute__((address_space(3)))
typedef unsigned short bf16_t;
typedef short bf16x8 __attribute__((ext_vector_type(8)));
typedef float f32x4 __attribute__((ext_vector_type(4)));
typedef unsigned u32x4 __attribute__((ext_vector_type(4)));
typedef int i32x4 __attribute__((ext_vector_type(4)));
typedef unsigned u32x2 __attribute__((ext_vector_type(2)));
constexpr int BM = 256, BK = 64, HALF = 128, HTB = HALF * BK * 2  , STAGE_BYTES = 8 * HTB, NXCD = 8, WGM = 8;

__host__ __device__ __forceinline__ int lds_byte(int r, int c) { const int st = (r >> 4) * 2 + (c >> 5), rr = r & 15, cc = c & 31, ob = rr * 64 + cc * 2; return st * 1024 + (ob ^ (((ob >> 9) & 1) << 5)); }
__host__ __device__ __forceinline__ void stage_rc(int b, int& R, int& C) { const int st = b / 1024, sb = b % 1024, swz = sb ^ (((sb >> 9) & 1) << 5); R = (st >> 1) * 16 + swz / 64; C = (st & 1) * 32 + (swz % 64) / 2; }
__host__ __device__ __forceinline__ int perm32(int rho) { const int n = rho >> 4, i = rho & 15; return 8 * (i >> 2) + 4 * n + (i & 3); }

struct Unit { int pm, pn; };
struct Gemm { const bf16_t* A; const bf16_t* Bt; int M, N, K; };

struct StaticOrder {
    int nM, nN, nwg, G, c;
    __host__ __device__ __forceinline__ void init(int M, int N, int G_, int c_) { nM = M / BM; nN = N / BM; nwg = nM * nN; G = G_; c = c_; }
    __host__ __device__ __forceinline__ bool next(int i, Unit& u) const {
        const long L = (long)i * G + c; if (L >= nwg) return false;
        int wgid = (int)L; { const int q = nwg / NXCD, r = nwg % NXCD, xcd = wgid % NXCD, off = wgid / NXCD; wgid = (xcd < r ? xcd * (q + 1) : r * (q + 1) + (xcd - r) * q) + off; }
        const int nig = WGM * nN, gid = wgid / nig, fm = gid * WGM, gsz = (nM - fm) < WGM ? (nM - fm) : WGM;
        u.pm = fm + ((wgid % nig) % gsz); u.pn = (wgid % nig) / gsz; return true;
    }
    __device__ __forceinline__ void a_ready(const Unit&) const {}
    __device__ __forceinline__ void done(const Unit&) const {}
};

__device__ __forceinline__ unsigned cvt_pk_bf16(float lo, float hi) { unsigned r; asm volatile("v_cvt_pk_bf16_f32 %0, %1, %2" : "=v"(r) : "v"(lo), "v"(hi)); return r; }
typedef float f32x2 __attribute__((ext_vector_type(2)));
__device__ __forceinline__ f32x2 gelu_pk(f32x2 v) {
    const f32x2 av = __builtin_elementwise_abs(v), d = av * 0.2316418882f + 1.0f;
    f32x2 t; t.x = __builtin_amdgcn_rcpf(d.x); t.y = __builtin_amdgcn_rcpf(d.y);
    f32x2 q = t * 0.5307027145f + (-0.7265760135f); q = q * t + 0.7107068705f; q = q * t + (-0.142248368f); q = q * t + 0.127414796f; q = q * t;
    const f32x2 s = (v * v) * (-0.72134752044f);
    f32x2 e; e.x = __builtin_amdgcn_exp2f(s.x); e.y = __builtin_amdgcn_exp2f(s.y);
    const f32x2 m = v * (q * e), r = v - m;
    f32x2 o; o.x = v.x < 0.f ? m.x : r.x; o.y = v.y < 0.f ? m.y : r.y; return o;
}

template <int ACT  > struct EpiBf16 {
    static constexpr bool PERM = true, AFTER_DRAIN = false, HAS_MID = false, I8 = false; static constexpr int MID_T = -1, NST = 0, PID = 0; static_assert(ACT == 0 || ACT == 1, "EpiBf16: ACT is 0 (none) or 1 (gelu_pk)");
    bf16_t* O; int ldc; const float* bias; int split_cols; size_t split_stride; float scale0;
    __device__ __forceinline__ void operator()(const f32x4 (&acc)[2][2][4][2], const Unit& u, int wr, int wc, int fr, int fq) const {
        const int row0 = u.pm * BM + wr * 64 + fr; int colt = u.pn * BM; bf16_t* base = O;
        float sc = 1.f; if (split_cols) { const int t = colt / split_cols; base += (size_t)t * split_stride; colt -= t * split_cols; if (t == 0) sc = scale0; }
        const int col0 = colt + wc * 32 + 8 * fq, bcol0 = u.pn * BM + wc * 32 + 8 * fq;
        f32x4 bv[2][2];
#pragma unroll
        for (int bj = 0; bj < 2; ++bj)
#pragma unroll
            for (int n = 0; n < 2; ++n) bv[bj][n] = bias ? *(const f32x4*)(bias + bcol0 + bj * HALF + 4 * n) : (f32x4){0.f, 0.f, 0.f, 0.f};
#pragma unroll
        for (int ai = 0; ai < 2; ++ai)
#pragma unroll
            for (int m = 0; m < 4; ++m) { bf16_t* rowp = base + (size_t)(row0 + ai * HALF + m * 16) * ldc + col0;
#pragma unroll
                for (int bj = 0; bj < 2; ++bj) { f32x4 v0 = acc[ai][bj][m][0] + bv[bj][0], v1 = acc[ai][bj][m][1] + bv[bj][1];
                    if (ACT == 1) { f32x2 a = gelu_pk((f32x2){v0[0], v0[1]}), b = gelu_pk((f32x2){v0[2], v0[3]}), c = gelu_pk((f32x2){v1[0], v1[1]}), d = gelu_pk((f32x2){v1[2], v1[3]});
                        v0 = (f32x4){a.x, a.y, b.x, b.y}; v1 = (f32x4){c.x, c.y, d.x, d.y}; }
                    v0 = v0 * sc; v1 = v1 * sc; u32x4 w; w.x = cvt_pk_bf16(v0[0], v0[1]); w.y = cvt_pk_bf16(v0[2], v0[3]); w.z = cvt_pk_bf16(v1[0], v1[1]); w.w = cvt_pk_bf16(v1[2], v1[3]);
                    *(u32x4*)(rowp + bj * HALF) = w; } }
    }
};

template <class Epi, class Sched, bool ALIGN_EPI = false, bool SP2 = false>
__device__ __forceinline__ void gemm_phase(PG8_LAS unsigned char* lds, const Gemm g, const Sched& S, const Epi& E) {
    int tid_o = threadIdx.x; asm volatile("" : "+v"(tid_o));
    const int tid = tid_o, wid = __builtin_amdgcn_readfirstlane(tid >> 6), lane = tid & 63, wr = wid >> 2, wc = wid & 3, fr = lane & 15, fq = lane >> 4;
    const int K = g.K, nt = K / BK;
    unsigned voffA[2], voffB[2];
#pragma unroll
    for (int i = 0; i < 2; ++i) { int R, C; stage_rc(tid * 16 + i * 8192, R, C); const int Rb = Epi::PERM ? ((R & ~31) + perm32(R & 31)) : R;
        voffA[i] = (unsigned)(R * K + C) * 2u; voffB[i] = (unsigned)(Rb * K + C) * 2u; }
    const size_t kstep = (size_t)(BK * 2);
    const size_t hstep = (size_t)HALF * K * 2;
    const size_t tstep = 2 * hstep;
    const unsigned ldsw = (unsigned)wid * 1024u;
    const int aoff = lds_byte(wr * 64 + fr, fq * 8), boff = lds_byte(wc * 32 + fr, fq * 8);
#define PG8_SA(b, h) (((b) * 2 + (h)) * HTB)
#define PG8_SB(b, h) ((4 + (b) * 2 + (h)) * HTB)
#define PG8_STAGE(bufoff, gbase, voff) do { _Pragma("unroll") for (int _i = 0; _i < 2; ++_i) \
        __builtin_amdgcn_global_load_lds((const unsigned*)((const char*)(gbase) + (voff)[_i]), (PG8_LAS unsigned*)(lds + (bufoff) + ldsw + _i * 8192), 16, 0, 0); } while (0)
#define PG8_LDA(dst, b, h) do { _Pragma("unroll") for (int m = 0; m < 4; ++m) _Pragma("unroll") for (int k = 0; k < 2; ++k) dst[m][k] = *(const PG8_LAS bf16x8*)(lds + PG8_SA(b, h) + aoff + m * 2048 + k * 1024); } while (0)
#define PG8_LDB(dst, b, h) do { _Pragma("unroll") for (int n = 0; n < 2; ++n) _Pragma("unroll") for (int k = 0; k < 2; ++k) dst[n][k] = *(const PG8_LAS bf16x8*)(lds + PG8_SB(b, h) + boff + n * 2048 + k * 1024); } while (0)
#define PG8_MMA(ai, bj, At, Bt) do { __builtin_amdgcn_s_setprio(1); _Pragma("unroll") for (int m = 0; m < 4; ++m) _Pragma("unroll") for (int n = 0; n < 2; ++n) _Pragma("unroll") for (int k = 0; k < 2; ++k) \
        { if constexpr (Epi::I8) acc[ai][bj][m][n] = __builtin_bit_cast(f32x4, __builtin_amdgcn_mfma_i32_16x16x64_i8(__builtin_bit_cast(i32x4, Bt[n][k]), __builtin_bit_cast(i32x4, At[m][k]), __builtin_bit_cast(i32x4, acc[ai][bj][m][n]), 0, 0, 0)); \
          else acc[ai][bj][m][n] = __builtin_amdgcn_mfma_f32_16x16x32_bf16(Bt[n][k], At[m][k], acc[ai][bj][m][n], 0, 0, 0); } __builtin_amdgcn_s_setprio(0); } while (0)
#define PG8_WAIT_V(n) asm volatile("s_waitcnt vmcnt(" #n ")" ::: "memory")
#define PG8_WAIT_L(n) asm volatile("s_waitcnt lgkmcnt(" #n ")" ::: "memory")
#define PG8_BAR __builtin_amdgcn_s_barrier()
#define PG8_SCHED __builtin_amdgcn_sched_barrier(0)
    Unit cur, nxt; int ui = 0;
    if (!S.next(0, cur)) return;
#ifdef PROBE_EPI
    unsigned long long pe_prev = __builtin_amdgcn_s_memrealtime();
#endif
    f32x4 acc[2][2][4][2];
#pragma unroll
    for (int a = 0; a < 2; ++a)
#pragma unroll
        for (int b = 0; b < 2; ++b)
#pragma unroll
            for (int m = 0; m < 4; ++m)
#pragma unroll
                for (int n = 0; n < 2; ++n) acc[a][b][m][n] = (f32x4){0.f, 0.f, 0.f, 0.f};
    bf16x8 At[4][2], B0[2][2], B1[2][2];
    const char* cA = (const char*)g.A + (size_t)cur.pm * tstep; const char* cB = (const char*)g.Bt + (size_t)cur.pn * tstep;
    S.a_ready(cur);
    if constexpr (SP2) {
        PG8_STAGE(PG8_SB(0, 0), cB, voffB); PG8_STAGE(PG8_SB(0, 1), cB + hstep, voffB); PG8_STAGE(PG8_SA(0, 0), cA, voffA); PG8_STAGE(PG8_SA(0, 1), cA + hstep, voffA);
        if (wr == 1) PG8_BAR;
        PG8_WAIT_V(2); PG8_BAR;
        PG8_STAGE(PG8_SB(1, 0), cB + kstep, voffB); PG8_STAGE(PG8_SA(1, 0), cA + kstep, voffA); PG8_STAGE(PG8_SB(1, 1), cB + hstep + kstep, voffB);
        PG8_WAIT_V(6); PG8_BAR;
    } else {
        PG8_STAGE(PG8_SB(0, 0), cB, voffB); PG8_STAGE(PG8_SA(0, 0), cA, voffA); PG8_STAGE(PG8_SB(0, 1), cB + hstep, voffB); PG8_STAGE(PG8_SA(0, 1), cA + hstep, voffA);
        if (wr == 1) PG8_BAR;
        PG8_WAIT_V(4); PG8_BAR;
        PG8_STAGE(PG8_SB(1, 0), cB + kstep, voffB); PG8_STAGE(PG8_SA(1, 0), cA + kstep, voffA); PG8_STAGE(PG8_SB(1, 1), cB + hstep + kstep, voffB);
        PG8_WAIT_V(6); PG8_BAR;
    }
#ifndef PG8_EARLY
#define PG8_EARLY PG8_STAGE(PG8_SA(1, 1), nA + kstep + hstep, voffA);
#endif
    int fresh = 0;
    for (;;) {
        const bool has_next = S.next(ui + 1, nxt);
        const char* nA = has_next ? (const char*)g.A + (size_t)nxt.pm * tstep : cA; const char* nB = has_next ? (const char*)g.Bt + (size_t)nxt.pn * tstep : cB;
        for (int t = 0; t < nt; t += 2) {
            const bool last = (t == nt - 2);
            const char* a1 = cA + (size_t)(t + 1) * kstep;
            const char* a2 = last ? nA : cA + (size_t)(t + 2) * kstep; const char* b2 = last ? nB : cB + (size_t)(t + 2) * kstep;
            const char* a3 = a2 + kstep; const char* b3 = b2 + kstep;
            if (last && has_next) S.a_ready(nxt);
            if constexpr (SP2) {
            int fresh_now = 0;
            if constexpr (Epi::NST != 0) { int tt = t; asm volatile("" : "+s"(tt)); fresh_now = (tt == 0) ? fresh : 0; }
#define PG8_WAIT_VF() do { static_assert(Epi::NST == 0 || Epi::NST == 14 || Epi::NST == 16, "NST"); \
        if constexpr (Epi::NST == 16) asm volatile("s_waitcnt vmcnt(26)\n\ts_cmp_lg_u32 %0, 0\n\ts_cbranch_scc1 .Lpg8f%=\n\ts_waitcnt vmcnt(8)\n.Lpg8f%=:" :: "s"(fresh_now) : "memory", "scc"); \
        else if constexpr (Epi::NST == 14) asm volatile("s_waitcnt vmcnt(24)\n\ts_cmp_lg_u32 %0, 0\n\ts_cbranch_scc1 .Lpg8g%=\n\ts_waitcnt vmcnt(8)\n.Lpg8g%=:" :: "s"(fresh_now) : "memory", "scc"); \
        else PG8_WAIT_V(8); } while (0)
            PG8_LDB(B0, 0, 0); PG8_LDB(B1, 0, 1); PG8_SCHED; PG8_LDA(At, 0, 0); PG8_STAGE(PG8_SA(1, 1), a1 + hstep, voffA);
            PG8_WAIT_VF(); PG8_WAIT_L(0); PG8_BAR; PG8_MMA(0, 0, At, B0); PG8_MMA(0, 1, At, B1); PG8_BAR; PG8_SCHED;
            PG8_LDA(At, 0, 1); PG8_STAGE(PG8_SB(0, 0), b2, voffB); PG8_STAGE(PG8_SB(0, 1), b2 + hstep, voffB); PG8_STAGE(PG8_SA(0, 0), a2, voffA);
            PG8_WAIT_VF(); PG8_WAIT_L(0); PG8_BAR; PG8_MMA(1, 0, At, B0); PG8_MMA(1, 1, At, B1); PG8_BAR; PG8_SCHED;
            PG8_LDB(B0, 1, 0); PG8_LDB(B1, 1, 1); PG8_SCHED; PG8_LDA(At, 1, 0); PG8_STAGE(PG8_SA(0, 1), a2 + hstep, voffA);
            PG8_WAIT_VF(); PG8_WAIT_L(0); PG8_BAR; PG8_MMA(0, 0, At, B0); PG8_MMA(0, 1, At, B1); PG8_BAR; PG8_SCHED;
            PG8_LDA(At, 1, 1); PG8_STAGE(PG8_SB(1, 0), b3, voffB); PG8_STAGE(PG8_SB(1, 1), b3 + hstep, voffB); PG8_STAGE(PG8_SA(1, 0), a3, voffA);
            PG8_WAIT_V(8); PG8_WAIT_L(0); PG8_BAR; PG8_MMA(1, 0, At, B0); PG8_MMA(1, 1, At, B1); PG8_BAR; PG8_SCHED;
#undef PG8_WAIT_VF
            } else {
            PG8_LDB(B0, 0, 0); PG8_SCHED; PG8_LDA(At, 0, 0); PG8_STAGE(PG8_SA(1, 1), a1 + hstep, voffA);
            PG8_WAIT_L(8); PG8_BAR; PG8_WAIT_L(0); PG8_MMA(0, 0, At, B0); PG8_BAR; PG8_SCHED;
            PG8_LDB(B1, 0, 1); PG8_STAGE(PG8_SB(0, 0), b2, voffB);
            PG8_BAR; PG8_WAIT_L(0); PG8_MMA(0, 1, At, B1); PG8_BAR;
            PG8_LDA(At, 0, 1); PG8_STAGE(PG8_SA(0, 0), a2, voffA);
            PG8_BAR; PG8_WAIT_L(0); PG8_MMA(1, 0, At, B0); PG8_BAR; PG8_SCHED;
            PG8_STAGE(PG8_SB(0, 1), b2 + hstep, voffB);
            PG8_WAIT_V(6); PG8_BAR; PG8_MMA(1, 1, At, B1); PG8_BAR;
            PG8_LDB(B0, 1, 0); PG8_SCHED; PG8_LDA(At, 1, 0); PG8_STAGE(PG8_SA(0, 1), a2 + hstep, voffA);
            PG8_WAIT_L(8); PG8_BAR; PG8_WAIT_L(0); PG8_MMA(0, 0, At, B0); PG8_BAR; PG8_SCHED;
            PG8_LDB(B1, 1, 1); PG8_STAGE(PG8_SB(1, 0), b3, voffB);
            PG8_BAR; PG8_WAIT_L(0); PG8_MMA(0, 1, At, B1); PG8_BAR;
            PG8_LDA(At, 1, 1); PG8_STAGE(PG8_SA(1, 0), a3, voffA);
            PG8_BAR; PG8_WAIT_L(0); PG8_MMA(1, 0, At, B0); PG8_BAR; PG8_SCHED;
            PG8_STAGE(PG8_SB(1, 1), b3 + hstep, voffB);
            PG8_WAIT_V(6); PG8_BAR; PG8_MMA(1, 1, At, B1); PG8_BAR;
            }
            if constexpr (Epi::HAS_MID) { if (t == Epi::MID_T) E.mid(acc, cur, wr, wc, fr, fq); }
        }
#ifdef PROBE_EPI
        const unsigned long long pe_t0 = __builtin_amdgcn_s_memrealtime();
#endif
        if constexpr (ALIGN_EPI) { if (wr == 0) PG8_BAR; }
        if constexpr (SP2 && ALIGN_EPI && Epi::NST != 0) { PG8_EARLY fresh = 1; }
        if constexpr (Epi::I8) {
#pragma unroll
            for (int a = 0; a < 2; ++a)
#pragma unroll
                for (int b = 0; b < 2; ++b)
#pragma unroll
                    for (int m = 0; m < 4; ++m)
#pragma unroll
                        for (int n = 0; n < 2; ++n) acc[a][b][m][n] = __builtin_convertvector(__builtin_bit_cast(i32x4, acc[a][b][m][n]), f32x4);
        }
        if constexpr (!Epi::AFTER_DRAIN) { E(acc, cur, wr, wc, fr, fq); S.done(cur); }
#ifdef PROBE_EPI
        if constexpr (Epi::PID == PROBE_EPI) { const unsigned long long now_ = __builtin_amdgcn_s_memrealtime();
            if (tid == 0) { volatile PG8_LAS unsigned long long* pa_ = (volatile PG8_LAS unsigned long long*)(lds + 143360 + 1024); pa_[0] += now_ - pe_t0; pa_[1] += now_ - pe_prev; }
            pe_prev = now_; }
#endif
        if (!has_next) break;
#pragma unroll
        for (int a = 0; a < 2; ++a)
#pragma unroll
            for (int b = 0; b < 2; ++b)
#pragma unroll
                for (int m = 0; m < 4; ++m)
#pragma unroll
                    for (int n = 0; n < 2; ++n) acc[a][b][m][n] = (f32x4){0.f, 0.f, 0.f, 0.f};
        cur = nxt; cA = nA; cB = nB; ++ui;
        if constexpr (ALIGN_EPI) { if (wr == 1) PG8_BAR; }
    }
    PG8_WAIT_V(0);
    if constexpr (!ALIGN_EPI) { if (wr == 0) PG8_BAR; }
    PG8_BAR;
    if constexpr (Epi::AFTER_DRAIN) { E.fused(acc, cur, wr, wc, fr, fq, lds, wid, lane); S.done(cur); }
#undef PG8_SA
#undef PG8_SB
#undef PG8_STAGE
#undef PG8_LDA
#undef PG8_LDB
#undef PG8_MMA
#undef PG8_WAIT_V
#undef PG8_WAIT_L
#undef PG8_BAR
#undef PG8_SCHED
}
}
namespace pg8 {
#define PG8_GAS __attribute__((address_space(1)))
#define ST16(p, v) (*(PG8_GAS u32x4*)(p) = (v))
constexpr int RSL_OFF = 131072 + 8192;
__device__ __forceinline__ const PG8_LAS float* rs_lds() { extern __shared__ __attribute__((aligned(16))) unsigned char lds_dyn_[]; return (const PG8_LAS float*)((PG8_LAS unsigned char*)lds_dyn_ + RSL_OFF); }
__device__ __forceinline__ void pair_swap(const u32x4 w0, const u32x4 w1, int odd, u32x4& dA, u32x4& dB) {
    const u32x4 snd = odd ? w0 : w1; u32x4 rcv;
    rcv.x = (unsigned)__builtin_amdgcn_update_dpp(0, (int)snd.x, 0xB1, 0xf, 0xf, false); rcv.y = (unsigned)__builtin_amdgcn_update_dpp(0, (int)snd.y, 0xB1, 0xf, 0xf, false);
    rcv.z = (unsigned)__builtin_amdgcn_update_dpp(0, (int)snd.z, 0xB1, 0xf, 0xf, false); rcv.w = (unsigned)__builtin_amdgcn_update_dpp(0, (int)snd.w, 0xB1, 0xf, 0xf, false);
    dA = odd ? rcv : w0; dB = odd ? w1 : rcv;
}
__device__ __forceinline__ float bfbits2f(unsigned b16) { return __uint_as_float(b16 << 16); }
__device__ __forceinline__ float sigmoidf_(float x) { return __builtin_amdgcn_rcpf(1.0f + __builtin_amdgcn_exp2f(x * -1.4426950408889634f)); }
struct EpiGateA {
    static constexpr bool PERM = true, AFTER_DRAIN = false, HAS_MID = false, I8 = false; static constexpr int MID_T = -1, NST = 0, PID = 0;
    bf16_t* O; int ldc; const bf16_t* gate; int ldg;
    __device__ __forceinline__ void operator()(const f32x4 (&acc)[2][2][4][2], const Unit& u, int wr, int wc, int fr, int fq) const {
        const int row0 = u.pm * BM + wr * 64 + fr, col0 = u.pn * BM + wc * 32 + 8 * fq;
#pragma unroll
        for (int ai = 0; ai < 2; ++ai)
#pragma unroll
            for (int m = 0; m < 4; ++m) { const size_t r = (size_t)(row0 + ai * HALF + m * 16);
#pragma unroll
                for (int bj = 0; bj < 2; ++bj) { const int c = col0 + bj * HALF;
                    const u32x4 gv = *(const PG8_GAS u32x4*)(gate + r * ldg + c);
                    const f32x4 v0 = acc[ai][bj][m][0], v1 = acc[ai][bj][m][1];
                    float o[8];
                    o[0] = v0[0] * sigmoidf_(bfbits2f(gv.x & 0xffffu)); o[1] = v0[1] * sigmoidf_(bfbits2f(gv.x >> 16));
                    o[2] = v0[2] * sigmoidf_(bfbits2f(gv.y & 0xffffu)); o[3] = v0[3] * sigmoidf_(bfbits2f(gv.y >> 16));
                    o[4] = v1[0] * sigmoidf_(bfbits2f(gv.z & 0xffffu)); o[5] = v1[1] * sigmoidf_(bfbits2f(gv.z >> 16));
                    o[6] = v1[2] * sigmoidf_(bfbits2f(gv.w & 0xffffu)); o[7] = v1[3] * sigmoidf_(bfbits2f(gv.w >> 16));
                    u32x4 w; w.x = cvt_pk_bf16(o[0], o[1]); w.y = cvt_pk_bf16(o[2], o[3]); w.z = cvt_pk_bf16(o[4], o[5]); w.w = cvt_pk_bf16(o[6], o[7]);
                    *(PG8_GAS u32x4*)(O + r * ldc + c) = w; }
                if (m == 3) asm volatile("" ::: "memory"); }
    }
};
struct EpiGateR {
    static constexpr bool PERM = true, AFTER_DRAIN = false, HAS_MID = false, I8 = false; static constexpr int MID_T = -1, NST = 0, PID = 0;
    bf16_t* O; int ldc; const bf16_t* gate; int ldg;
    __device__ __forceinline__ void operator()(const f32x4 (&acc)[2][2][4][2], const Unit& u, int wr, int wc, int fr, int fq) const {
        const int row0 = u.pm * BM + wr * 64 + fr, col0 = u.pn * BM + wc * 32 + 8 * fq;
#pragma unroll
        for (int ai = 0; ai < 2; ++ai)
#pragma unroll
            for (int m = 0; m < 4; ++m) { const size_t r = (size_t)(row0 + ai * HALF + m * 16);
#pragma unroll
                for (int bj = 0; bj < 2; ++bj) { const int c = col0 + bj * HALF;
                    const u32x4 gv = *(const PG8_GAS u32x4*)(gate + r * ldg + c);
                    const u32x4 tv = *(const PG8_GAS u32x4*)(O + r * ldc + c);
                    const f32x4 v0 = acc[ai][bj][m][0], v1 = acc[ai][bj][m][1];
                    float o[8];
                    o[0] = bfbits2f(tv.x & 0xffffu) + v0[0] * sigmoidf_(bfbits2f(gv.x & 0xffffu)); o[1] = bfbits2f(tv.x >> 16) + v0[1] * sigmoidf_(bfbits2f(gv.x >> 16));
                    o[2] = bfbits2f(tv.y & 0xffffu) + v0[2] * sigmoidf_(bfbits2f(gv.y & 0xffffu)); o[3] = bfbits2f(tv.y >> 16) + v0[3] * sigmoidf_(bfbits2f(gv.y >> 16));
                    o[4] = bfbits2f(tv.z & 0xffffu) + v1[0] * sigmoidf_(bfbits2f(gv.z & 0xffffu)); o[5] = bfbits2f(tv.z >> 16) + v1[1] * sigmoidf_(bfbits2f(gv.z >> 16));
                    o[6] = bfbits2f(tv.w & 0xffffu) + v1[2] * sigmoidf_(bfbits2f(gv.w & 0xffffu)); o[7] = bfbits2f(tv.w >> 16) + v1[3] * sigmoidf_(bfbits2f(gv.w >> 16));
                    u32x4 w; w.x = cvt_pk_bf16(o[0], o[1]); w.y = cvt_pk_bf16(o[2], o[3]); w.z = cvt_pk_bf16(o[4], o[5]); w.w = cvt_pk_bf16(o[6], o[7]);
                    *(PG8_GAS u32x4*)(O + r * ldc + c) = w; }
                if (m == 3) asm volatile("" ::: "memory"); }
    }
};
struct EpiF32 {
    static constexpr bool PERM = true, AFTER_DRAIN = false, HAS_MID = false, I8 = false; static constexpr int MID_T = -1, NST = 0, PID = 0;
    float* O; int ldc;
    __device__ __forceinline__ void operator()(const f32x4 (&acc)[2][2][4][2], const Unit& u, int wr, int wc, int fr, int fq) const {
        const int row0 = u.pm * BM + wr * 64 + fr, col0 = u.pn * BM + wc * 32 + 8 * fq;
#pragma unroll
        for (int ai = 0; ai < 2; ++ai)
#pragma unroll
            for (int m = 0; m < 4; ++m) { float* rowp = O + (size_t)(row0 + ai * HALF + m * 16) * ldc + col0;
#pragma unroll
                for (int bj = 0; bj < 2; ++bj) { *(PG8_GAS f32x4*)(rowp + bj * HALF) = acc[ai][bj][m][0]; *(PG8_GAS f32x4*)(rowp + bj * HALF + 4) = acc[ai][bj][m][1]; } }
    }
};

__device__ __forceinline__ float dpp_f(float v, int ctrl_sel) {
    const int iv = __builtin_bit_cast(int, v); int r;
    switch (ctrl_sel) { case 0: r = __builtin_amdgcn_update_dpp(0, iv, 0x111, 0xf, 0xf, true); break;
                        case 1: r = __builtin_amdgcn_update_dpp(0, iv, 0x112, 0xf, 0xf, true); break;
                        case 2: r = __builtin_amdgcn_update_dpp(0, iv, 0x10F, 0xf, 0xf, true); break;
                        default: r = __builtin_amdgcn_update_dpp(0, iv, 0x10E, 0xf, 0xf, true); break; }
    return __builtin_bit_cast(float, r);
}
__device__ __forceinline__ float gelu_tanh_f(float x) { const float u2 = 1.5957691216057308f * (x + 0.044715f * x * x * x); return x * __builtin_amdgcn_rcpf(1.0f + __expf(-u2)); }
struct EpiConv {
    static constexpr bool PERM = true, AFTER_DRAIN = false, HAS_MID = false, I8 = PG_I8_UP; static constexpr int MID_T = -1, NST = PG_NST ? 14 : 0  , PID = 1;
    bf16_t* G; bf16_t* H; const float* cw; const float* cb; int dff; const float* stat; float eps; int pmc;
    const float* qs; const unsigned* wsc;
    __device__ __forceinline__ void operator()(const f32x4 (&acc)[2][2][4][2], const Unit& u, int wr, int wc, int fr, int fq) const {
        const int colb = u.pn * HALF + wc * 32 + 8 * fq;
        float ts0 = 1.0f, ts1 = 1.0f;
        if constexpr (I8) { ts0 = __uint_as_float(((const PG8_GAS unsigned*)wsc)[u.pn * 8 + wc]) * (1.0f / 127.0f); ts1 = __uint_as_float(((const PG8_GAS unsigned*)wsc)[u.pn * 8 + 4 + wc]) * (1.0f / 127.0f); }
        f32x2 w02[4], w12[4], w22[4], wb2[4];
#pragma unroll
        for (int h = 0; h < 2; ++h) { const f32x4 a = *(const PG8_GAS f32x4*)(cw + colb + 4 * h), b = *(const PG8_GAS f32x4*)(cw + dff + colb + 4 * h), c = *(const PG8_GAS f32x4*)(cw + 2 * dff + colb + 4 * h), d = *(const PG8_GAS f32x4*)(cb + colb + 4 * h);
            w02[2 * h] = (f32x2){a[0], a[1]}; w02[2 * h + 1] = (f32x2){a[2], a[3]}; w12[2 * h] = (f32x2){b[0], b[1]}; w12[2 * h + 1] = (f32x2){b[2], b[3]};
            w22[2 * h] = (f32x2){c[0], c[1]}; w22[2 * h + 1] = (f32x2){c[2], c[3]}; wb2[2 * h] = (f32x2){d[0], d[1]}; wb2[2 * h + 1] = (f32x2){d[2], d[3]}; }
#pragma unroll
        for (int ai = 0; ai < 2; ++ai) {
            const int row64 = u.pm * BM + ai * HALF + wr * 64, grp = row64 >> 6;
            float rsc[4];
            {
                const int tb_ = (u.pm == pmc) ? 0 : 256;
#pragma unroll
                for (int m = 0; m < 4; ++m) rsc[m] = rs_lds()[tb_ + ((row64 + m * 16 + fr) & 255)];
            }
            float rsv[4];
#pragma unroll
            for (int m = 0; m < 4; ++m) { rsv[m] = rsc[m] * ts1; rsc[m] *= ts0; }
            if (fr >= 14) { const f32x4 v0 = acc[ai][0][3][0] * rsc[3], v1 = acc[ai][0][3][1] * rsc[3]; u32x4 w; w.x = cvt_pk_bf16(v0[0], v0[1]); w.y = cvt_pk_bf16(v0[2], v0[3]); w.z = cvt_pk_bf16(v1[0], v1[1]); w.w = cvt_pk_bf16(v1[2], v1[3]);
                *(PG8_GAS u32x4*)(H + (size_t)(grp * 6 + (fr - 14)) * dff + colb) = w; }
            if (fr < 2) { const f32x4 v0 = acc[ai][0][0][0] * rsc[0], v1 = acc[ai][0][0][1] * rsc[0], x0 = acc[ai][1][0][0] * rsv[0], x1 = acc[ai][1][0][1] * rsv[0]; u32x4 w, x;
                w.x = cvt_pk_bf16(v0[0], v0[1]); w.y = cvt_pk_bf16(v0[2], v0[3]); w.z = cvt_pk_bf16(v1[0], v1[1]); w.w = cvt_pk_bf16(v1[2], v1[3]);
                x.x = cvt_pk_bf16(x0[0], x0[1]); x.y = cvt_pk_bf16(x0[2], x0[3]); x.z = cvt_pk_bf16(x1[0], x1[1]); x.w = cvt_pk_bf16(x1[2], x1[3]);
                *(PG8_GAS u32x4*)(H + (size_t)(grp * 6 + 2 + fr) * dff + colb) = w; *(PG8_GAS u32x4*)(H + (size_t)(grp * 6 + 4 + fr) * dff + colb) = x; }
            f32x2 ap[4];
#pragma unroll
            for (int pr = 0; pr < 4; ++pr) ap[pr] = (f32x2){0.f, 0.f};
#pragma unroll
            for (int m = 0; m < 4; ++m) {
                f32x2 o2[4];
#pragma unroll
                for (int pr = 0; pr < 4; ++pr) { const int n = pr >> 1, i = (pr & 1) * 2;
                    const f32x2 a2 = (f32x2){acc[ai][0][m][n][i], acc[ai][0][m][n][i + 1]} * rsc[m];
                    const f32x2 v2 = (f32x2){acc[ai][1][m][n][i], acc[ai][1][m][n][i + 1]} * rsv[m];
                    f32x2 p1 = (f32x2){dpp_f(a2.x, 0), dpp_f(a2.y, 0)}, p2 = (f32x2){dpp_f(a2.x, 1), dpp_f(a2.y, 1)};
                    if (m > 0) { p1 += (f32x2){dpp_f(ap[pr].x, 2), dpp_f(ap[pr].y, 2)}; p2 += (f32x2){dpp_f(ap[pr].x, 3), dpp_f(ap[pr].y, 3)}; }
                    ap[pr] = a2;
                    const f32x2 ac = wb2[pr] + w02[pr] * p2 + w12[pr] * p1 + w22[pr] * a2;
                    const f32x2 u2 = (ac + (ac * ac) * ac * 0.044715f) * (-1.5957691216057308f * 1.4426950408889634f);
                    f32x2 e; e.x = __builtin_amdgcn_exp2f(u2.x); e.y = __builtin_amdgcn_exp2f(u2.y);
                    const f32x2 d = e + 1.0f; f32x2 r; r.x = __builtin_amdgcn_rcpf(d.x); r.y = __builtin_amdgcn_rcpf(d.y);
                    o2[pr] = (ac * r) * v2; }
                u32x4 w; w.x = cvt_pk_bf16(o2[0].x, o2[0].y); w.y = cvt_pk_bf16(o2[1].x, o2[1].y); w.z = cvt_pk_bf16(o2[2].x, o2[2].y); w.w = cvt_pk_bf16(o2[3].x, o2[3].y);
                *(PG8_GAS u32x4*)(G + (size_t)(row64 + m * 16 + fr) * dff + colb) = w;
            }
        }
    }
};

struct PanelRms {
    unsigned* xbuf;
    unsigned* cnt;
    unsigned* tmo;
    float eps; unsigned code;
    const float* amx_in;
    float* qs_out;
    template <bool quant> __device__ __forceinline__ bool run(const f32x4 (&v)[2][2][4][2], const f32x4 (&gv)[2][2], const Unit& u, int wr, int wc, int fr, int fq, PG8_LAS unsigned char* lds, int wid, int lane) const {
        PG8_LAS float* P = (PG8_LAS float*)lds;
        PG8_LAS float* PX = (PG8_LAS float*)(lds + 4096);
        PG8_LAS float* S = (PG8_LAS float*)(lds + 8192);
        PG8_LAS float* S2 = (PG8_LAS float*)(lds + 9216);
        PG8_LAS unsigned* flag = (PG8_LAS unsigned*)(lds + 8192 + 2048);
        const int row = wid * 32 + (lane & 31);
        f32x4 ao = (f32x4){0.f, 0.f, 0.f, 0.f};
        if (quant && lane < 32) ao = *(const PG8_GAS f32x4*)(amx_in + (size_t)(u.pm * BM + row) * 4);
#pragma unroll
        for (int ai = 0; ai < 2; ++ai)
#pragma unroll
            for (int m = 0; m < 4; ++m) {
                float s = 0.f, mx = 0.f;
#pragma unroll
                for (int bj = 0; bj < 2; ++bj)
#pragma unroll
                    for (int n = 0; n < 2; ++n) { const f32x4 x = v[ai][bj][m][n]; s += (x[0] * x[0] + x[1] * x[1]) + (x[2] * x[2] + x[3] * x[3]);
                        if (quant) { const f32x4 y = x * gv[bj][n]; mx = fmaxf(mx, fmaxf(fmaxf(fabsf(y[0]), fabsf(y[1])), fmaxf(fabsf(y[2]), fabsf(y[3])))); } }
                s += __shfl_xor(s, 16); s += __shfl_xor(s, 32);
                if (quant) { mx = fmaxf(mx, __shfl_xor(mx, 16)); mx = fmaxf(mx, __shfl_xor(mx, 32)); }
                if (fq == 0) { P[(ai * HALF + wr * 64 + m * 16 + fr) * 4 + wc] = s; if (quant) PX[(ai * HALF + wr * 64 + m * 16 + fr) * 4 + wc] = mx; }
            }
        asm volatile("s_waitcnt lgkmcnt(0)" ::: "memory"); __builtin_amdgcn_s_barrier(); asm volatile("" ::: "memory");
        if (lane < 32) {
            const float t = (P[row * 4 + 0] + P[row * 4 + 1]) + (P[row * 4 + 2] + P[row * 4 + 3]);
            const float tm = quant ? fmaxf(fmaxf(PX[row * 4 + 0], PX[row * 4 + 1]), fmaxf(PX[row * 4 + 2], PX[row * 4 + 3])) : 0.f;
            __hip_atomic_store((PG8_GAS unsigned long long*)(xbuf + ((size_t)(u.pm * BM + row) * 4 + u.pn) * 2), ((unsigned long long)__float_as_uint(tm) << 32) | (unsigned long long)__float_as_uint(t), __ATOMIC_RELAXED, __HIP_MEMORY_SCOPE_AGENT);
        }
        asm volatile("s_waitcnt vmcnt(0)" ::: "memory");
        if (lane == 0) __hip_atomic_fetch_add((PG8_GAS unsigned*)cnt + 64 * u.pm, 1u, __ATOMIC_RELAXED, __HIP_MEMORY_SCOPE_AGENT);
        if (wid == 0) {
            bool dead = false; const unsigned want = 8u * 4u;
            for (unsigned spins = 0;; ++spins) {
                if ((unsigned)__builtin_amdgcn_readfirstlane(__hip_atomic_load((const PG8_GAS unsigned*)cnt + 64 * u.pm, __ATOMIC_RELAXED, __HIP_MEMORY_SCOPE_AGENT)) >= want) break;
                if (spins > (1u << 20)) {
                    if (lane == 0) { unsigned expect = 0u; __hip_atomic_compare_exchange_strong(tmo + 1, &expect, code | (unsigned)(u.pm & 0xff), __ATOMIC_RELAXED, __ATOMIC_RELAXED, __HIP_MEMORY_SCOPE_AGENT);
                                     __hip_atomic_store(tmo, 1u, __ATOMIC_RELAXED, __HIP_MEMORY_SCOPE_AGENT); }
                    dead = true; break; }
                __builtin_amdgcn_s_sleep(2);
            }
            __builtin_amdgcn_fence(__ATOMIC_ACQUIRE, "agent");
            if (lane == 0) flag[0] = dead ? 1u : 0u;
        }
        asm volatile("s_waitcnt vmcnt(0) lgkmcnt(0)" ::: "memory"); __builtin_amdgcn_s_barrier(); asm volatile("" ::: "memory");
        const bool bad = flag[0] != 0u;
        if (lane < 32) {
            const PG8_GAS unsigned long long* slot = (const PG8_GAS unsigned long long*)(xbuf + (size_t)(u.pm * BM + row) * 8); float q = 0.f; f32x4 bm;
#pragma unroll
            for (int t = 0; t < 4; ++t) { const unsigned long long w = __hip_atomic_load(slot + t, __ATOMIC_RELAXED, __HIP_MEMORY_SCOPE_AGENT); q += __uint_as_float((unsigned)w); bm[t] = __uint_as_float((unsigned)(w >> 32)); }
            const float rinv = __builtin_amdgcn_rsqf(q * (1.0f / 1024.0f) + eps);
            S[row] = rinv;
            if (quant) { const f32x4 bt = ao + bm * rinv;
                const float B = fmaxf(fmaxf(bt[0], bt[1]), fmaxf(bt[2], bt[3])) * 1.004f + 1e-20f;
                S2[row] = 127.0f * __builtin_amdgcn_rcpf(B); if (u.pn == 0) ((PG8_GAS float*)qs_out)[u.pm * BM + row] = B * (1.0f / 127.0f); }
        }
        asm volatile("s_waitcnt lgkmcnt(0)" ::: "memory"); __builtin_amdgcn_s_barrier(); asm volatile("" ::: "memory");
        return bad;
    }
};
__device__ __forceinline__ unsigned pack_i8x4(const f32x4 q) {
    return __builtin_amdgcn_perm(__float_as_uint(q[1]), __float_as_uint(q[0]), 0x0c0c0400u) | __builtin_amdgcn_perm(__float_as_uint(q[3]), __float_as_uint(q[2]), 0x04000c0cu);
}
__device__ __forceinline__ float amax4(const f32x4 a) { return fmaxf(fmaxf(fabsf(a[0]), fabsf(a[1])), fmaxf(fabsf(a[2]), fabsf(a[3]))); }
template <bool QUANT  > struct EpiRmsRes {
    static constexpr bool PERM = true, AFTER_DRAIN = true, HAS_MID = false, I8 = false; static constexpr int MID_T = -1, NST = 0, PID = 0;
    bf16_t* xb; float* outf; int ldc; const float* g1; float* stat; signed char* xq; float* amx; PanelRms st;
    __device__ __forceinline__ void fused(f32x4 (&acc)[2][2][4][2], const Unit& u, int wr, int wc, int fr, int fq, PG8_LAS unsigned char* lds, int wid, int lane) const {
        const PG8_LAS float* S = (const PG8_LAS float*)(lds + 8192);
        const PG8_LAS float* S2 = (const PG8_LAS float*)(lds + 9216);
        PG8_LAS float* P = (PG8_LAS float*)lds;
        PG8_LAS float* PX = (PG8_LAS float*)(lds + 4096);
        const int col0 = u.pn * BM + wc * 64 + 8 * fq, odd = fr & 1;
        u32x4 pre[2][4][2];
#pragma unroll
        for (int ai = 0; ai < 2; ++ai)
#pragma unroll
            for (int m = 0; m < 4; ++m) { const size_t off = (size_t)(u.pm * BM + ai * HALF + wr * 64 + m * 16 + fr) * ldc + col0;
#pragma unroll
                for (int bj = 0; bj < 2; ++bj) pre[ai][m][bj] = *(const PG8_GAS u32x4*)(xb + off + bj * 32); }
        f32x4 gv[2][2];
#pragma unroll
        for (int bj = 0; bj < 2; ++bj)
#pragma unroll
            for (int n = 0; n < 2; ++n) gv[bj][n] = *(const PG8_GAS f32x4*)(g1 + col0 + bj * 32 + 4 * n);
        (void)st.template run<QUANT>(acc, gv, u, wr, wc, fr, fq, lds, wid, lane);
#pragma unroll
        for (int ai = 0; ai < 2; ++ai)
#pragma unroll
            for (int m = 0; m < 4; ++m) { const int r = ai * HALF + wr * 64 + m * 16 + fr; const float sr = S[r]; const size_t off = (size_t)(u.pm * BM + r) * ldc + col0;
                const float s2r = QUANT ? S2[r] : 0.f;
                float ps = 0.f, pmx = 0.f; u32x4 w[2];
#pragma unroll
                for (int bj = 0; bj < 2; ++bj) { const u32x4 pb = pre[ai][m][bj];
                    const f32x4 b0 = (f32x4){bfbits2f(pb.x & 0xffffu), bfbits2f(pb.x >> 16), bfbits2f(pb.y & 0xffffu), bfbits2f(pb.y >> 16)};
                    const f32x4 b1 = (f32x4){bfbits2f(pb.z & 0xffffu), bfbits2f(pb.z >> 16), bfbits2f(pb.w & 0xffffu), bfbits2f(pb.w >> 16)};
                    const f32x4 o0 = b0 + acc[ai][bj][m][0] * sr * gv[bj][0], o1 = b1 + acc[ai][bj][m][1] * sr * gv[bj][1];
                    if (outf) { *(PG8_GAS f32x4*)(outf + off + bj * 32) = o0; *(PG8_GAS f32x4*)(outf + off + bj * 32 + 4) = o1; }
                    else { w[bj].x = cvt_pk_bf16(o0[0], o0[1]); w[bj].y = cvt_pk_bf16(o0[2], o0[3]); w[bj].z = cvt_pk_bf16(o1[0], o1[1]); w[bj].w = cvt_pk_bf16(o1[2], o1[3]);
                        ps += ((o0[0] * o0[0] + o0[1] * o0[1]) + (o0[2] * o0[2] + o0[3] * o0[3])) + ((o1[0] * o1[0] + o1[1] * o1[1]) + (o1[2] * o1[2] + o1[3] * o1[3]));
                        pmx = fmaxf(pmx, fmaxf(amax4(o0), amax4(o1)));
                        if constexpr (QUANT) { u32x2 qw; qw.x = pack_i8x4(o0 * s2r + 12582912.0f); qw.y = pack_i8x4(o1 * s2r + 12582912.0f);
                            *(PG8_GAS u32x2*)(xq + off + bj * 32) = qw; } } }
                if (!outf) { u32x4 dA, dB; pair_swap(w[0], w[1], odd, dA, dB);
                    bf16_t* pA = xb + (size_t)(u.pm * BM + r - odd) * ldc + col0 + 32 * odd; *(PG8_GAS u32x4*)pA = dA; *(PG8_GAS u32x4*)(pA + ldc) = dB; }
                if (!outf) { ps += __shfl_xor(ps, 16); ps += __shfl_xor(ps, 32); pmx = fmaxf(pmx, __shfl_xor(pmx, 16)); pmx = fmaxf(pmx, __shfl_xor(pmx, 32)); if (fq == 0) { P[r * 4 + wc] = ps; PX[r * 4 + wc] = pmx; } } }
        if (!outf) {
            asm volatile("s_waitcnt lgkmcnt(0)" ::: "memory"); __builtin_amdgcn_s_barrier(); asm volatile("" ::: "memory");
            const int row = wid * 32 + (lane & 31);
            if (lane < 32) { ((PG8_GAS float*)stat)[(size_t)(u.pm * BM + row) * 4 + u.pn] = (P[row * 4 + 0] + P[row * 4 + 1]) + (P[row * 4 + 2] + P[row * 4 + 3]);
                ((PG8_GAS float*)amx)[(size_t)(u.pm * BM + row) * 4 + u.pn] = fmaxf(fmaxf(PX[row * 4 + 0], PX[row * 4 + 1]), fmaxf(PX[row * 4 + 2], PX[row * 4 + 3])); }
        }
    }
};
template <bool I8E, int THR, int OFF_HI, int TB> struct EpiBf16Rs {
    static constexpr bool PERM = true, AFTER_DRAIN = false, HAS_MID = false, I8 = I8E; static constexpr int MID_T = -1, NST = PG_NST, PID = I8E ? 2 : 3;
    bf16_t* O; int ldc; const float* costab; const float* sintab; const unsigned* wsc;
    __device__ __forceinline__ void operator()(const f32x4 (&acc)[2][2][4][2], const Unit& u, int wr, int wc, int fr, int fq) const {
        const int pn = u.pn + (u.pn >= THR ? OFF_HI : 0);
        const int row0 = u.pm * BM + wr * 64 + fr, col0 = pn * BM + wc * 32 + 8 * fq;
        float ts[2] = {1.0f, 1.0f};
        if constexpr (I8) { ts[0] = __uint_as_float(((const PG8_GAS unsigned*)wsc)[u.pn * 8 + wc]) * (1.0f / 127.0f); ts[1] = __uint_as_float(((const PG8_GAS unsigned*)wsc)[u.pn * 8 + 4 + wc]) * (1.0f / 127.0f); }
        const bool rot = !I8E && (pn >= 3) && (pn <= 6);
        float sc[2][4];
        {
#pragma unroll
            for (int ai = 0; ai < 2; ++ai)
#pragma unroll
                for (int m = 0; m < 4; ++m) sc[ai][m] = rs_lds()[TB + ((row0 + ai * HALF + m * 16) & 255)];
        }
        if (!rot) {
            const int odd = fr & 1; const int colL = pn * BM + wc * 64 + 32 * odd + 8 * fq;
#pragma unroll
            for (int ai = 0; ai < 2; ++ai)
#pragma unroll
                for (int m = 0; m < 4; ++m) { const int rr = row0 + ai * HALF + m * 16;
                    u32x4 w[2];
#pragma unroll
                    for (int bj = 0; bj < 2; ++bj) { const float sb = sc[ai][m] * ts[bj]; const f32x4 v0 = acc[ai][bj][m][0] * sb, v1 = acc[ai][bj][m][1] * sb;
                        w[bj].x = cvt_pk_bf16(v0[0], v0[1]); w[bj].y = cvt_pk_bf16(v0[2], v0[3]); w[bj].z = cvt_pk_bf16(v1[0], v1[1]); w[bj].w = cvt_pk_bf16(v1[2], v1[3]); }
                    const u32x4 snd = odd ? w[0] : w[1];
                    u32x4 rcv;
                    rcv.x = (unsigned)__builtin_amdgcn_update_dpp(0, (int)snd.x, 0xB1, 0xf, 0xf, false); rcv.y = (unsigned)__builtin_amdgcn_update_dpp(0, (int)snd.y, 0xB1, 0xf, 0xf, false);
                    rcv.z = (unsigned)__builtin_amdgcn_update_dpp(0, (int)snd.z, 0xB1, 0xf, 0xf, false); rcv.w = (unsigned)__builtin_amdgcn_update_dpp(0, (int)snd.w, 0xB1, 0xf, 0xf, false);
                    const u32x4 dA = odd ? rcv : w[0], dB = odd ? w[1] : rcv;
                    bf16_t* pA = O + (size_t)(rr - odd) * ldc + colL; bf16_t* pB = O + (size_t)(rr - odd + 1) * ldc + colL;
                    ST16(pA, dA); ST16(pB, dB); }
        } else {
            const bool isk = pn >= 5; const int hb = 2 * ((pn - 3) & 1);
            float lgs[2];
#pragma unroll
            for (int bj = 0; bj < 2; ++bj) { const float lg2 = LOG2_GAMMA_OF(hb + bj); lgs[bj] = isk ? -lg2 : lg2; }
            const float kmul = isk ? 0.08838834764831845f : 1.0f;
#pragma unroll
            for (int ai = 0; ai < 2; ++ai)
#pragma unroll
                for (int m = 0; m < 4; ++m) { const int ri = row0 + ai * HALF + m * 16; bf16_t* rowp = O + (size_t)ri * ldc + col0;
                    const int toff = (ri & 4095) * 64 + 4 * (4 * wc + fq); const f32x4 cs = *(const PG8_GAS f32x4*)(costab + toff), sn = *(const PG8_GAS f32x4*)(sintab + toff);
                    const float cpos = (float)(ri & 127);
#pragma unroll
                    for (int bj = 0; bj < 2; ++bj) { const float scl = sc[ai][m] * (kmul * ts[bj]) * __builtin_amdgcn_exp2f(lgs[bj] * cpos);
                        const f32x4 x1 = acc[ai][bj][m][0], x2 = acc[ai][bj][m][1];
                        const f32x4 v0 = (x1 * cs - x2 * sn) * scl, v1 = (x1 * sn + x2 * cs) * scl;
                        u32x4 w; w.x = cvt_pk_bf16(v0[0], v0[1]); w.y = cvt_pk_bf16(v0[2], v0[3]); w.z = cvt_pk_bf16(v1[0], v1[1]); w.w = cvt_pk_bf16(v1[2], v1[3]);
                        ST16(rowp + bj * HALF, w); } }
        }
    }
};
struct EpiNull {
    static constexpr bool PERM = true, AFTER_DRAIN = false, HAS_MID = false, I8 = false; static constexpr int MID_T = -1, NST = 0, PID = 0;
    float* sink;
    __device__ __forceinline__ void operator()(const f32x4 (&acc)[2][2][4][2], const Unit& u, int wr, int wc, int fr, int fq) const {
        f32x4 t = acc[0][0][0][0];
#pragma unroll
        for (int ai = 0; ai < 2; ++ai)
#pragma unroll
            for (int bj = 0; bj < 2; ++bj)
#pragma unroll
                for (int m = 0; m < 4; ++m)
#pragma unroll
                    for (int n = 0; n < 2; ++n) t += acc[ai][bj][m][n];
        if (t[0] + t[1] + t[2] + t[3] == 123456.789f) sink[0] = t[0];
    }
};

struct EpiGate2 {
    static constexpr bool PERM = true, AFTER_DRAIN = false, HAS_MID = true, I8 = false; static constexpr int MID_T = 6, NST = 0, PID = 0;
    bf16_t* O; int ldc; const bf16_t* ga; const bf16_t* gr; int ldg;
    static __device__ __forceinline__ f32x2 expneg2(unsigned w) { const f32x2 x = (f32x2){bfbits2f(w & 0xffffu), __uint_as_float(w & 0xffff0000u)} * -1.4426950408889634f; f32x2 e; e.x = __builtin_amdgcn_exp2f(x.x); e.y = __builtin_amdgcn_exp2f(x.y); return e; }
    static __device__ __forceinline__ f32x2 rcp2(f32x2 d) { f32x2 r; r.x = __builtin_amdgcn_rcpf(d.x); r.y = __builtin_amdgcn_rcpf(d.y); return r; }
    __device__ __forceinline__ void mid(f32x4 (&acc)[2][2][4][2], const Unit& u, int wr, int wc, int fr, int fq) const {
        int fro = fr; asm volatile("" : "+v"(fro));
        const int row0 = u.pm * BM + wr * 64 + fro, col0 = u.pn * BM + wc * 64 + 8 * fq;
#pragma unroll
        for (int ai = 0; ai < 2; ++ai)
#pragma unroll
            for (int m = 0; m < 4; ++m) { const size_t r = (size_t)(row0 + ai * HALF + m * 16);
#pragma unroll
                for (int bj = 0; bj < 2; ++bj) { const int c = col0 + bj * 32;
                    const u32x4 a = *(const PG8_GAS u32x4*)(ga + r * ldg + c), g = *(const PG8_GAS u32x4*)(gr + r * ldg + c);
                    const unsigned aw[4] = {a.x, a.y, a.z, a.w}, gw_[4] = {g.x, g.y, g.z, g.w};
                    f32x2 rho[4];
#pragma unroll
                    for (int k = 0; k < 4; ++k) rho[k] = (expneg2(gw_[k]) + 1.0f) * rcp2(expneg2(aw[k]) + 1.0f);
                    acc[ai][bj][m][0] = acc[ai][bj][m][0] * (f32x4){rho[0].x, rho[0].y, rho[1].x, rho[1].y};
                    acc[ai][bj][m][1] = acc[ai][bj][m][1] * (f32x4){rho[2].x, rho[2].y, rho[3].x, rho[3].y}; }
                if (m & 1) asm volatile("" ::: "memory"); }
    }
    __device__ __forceinline__ void operator()(const f32x4 (&acc)[2][2][4][2], const Unit& u, int wr, int wc, int fr, int fq) const {
        const int row0 = u.pm * BM + wr * 64 + fr, col0 = u.pn * BM + wc * 64 + 8 * fq, odd = fr & 1;
#pragma unroll
        for (int ai = 0; ai < 2; ++ai)
#pragma unroll
            for (int m = 0; m < 4; ++m) { const size_t r = (size_t)(row0 + ai * HALF + m * 16);
                u32x4 w[2];
#pragma unroll
                for (int bj = 0; bj < 2; ++bj) { const int c = col0 + bj * 32;
                    const u32x4 gv = *(const PG8_GAS u32x4*)(gr + r * ldg + c);
                    const f32x4 v0 = acc[ai][bj][m][0], v1 = acc[ai][bj][m][1];
                    const f32x2 s0 = rcp2(expneg2(gv.x) + 1.0f), s1 = rcp2(expneg2(gv.y) + 1.0f), s2 = rcp2(expneg2(gv.z) + 1.0f), s3 = rcp2(expneg2(gv.w) + 1.0f);
                    const f32x2 o0 = (f32x2){v0[0], v0[1]} * s0, o1 = (f32x2){v0[2], v0[3]} * s1, o2 = (f32x2){v1[0], v1[1]} * s2, o3 = (f32x2){v1[2], v1[3]} * s3;
                    w[bj].x = cvt_pk_bf16(o0.x, o0.y); w[bj].y = cvt_pk_bf16(o1.x, o1.y); w[bj].z = cvt_pk_bf16(o2.x, o2.y); w[bj].w = cvt_pk_bf16(o3.x, o3.y); }
                u32x4 dA, dB; pair_swap(w[0], w[1], odd, dA, dB);
                bf16_t* pA = O + (r - odd) * ldc + col0 + 32 * odd;
                *(PG8_GAS u32x4*)pA = dA; *(PG8_GAS u32x4*)(pA + ldc) = dB;
                if (m == 3) asm volatile("" ::: "memory"); }
    }
};
}

constexpr int NWAVES = 8;
constexpr int D = 1024, BATCH = 8, SEQ = 4096, DEPTH = 4;
constexpr int M = BATCH * SEQ, MH = M / 2;
constexpr int DIN = 5888, DFF = 2816, NUP = 2 * DFF;
constexpr int C_QA = 0, C_KA = 512, C_VA = 640, C_QR = 768, C_KR = 1280, C_VR = 1792, C_GR = 2816, C_GA = 3840, C_GT = 4864;
constexpr float EPS = 1e-6f;
#ifndef MK_ONE_LAUNCH
#define MK_ONE_LAUNCH 0
#endif
constexpr int PH_PER = 15;
constexpr int N_PHASES = 1 + DEPTH * PH_PER;

constexpr size_t MiB = 1u << 20;
constexpr size_t WS_CTL = 0, CTL_ZERO_BYTES = 1 * MiB;
constexpr size_t WS_BIAS = 1 * MiB;
constexpr size_t WS_AMX = 5 * MiB;
constexpr size_t WS_COS = 2 * MiB, WS_SIN = 3 * MiB;
constexpr size_t WS_STAT = 4 * MiB;
constexpr size_t WS_W = 6 * MiB;
constexpr size_t W_IN = 0, W_OA = W_IN + (size_t)DIN * D, W_OR = W_OA + (size_t)D * 512, W_O = W_OR + (size_t)D * D, W_UP = W_O + (size_t)D * D, W_DN = W_UP + (size_t)NUP * D, W_LAYER = W_DN + (size_t)D * DFF;
static_assert(W_LAYER * 2 == 33 * MiB, "weights per layer");
constexpr size_t W_IN8 = W_UP + (size_t)NUP * D / 2;
constexpr size_t WS_RA = WS_W + 4 * 33 * MiB;
constexpr size_t WS_RB = WS_RA + 184 * MiB;
constexpr size_t WS_XN = WS_RB;
constexpr size_t WS_XN1 = WS_XN + 32 * MiB;
constexpr size_t WS_AOA = WS_XN1 + 32 * MiB;
constexpr size_t WS_AOR = WS_AOA + 16 * MiB;
constexpr size_t WS_KV = WS_AOA + 48 * MiB;
constexpr size_t WS_MG = WS_KV;
constexpr size_t WS_G = WS_RA;
constexpr size_t WS_H = WS_AOA;
constexpr size_t WS_XQ = WS_KV + 32 * MiB;
constexpr size_t WS_XSLOT = WS_XQ + 32 * MiB;
constexpr size_t WS_QS = WS_XSLOT + 1 * MiB;
constexpr size_t WS_END = WS_QS + 1 * MiB;
static_assert((size_t)MH * DIN * 2 == 184 * MiB && (size_t)M * DFF * 2 <= 184 * MiB && (size_t)(M / 64) * 6 * DFF * 2 <= 48 * MiB && WS_END <= 512 * MiB, "ws map");
constexpr int CW_WAMAX = 131072;
constexpr int CW_BAR = 4096, CW_SEAM = 16384;

constexpr int RING_BYTES = 131072;
constexpr int LDS_BYTES = 147456;
constexpr int MISC_OFF = 143360;

#define GAS __attribute__((address_space(1)))
#define LAS __attribute__((address_space(3)))
typedef unsigned short bf16;
typedef unsigned v4u __attribute__((ext_vector_type(4)));
typedef float f32x4 __attribute__((ext_vector_type(4)));
typedef short bf16x8 __attribute__((ext_vector_type(8)));
typedef GAS unsigned gu32;
typedef GAS unsigned long long gu64;
#define RLX_AGENT __ATOMIC_RELAXED, __HIP_MEMORY_SCOPE_AGENT
#define LDS_WAIT() asm volatile("s_waitcnt lgkmcnt(0)" ::: "memory")
#define VM_WAIT() asm volatile("s_waitcnt vmcnt(0)" ::: "memory")
__device__ __forceinline__ unsigned long long rt() { return __builtin_amdgcn_s_memrealtime(); }
__device__ __forceinline__ unsigned f2bf(float f) { unsigned u = __builtin_bit_cast(unsigned, f); return (u + 0x7fffu + ((u >> 16) & 1u)) >> 16; }
typedef float pk2_f32x2_t __attribute__((ext_vector_type(2))); typedef __bf16 pk2_bf16x2_t __attribute__((ext_vector_type(2)));
__device__ __forceinline__ unsigned pk2(float lo, float hi) { const pk2_f32x2_t v = {lo, hi}; return __builtin_bit_cast(unsigned, __builtin_convertvector(v, pk2_bf16x2_t)); }

#define XB_TMO      128
#define XB_XCNT(j)  (256  + 64 * (j))
#define XB_XSUB(j)  (1280 + 64 * (j))
#define XB_XGEN(j)  (2304 + 64 * (j))
#define XB_TOP      3328
#define XB_TOPGEN   3392
#define XCD_BAR_WORDS 3456
#define XB_SPIN_CAP (1u << 18)

__device__ __forceinline__ unsigned xb_ld(unsigned* p)              { return __hip_atomic_load(p, __ATOMIC_RELAXED, __HIP_MEMORY_SCOPE_AGENT); }
__device__ __forceinline__ unsigned xb_add(unsigned* p, unsigned v) { return __hip_atomic_fetch_add(p, v, __ATOMIC_RELAXED, __HIP_MEMORY_SCOPE_AGENT); }
__device__ __forceinline__ unsigned xb_xcc_id() { return (unsigned)__builtin_amdgcn_s_getreg((3 << 11) | 20) & 0xFu; }
#define XB_SPIN(cond, bar) do { unsigned _sp = 0; while (cond) { __builtin_amdgcn_s_sleep(1); \
    if ((++_sp & 255u) == 0u) { if (xb_ld(&(bar)[XB_TMO])) break; if (_sp > XB_SPIN_CAP) { atomicAdd(&(bar)[XB_TMO], 1u); break; } } } } while (0)

struct XcdBarrier {
    unsigned* bar; unsigned x;
    volatile LAS unsigned* st;
};

__device__ __forceinline__ XcdBarrier xcd_barrier_post(unsigned* bar, volatile LAS unsigned* st) {
    XcdBarrier b; b.bar = bar; b.x = xb_xcc_id(); b.st = st;
    if (threadIdx.x == 0) (void)xb_add(&bar[XB_XCNT(b.x)], 1u);
    return b;
}
__device__ __forceinline__ void xcd_barrier_complete(unsigned* bar, unsigned x, unsigned& nloc, unsigned& nx) {
    const unsigned G = gridDim.x * gridDim.y * gridDim.z;
    unsigned sum, cnt, mine, sp = 0u;
    for (;;) {
        sum = 0u; cnt = 0u; mine = 0u;
#pragma unroll
        for (unsigned j = 0; j < 16; ++j) { const unsigned c = xb_ld(&bar[XB_XCNT(j)]); sum += c; cnt += (c > 0u) ? 1u : 0u; mine = (j == x) ? c : mine; }
        if (sum == G) break;
        __builtin_amdgcn_s_sleep(1);
        if ((++sp & 255u) == 0u) { if (xb_ld(&bar[XB_TMO])) break; if (sp > XB_SPIN_CAP) { atomicAdd(&bar[XB_TMO], 1u); break; } }
    }
    nloc = mine > 0u ? mine : 1u; nx = cnt > 0u ? cnt : 1u;
}

__device__ __forceinline__ void xcd_barrier(const XcdBarrier& b) {
    asm volatile("s_waitcnt vmcnt(0)" ::: "memory");
    __syncthreads();
    int tid0_ = threadIdx.x; asm volatile("" : "+v"(tid0_));
    if (tid0_ == 0) {
        unsigned* bar = b.bar;
        __builtin_amdgcn_s_waitcnt(0);
        unsigned nloc = b.st[0], nx = b.st[1];
        if (nloc == 0u) { xcd_barrier_complete(bar, b.x, nloc, nx); b.st[0] = nloc; b.st[1] = nx; }
        const unsigned old = xb_add(&bar[XB_XSUB(b.x)], 1u);
        const unsigned gen = old / nloc;
        if (old + 1u == (gen + 1u) * nloc) {
            __builtin_amdgcn_fence(__ATOMIC_RELEASE, "agent");
            asm volatile("s_waitcnt vmcnt(0)" ::: "memory");
            const unsigned og = xb_add(&bar[XB_TOP], 1u);
            const unsigned tg = og / nx;
            if (og + 1u == (tg + 1u) * nx) xb_add(&bar[XB_TOPGEN], 1u);
            else XB_SPIN(xb_ld(&bar[XB_TOPGEN]) == tg, bar);
            __builtin_amdgcn_fence(__ATOMIC_ACQUIRE, "agent");
            xb_add(&bar[XB_XGEN(b.x)], 1u);
            asm volatile("s_waitcnt vmcnt(0)" ::: "memory");
        } else {
            XB_SPIN(xb_ld(&bar[XB_XGEN(b.x)]) == gen, bar);
            __builtin_amdgcn_fence(__ATOMIC_ACQUIRE, "agent");
            asm volatile("s_waitcnt vmcnt(0)" ::: "memory");
        }
    }
    __syncthreads();
}
typedef unsigned u32x2 __attribute__((ext_vector_type(2)));
typedef unsigned short u16;
#define MFMA16(a, b, c) __builtin_amdgcn_mfma_f32_16x16x32_bf16((a), (b), (c), 0, 0, 0)
__device__ __forceinline__ float bf2f(unsigned b) { return __uint_as_float(b << 16); }
__device__ __forceinline__ float wave_sum(float v) {
#pragma unroll
    for (int o = 1; o < 64; o <<= 1) v += __shfl_xor(v, o);
    return v;
}
__device__ __forceinline__ float sigm(float x) { return __builtin_amdgcn_rcpf(1.0f + __builtin_amdgcn_exp2f(x * -1.4426950408889634f)); }
__device__ __forceinline__ float tanh_fast(float x) { const float e = __expf(-2.0f * fabsf(x)); const float t = (1.0f - e) / (1.0f + e); return x < 0.f ? -t : t; }
__device__ __forceinline__ float gelu_tanh(float x) { const float u = 0.7978845608028654f * (x + 0.044715f * x * x * x); return 0.5f * x * (1.0f + tanh_fast(u)); }

struct ColSel { int cnt, split, gap, rt_split, rt_gap; };
__device__ __forceinline__ int p0_row(int ro, int N, int rmode) {
    if (rmode == 1) { const int hv = ro >= (N >> 1), nn = hv ? ro - (N >> 1) : ro; ro = 256 * (nn >> 7) + 128 * hv + (nn & 127); }
    else if (rmode == 2 && ro >= C_QR && ro < C_VR) { const int jj = ro & 127; ro = (ro & ~127) + ((jj & 63) >> 2) * 8 + ((jj >> 6) << 2) + (jj & 3); }
    else if (rmode == 2 || rmode == 3) { const int x = ro & 255; ro = (ro & ~255) + 128 * ((x >> 5) & 1) + 32 * (x >> 6) + (x & 31); }
    return ro;
}
__device__ __forceinline__ int p0_rowc(int col, int N, int rmode, const ColSel cs) { int ro = p0_row(col, N, rmode); if ((ro >> 8) >= cs.rt_split) ro -= 256 * cs.rt_gap; return ro; }
__device__ __forceinline__ void p0_load_item(const float* W, int N, int item, int lane, const ColSel cs, f32x4 (&wv)[8]) {
    const int kb = item / cs.cnt, j = item % cs.cnt, nb = j + (j >= cs.split ? cs.gap : 0), k0 = 64 * kb;
    const float* base = W + (size_t)(k0 + (lane >> 3)) * N + 32 * nb + 4 * (lane & 7);
#pragma unroll
    for (int i = 0; i < 8; ++i) wv[i] = *(const GAS f32x4*)(base + (size_t)(8 * i) * N);
}
__device__ __forceinline__ unsigned p0_pack8(const float (&q)[4]) {
    return __builtin_amdgcn_perm(__float_as_uint(q[1]), __float_as_uint(q[0]), 0x0c0c0400u) | __builtin_amdgcn_perm(__float_as_uint(q[3]), __float_as_uint(q[2]), 0x04000c0cu);
}
template <bool Q8>
__device__ __forceinline__ void p0_store_item(const f32x4 (&wv)[8], int K, int N, bf16* WT, int ldw, LAS float* scr, int item, int lane, int rmode, const float* gk, const unsigned* wamax, const ColSel cs) {
    const int kb = item / cs.cnt, j_ = item % cs.cnt, nb = j_ + (j_ >= cs.split ? cs.gap : 0), k0 = 64 * kb;
    float qsc = 1.0f;
    if (Q8) { const int blk = p0_rowc(32 * nb, N, rmode, cs) >> 5; qsc = 127.0f * __builtin_amdgcn_rcpf(fmaxf(__uint_as_float(((const GAS unsigned*)wamax)[blk]), 1e-20f)); }
#pragma unroll
    for (int i = 0; i < 8; ++i) { const int kk = 8 * i + (lane >> 3); const float gs = (gk ? ((const GAS float*)gk)[k0 + kk] : 1.0f) * qsc; LAS float* d = scr + kk * 33 + 4 * (lane & 7);
        d[0] = wv[i].x * gs; d[1] = wv[i].y * gs; d[2] = wv[i].z * gs; d[3] = wv[i].w * gs; }
    LDS_WAIT(); asm volatile("" ::: "memory");
    const int c = lane & 7;
#pragma unroll
    for (int j = 0; j < 4; ++j) { const int n = (lane >> 3) + 8 * j; const LAS float* s = scr + (8 * c) * 33 + n;
        const int ro = p0_rowc(32 * nb + n, N, rmode, cs);
        if (Q8) { const float qa[4] = {s[0 * 33] + 12582912.0f, s[1 * 33] + 12582912.0f, s[2 * 33] + 12582912.0f, s[3 * 33] + 12582912.0f}, qb[4] = {s[4 * 33] + 12582912.0f, s[5 * 33] + 12582912.0f, s[6 * 33] + 12582912.0f, s[7 * 33] + 12582912.0f};
            u32x2 o; o.x = p0_pack8(qa); o.y = p0_pack8(qb);
            *(GAS u32x2*)((signed char*)WT + (size_t)ro * ldw + k0 + 8 * c) = o; }
        else { v4u o; o.x = pk2(s[0 * 33], s[1 * 33]); o.y = pk2(s[2 * 33], s[3 * 33]); o.z = pk2(s[4 * 33], s[5 * 33]); o.w = pk2(s[6 * 33], s[7 * 33]);
            *(GAS v4u*)(WT + (size_t)ro * ldw + k0 + 8 * c) = o; } }
    LDS_WAIT(); asm volatile("" ::: "memory");
}
template <bool Q8>
__device__ __forceinline__ void p0_matrix_sel(const float* W, int K, int N, bf16* WT, int ldw, LAS float* scr, int gw, int NGW, int lane, int rmode, const float* gk, const unsigned* wamax, const ColSel cs) {
    const int nitems = (K / 64) * cs.cnt;
    f32x4 wa[8], wb[8];
    int it = gw;
    if (it < nitems) p0_load_item(W, N, it, lane, cs, wa);
    while (it < nitems) {
        const int it1 = it + NGW, it2 = it1 + NGW;
        if (it1 < nitems) p0_load_item(W, N, it1, lane, cs, wb);
        p0_store_item<Q8>(wa, K, N, WT, ldw, scr, it, lane, rmode, gk, wamax, cs);
        if (it1 >= nitems) break;
        if (it2 < nitems) p0_load_item(W, N, it2, lane, cs, wa);
        p0_store_item<Q8>(wb, K, N, WT, ldw, scr, it1, lane, rmode, gk, wamax, cs);
        it = it2;
    }
}
template <bool Q8>
__device__ __forceinline__ void p0_matrix(const float* W, int K, int N, bf16* WT, int ldw, LAS float* scr, int gw, int NGW, int lane, int rmode, const float* gk, const unsigned* wamax = nullptr) {
    p0_matrix_sel<Q8>(W, K, N, WT, ldw, scr, gw, NGW, lane, rmode, gk, wamax, ColSel{N / 32, N / 32, 0, 1 << 20, 0});
}
__device__ __forceinline__ void p0_amax_item(const f32x4 (&wv)[8], int N, int item, int lane, int rmode, const float* gk, unsigned* wamax, const ColSel cs) {
    const int kb = item / cs.cnt, j = item % cs.cnt, nb = j + (j >= cs.split ? cs.gap : 0), k0 = 64 * kb;
    float mx = 0.f;
#pragma unroll
    for (int i = 0; i < 8; ++i) { const float gs = fabsf(((const GAS float*)gk)[k0 + 8 * i + (lane >> 3)]); mx = fmaxf(mx, gs * fmaxf(fmaxf(fabsf(wv[i].x), fabsf(wv[i].y)), fmaxf(fabsf(wv[i].z), fabsf(wv[i].w)))); }
#pragma unroll
    for (int o = 1; o < 64; o <<= 1) mx = fmaxf(mx, __shfl_xor(mx, o));
    if (lane == 0) __hip_atomic_fetch_max((GAS unsigned*)wamax + (p0_rowc(32 * nb, N, rmode, cs) >> 5), __float_as_uint(mx), __ATOMIC_RELAXED, __HIP_MEMORY_SCOPE_AGENT);
}
__device__ __forceinline__ void p0_amax(const float* W, int K, int N, int gw, int NGW, int lane, int rmode, const float* gk, unsigned* wamax, const ColSel cs) {
    const int nitems = (K / 64) * cs.cnt;
    f32x4 wa[8], wb[8];
    int it = gw;
    if (it < nitems) p0_load_item(W, N, it, lane, cs, wa);
    while (it < nitems) {
        const int it1 = it + NGW, it2 = it1 + NGW;
        if (it1 < nitems) p0_load_item(W, N, it1, lane, cs, wb);
        p0_amax_item(wa, N, it, lane, rmode, gk, wamax, cs);
        if (it1 >= nitems) break;
        if (it2 < nitems) p0_load_item(W, N, it2, lane, cs, wa);
        p0_amax_item(wb, N, it1, lane, rmode, gk, wamax, cs);
        it = it2;
    }
}

__device__ __forceinline__ void rms_rows(const float* x, const float* g, bf16* xn, int gw, int NGW, int lane) {
    f32x4 gg[4];
#pragma unroll
    for (int j = 0; j < 4; ++j) gg[j] = *((const f32x4*)g + lane + 64 * j);
    for (int m = gw; m < MH; m += NGW) {
        const GAS f32x4* xr = (const GAS f32x4*)(x + (size_t)m * D) + lane;
        f32x4 v[4]; float s = 0.f;
#pragma unroll
        for (int j = 0; j < 4; ++j) { v[j] = xr[64 * j]; s += (v[j].x * v[j].x + v[j].y * v[j].y) + (v[j].z * v[j].z + v[j].w * v[j].w); }
        const float r = __builtin_amdgcn_rsqf(wave_sum(s) * (1.f / D) + EPS);
        GAS u32x2* o = (GAS u32x2*)(xn + (size_t)m * D) + lane;
#pragma unroll
        for (int j = 0; j < 4; ++j) { u32x2 w; w.x = pk2(v[j].x * r * gg[j].x, v[j].y * r * gg[j].y); w.y = pk2(v[j].z * r * gg[j].z, v[j].w * r * gg[j].w); o[64 * j] = w; }
    }
}
__device__ __forceinline__ void xg_rows(const float* x, bf16* xg, float* stat, signed char* xq, float* qs, float* amx, int gw, int NGW, int lane) {
    for (int m0 = gw * 4; m0 < MH; m0 += NGW * 4) {
        f32x4 v[4][4];
#pragma unroll
        for (int r = 0; r < 4; ++r) { const GAS f32x4* xr = (const GAS f32x4*)(x + (size_t)(m0 + r) * D) + lane;
#pragma unroll
            for (int j = 0; j < 4; ++j) v[r][j] = xr[64 * j]; }
#pragma unroll
        for (int r = 0; r < 4; ++r) { float s = 0.f, mx = 0.f;
#pragma unroll
            for (int j = 0; j < 4; ++j) { s += (v[r][j].x * v[r][j].x + v[r][j].y * v[r][j].y) + (v[r][j].z * v[r][j].z + v[r][j].w * v[r][j].w);
                mx = fmaxf(mx, fmaxf(fmaxf(fabsf(v[r][j].x), fabsf(v[r][j].y)), fmaxf(fabsf(v[r][j].z), fabsf(v[r][j].w)))); }
            s = wave_sum(s);
#pragma unroll
            for (int o = 1; o < 64; o <<= 1) mx = fmaxf(mx, __shfl_xor(mx, o));
            const float B = fmaxf(mx, 1e-20f), s2 = 127.0f * __builtin_amdgcn_rcpf(B);
            GAS u32x2* o = (GAS u32x2*)(xg + (size_t)(m0 + r) * D) + lane;
            GAS unsigned* oq = (GAS unsigned*)(xq + (size_t)(m0 + r) * D) + lane;
#pragma unroll
            for (int j = 0; j < 4; ++j) { u32x2 w; w.x = pk2(v[r][j].x, v[r][j].y); w.y = pk2(v[r][j].z, v[r][j].w); o[64 * j] = w;
                if (PG_I8_P1) { const float qa[4] = {v[r][j].x * s2 + 12582912.0f, v[r][j].y * s2 + 12582912.0f, v[r][j].z * s2 + 12582912.0f, v[r][j].w * s2 + 12582912.0f}; oq[64 * j] = p0_pack8(qa); } }
            if (lane == 0) { *(GAS f32x4*)(stat + (size_t)(m0 + r) * 4) = (f32x4){s, 0.f, 0.f, 0.f}; *(GAS f32x4*)(amx + (size_t)(m0 + r) * 4) = (f32x4){mx, mx, mx, mx}; ((GAS float*)qs)[m0 + r] = B * (1.0f / 127.0f); } }
    }
}
__device__ __forceinline__ void resid_rows(const bf16* z, const float* xsrc, float* xdst, const float* gpost, const float* gnext, bf16* xn, int gw, int NGW, int lane) {
    for (int m = gw; m < MH; m += NGW) {
        const GAS u32x2* zr = (const GAS u32x2*)(z + (size_t)m * D) + lane;
        const GAS f32x4* xr = (const GAS f32x4*)(xsrc + (size_t)m * D) + lane;
        f32x4 v[4], xv[4]; float s = 0.f;
#pragma unroll
        for (int j = 0; j < 4; ++j) { const u32x2 zb = zr[64 * j]; v[j] = (f32x4){bf2f(zb.x & 0xffffu), bf2f(zb.x >> 16), bf2f(zb.y & 0xffffu), bf2f(zb.y >> 16)}; xv[j] = xr[64 * j]; s += (v[j].x * v[j].x + v[j].y * v[j].y) + (v[j].z * v[j].z + v[j].w * v[j].w); }
        const float r = __builtin_amdgcn_rsqf(wave_sum(s) * (1.f / D) + EPS);
        float s2 = 0.f;
        GAS f32x4* xo = (GAS f32x4*)(xdst + (size_t)m * D) + lane;
#pragma unroll
        for (int j = 0; j < 4; ++j) { const f32x4 gp = *((const f32x4*)gpost + lane + 64 * j); v[j] = xv[j] + v[j] * r * gp; xo[64 * j] = v[j];
            s2 += (v[j].x * v[j].x + v[j].y * v[j].y) + (v[j].z * v[j].z + v[j].w * v[j].w); }
        if (gnext) {
            const float r2 = __builtin_amdgcn_rsqf(wave_sum(s2) * (1.f / D) + EPS);
            GAS u32x2* o = (GAS u32x2*)(xn + (size_t)m * D) + lane;
#pragma unroll
            for (int j = 0; j < 4; ++j) { const f32x4 gn = *((const f32x4*)gnext + lane + 64 * j); u32x2 w; w.x = pk2(v[j].x * r2 * gn.x, v[j].y * r2 * gn.y); w.y = pk2(v[j].z * r2 * gn.z, v[j].w * r2 * gn.w); o[64 * j] = w; }
        }
    }
}
__device__ __forceinline__ void conv_phase(const bf16* U, bf16* G, const float* cw, const float* cb, int gt, int NGT) {
    constexpr int CG = DFF / 8, NIT = (MH / 32) * CG;
    for (int it = gt; it < NIT; it += NGT) {
        const int cg = it % CG, rg = it / CG, c0 = cg * 8, t0 = rg * 32;
        float w0[8], w1[8], w2[8], bb[8];
#pragma unroll
        for (int e = 0; e < 8; ++e) { w0[e] = cw[c0 + e]; w1[e] = cw[DFF + c0 + e]; w2[e] = cw[2 * DFF + c0 + e]; bb[e] = cb[c0 + e]; }
        float a2[8], a1[8];
        if ((t0 & (SEQ - 1)) == 0) {
#pragma unroll
            for (int e = 0; e < 8; ++e) { a2[e] = 0.f; a1[e] = 0.f; }
        } else {
            const v4u p2 = *(const GAS v4u*)(U + (size_t)(t0 - 2) * NUP + c0), p1 = *(const GAS v4u*)(U + (size_t)(t0 - 1) * NUP + c0);
            a2[0] = bf2f(p2.x & 0xffffu); a2[1] = bf2f(p2.x >> 16); a2[2] = bf2f(p2.y & 0xffffu); a2[3] = bf2f(p2.y >> 16); a2[4] = bf2f(p2.z & 0xffffu); a2[5] = bf2f(p2.z >> 16); a2[6] = bf2f(p2.w & 0xffffu); a2[7] = bf2f(p2.w >> 16);
            a1[0] = bf2f(p1.x & 0xffffu); a1[1] = bf2f(p1.x >> 16); a1[2] = bf2f(p1.y & 0xffffu); a1[3] = bf2f(p1.y >> 16); a1[4] = bf2f(p1.z & 0xffffu); a1[5] = bf2f(p1.z >> 16); a1[6] = bf2f(p1.w & 0xffffu); a1[7] = bf2f(p1.w >> 16);
        }
#pragma unroll 4
        for (int t = 0; t < 32; ++t) {
            const v4u pa = *(const GAS v4u*)(U + (size_t)(t0 + t) * NUP + c0), pv = *(const GAS v4u*)(U + (size_t)(t0 + t) * NUP + DFF + c0);
            float a0[8], vv[8], o[8];
            a0[0] = bf2f(pa.x & 0xffffu); a0[1] = bf2f(pa.x >> 16); a0[2] = bf2f(pa.y & 0xffffu); a0[3] = bf2f(pa.y >> 16); a0[4] = bf2f(pa.z & 0xffffu); a0[5] = bf2f(pa.z >> 16); a0[6] = bf2f(pa.w & 0xffffu); a0[7] = bf2f(pa.w >> 16);
            vv[0] = bf2f(pv.x & 0xffffu); vv[1] = bf2f(pv.x >> 16); vv[2] = bf2f(pv.y & 0xffffu); vv[3] = bf2f(pv.y >> 16); vv[4] = bf2f(pv.z & 0xffffu); vv[5] = bf2f(pv.z >> 16); vv[6] = bf2f(pv.w & 0xffffu); vv[7] = bf2f(pv.w >> 16);
#pragma unroll
            for (int e = 0; e < 8; ++e) { const float ac = bb[e] + w0[e] * a2[e] + w1[e] * a1[e] + w2[e] * a0[e]; o[e] = gelu_tanh(ac) * vv[e]; a2[e] = a1[e]; a1[e] = a0[e]; }
            v4u w; w.x = pk2(o[0], o[1]); w.y = pk2(o[2], o[3]); w.z = pk2(o[4], o[5]); w.w = pk2(o[6], o[7]);
            *(GAS v4u*)(G + (size_t)(t0 + t) * DFF + c0) = w;
        }
    }
}
__device__ __forceinline__ void ld8(const bf16* p, float (&o)[8]) { const v4u v = *(const GAS v4u*)p; o[0] = bf2f(v.x & 0xffffu); o[1] = bf2f(v.x >> 16); o[2] = bf2f(v.y & 0xffffu); o[3] = bf2f(v.y >> 16); o[4] = bf2f(v.z & 0xffffu); o[5] = bf2f(v.z >> 16); o[6] = bf2f(v.w & 0xffffu); o[7] = bf2f(v.w >> 16); }
__device__ __forceinline__ void up8(const v4u v, float (&o)[8]) { o[0] = bf2f(v.x & 0xffffu); o[1] = bf2f(v.x >> 16); o[2] = bf2f(v.y & 0xffffu); o[3] = bf2f(v.y >> 16); o[4] = bf2f(v.z & 0xffffu); o[5] = bf2f(v.z >> 16); o[6] = bf2f(v.w & 0xffffu); o[7] = bf2f(v.w >> 16); }
__device__ __forceinline__ void conv_fixup(const bf16* H, bf16* G, const float* cw, const float* cb, int pm, int tid) {
    if (tid >= DFF / 8) return;
    asm volatile("" : "+s"(pm));
    const int c0 = 8 * tid;
    v4u ld[4][6];
#pragma unroll
    for (int g = 0; g < 4; ++g) { const int grp = 4 * pm + g; const bool seq0 = ((grp * 64) & (SEQ - 1)) == 0; const int gp = seq0 ? grp : grp - 1;
        ld[g][0] = *(const GAS v4u*)(H + (size_t)(gp * 6 + 0) * DFF + c0);  ld[g][1] = *(const GAS v4u*)(H + (size_t)(gp * 6 + 1) * DFF + c0);
        ld[g][2] = *(const GAS v4u*)(H + (size_t)(grp * 6 + 2) * DFF + c0); ld[g][3] = *(const GAS v4u*)(H + (size_t)(grp * 6 + 3) * DFF + c0);
        ld[g][4] = *(const GAS v4u*)(H + (size_t)(grp * 6 + 4) * DFF + c0); ld[g][5] = *(const GAS v4u*)(H + (size_t)(grp * 6 + 5) * DFF + c0); }
    float w0[8], w1[8], w2[8], bb[8];
#pragma unroll
    for (int h = 0; h < 2; ++h) { const f32x4 a = *(const GAS f32x4*)(cw + c0 + 4 * h), b = *(const GAS f32x4*)(cw + DFF + c0 + 4 * h), c = *(const GAS f32x4*)(cw + 2 * DFF + c0 + 4 * h), d = *(const GAS f32x4*)(cb + c0 + 4 * h);
#pragma unroll
        for (int i = 0; i < 4; ++i) { w0[4 * h + i] = a[i]; w1[4 * h + i] = b[i]; w2[4 * h + i] = c[i]; bb[4 * h + i] = d[i]; } }
#pragma unroll
    for (int g = 0; g < 4; ++g) { const int grp = 4 * pm + g; const float pz = (((grp * 64) & (SEQ - 1)) == 0) ? 0.f : 1.f;
        float p62[8], p63[8], a0[8], a1[8], v0[8], v1[8], o0[8], o1[8];
        up8(ld[g][0], p62); up8(ld[g][1], p63); up8(ld[g][2], a0); up8(ld[g][3], a1); up8(ld[g][4], v0); up8(ld[g][5], v1);
#pragma unroll
        for (int e = 0; e < 8; ++e) { const float q62 = p62[e] * pz, q63 = p63[e] * pz;
            o0[e] = pg8::gelu_tanh_f(bb[e] + w0[e] * q62 + w1[e] * q63 + w2[e] * a0[e]) * v0[e];
            o1[e] = pg8::gelu_tanh_f(bb[e] + w0[e] * q63 + w1[e] * a0[e] + w2[e] * a1[e]) * v1[e]; }
        v4u x; x.x = pk2(o0[0], o0[1]); x.y = pk2(o0[2], o0[3]); x.z = pk2(o0[4], o0[5]); x.w = pk2(o0[6], o0[7]); *(GAS v4u*)(G + (size_t)(grp * 64) * DFF + c0) = x;
        v4u y; y.x = pk2(o1[0], o1[1]); y.y = pk2(o1[2], o1[3]); y.z = pk2(o1[4], o1[5]); y.w = pk2(o1[6], o1[7]); *(GAS v4u*)(G + (size_t)(grp * 64 + 1) * DFF + c0) = y; }
}
__device__ __forceinline__ void scan_phase(bf16* KV, int gt, int NGT) {
    constexpr int NIT = 16 * (256 * 128 / 4);
    for (int it = gt; it < NIT; it += NGT) {
        const int p = it / 8192, idx = it % 8192, h = p & 3;
        const float gc = GAMMA128_OF(h);
        GAS u32x2* base = (GAS u32x2*)(KV + (size_t)p * 32 * 32768) + idx;
        u32x2 ld[32];
#pragma unroll
        for (int n = 0; n < 32; ++n) ld[n] = base[(size_t)n * 8192];
        float s0 = 0.f, s1 = 0.f, s2 = 0.f, s3 = 0.f;
#pragma unroll
        for (int n = 0; n < 32; ++n) {
            u32x2 w; w.x = pk2(s0, s1); w.y = pk2(s2, s3); base[(size_t)n * 8192] = w;
            s0 = gc * s0 + bf2f(ld[n].x & 0xffffu); s1 = gc * s1 + bf2f(ld[n].x >> 16); s2 = gc * s2 + bf2f(ld[n].y & 0xffffu); s3 = gc * s3 + bf2f(ld[n].y >> 16);
        }
    }
}

__device__ __forceinline__ void attn_unit(LAS unsigned char* lds, const bf16* proj, bf16* aoa, const float* biastab, const float* sinks_l, int unit, int tid, int wave, int lane) {
    constexpr int KST = 144, VST = 136, K_OFF = 0, V_OFF = 256 * KST, B_OFF = V_OFF + 256 * VST;
    const int kh = unit & 1, n = (unit >> 1) & 31, bb = unit >> 6;
    const int rb = bb * SEQ + 128 * n;
#pragma unroll
    for (int it = tid; it < 2048; it += 512) {
        const int j = it >> 3, ch = it & 7;
        v4u kv = (v4u){0u, 0u, 0u, 0u}, vv = (v4u){0u, 0u, 0u, 0u};
        if (n > 0 || j >= 128) { const bf16* src = proj + (size_t)(rb - 128 + j) * DIN; kv = *(const GAS v4u*)(src + C_KA + kh * 64 + ch * 8); vv = *(const GAS v4u*)(src + C_VA + kh * 64 + ch * 8); }
        *(LAS v4u*)(lds + K_OFF + j * KST + ch * 16) = kv;
        *(LAS u32x2*)(lds + V_OFF + j * VST + ch * 16) = (u32x2){vv.x, vv.y};
        *(LAS u32x2*)(lds + V_OFF + j * VST + ch * 16 + 8) = (u32x2){vv.z, vv.w};
    }
    { LAS float* bl = (LAS float*)(lds + B_OFF); bl[tid] = biastab[(kh * 4 + (tid >> 7)) * 128 + (tid & 127)]; }
    __syncthreads();
    const int g = wave >> 1, qh = wave & 1, head = kh * 4 + g;
    const float sink = sinks_l[head];
    const int c = lane & 15, q = lane >> 4;
    const LAS float* bl = (const LAS float*)(lds + B_OFF) + g * 128;
    for (int qs = 0; qs < 4; ++qs) {
        const int i0 = 64 * qh + 16 * qs, i = i0 + c;
        const bf16* qsrc = proj + (size_t)(rb + i) * DIN + C_QA + head * 64 + 8 * q;
        const bf16x8 qf0 = *(const GAS bf16x8*)(qsrc), qf1 = *(const GAS bf16x8*)(qsrc + 32);
        f32x4 s[9];
#pragma unroll
        for (int kt = 0; kt < 9; ++kt) {
            const LAS unsigned char* kp = lds + K_OFF + (i0 + 16 * kt + c) * KST + 16 * q;
            const bf16x8 k0 = *(const LAS bf16x8*)kp, k1 = *(const LAS bf16x8*)(kp + 64);
            f32x4 a = (f32x4){0.f, 0.f, 0.f, 0.f};
            a = MFMA16(k0, qf0, a); a = MFMA16(k1, qf1, a); s[kt] = a;
        }
        float mx = -3.0e38f;
#pragma unroll
        for (int kt = 0; kt < 9; ++kt)
#pragma unroll
            for (int r = 0; r < 4; ++r) {
                const int j = i0 + 16 * kt + 4 * q + r, dist = 128 + i - j;
                const bool ok = (dist >= 0) && (dist < 128) && (n > 0 || j >= 128);
                const float v = ok ? s[kt][r] * 0.125f + bl[dist & 127] : -1.0e30f;
                s[kt][r] = v; mx = fmaxf(mx, v);
            }
        mx = fmaxf(mx, __shfl_xor(mx, 16)); mx = fmaxf(mx, __shfl_xor(mx, 32)); mx = fmaxf(mx, sink);
        float sum = 0.f;
#pragma unroll
        for (int kt = 0; kt < 9; ++kt)
#pragma unroll
            for (int r = 0; r < 4; ++r) { const float p = __expf(s[kt][r] - mx); s[kt][r] = p; sum += p; }
        sum += __shfl_xor(sum, 16); sum += __shfl_xor(sum, 32);
        const float inv = __builtin_amdgcn_rcpf(sum + __expf(sink - mx));
        f32x4 o[4];
#pragma unroll
        for (int dt = 0; dt < 4; ++dt) o[dt] = (f32x4){0.f, 0.f, 0.f, 0.f};
#pragma unroll
        for (int p = 0; p < 5; ++p) {
            const f32x4 ta = s[2 * p], tb = (2 * p + 1 < 9) ? s[2 * p + 1 < 9 ? 2 * p + 1 : 8] : (f32x4){0.f, 0.f, 0.f, 0.f};
            v4u pw; pw.x = pk2(ta[0], ta[1]); pw.y = pk2(ta[2], ta[3]); pw.z = pk2(tb[0], tb[1]); pw.w = pk2(tb[2], tb[3]);
            const bf16x8 pb = __builtin_bit_cast(bf16x8, pw);
#pragma unroll
            for (int dt = 0; dt < 4; ++dt) {
                bf16x8 va;
#pragma unroll
                for (int j = 0; j < 8; ++j) { int key = i0 + 32 * p + (j < 4 ? 4 * q + j : 16 + 4 * q + (j - 4)); key = key > 255 ? 255 : key;
                    va[j] = (short)*(const LAS u16*)(lds + V_OFF + key * VST + (16 * dt + c) * 2); }
                o[dt] = MFMA16(va, pb, o[dt]);
            }
        }
        bf16* orow = aoa + (size_t)(rb + i) * 1536 + head * 64 + 4 * q;
#pragma unroll
        for (int dt = 0; dt < 4; ++dt) { u32x2 w; w.x = pk2(o[dt][0] * inv, o[dt][1] * inv); w.y = pk2(o[dt][2] * inv, o[dt][3] * inv); *(GAS u32x2*)(orow + 16 * dt) = w; }
    }
    __syncthreads();
}

__device__ __forceinline__ void stage_copy(LAS unsigned char* img, const bf16* src, int s, int i8) {
    const v4u x1 = *(const GAS v4u*)(src), x2 = *(const GAS v4u*)(src + 64);
    *(LAS v4u*)(img + s * 272 + i8 * 16) = x1; *(LAS v4u*)(img + s * 272 + 128 + i8 * 16) = x2;
}
__device__ __forceinline__ void stage_v(LAS unsigned char* img, const bf16* proj, int rb, int h, int tid) {
#pragma unroll
    for (int it = tid; it < 4096; it += 512) { const int s = it >> 5, ch = it & 31;
        const v4u v = *(const GAS v4u*)(proj + (size_t)(rb + s) * DIN + C_VR + h * 256 + 8 * ch);
        *(LAS u32x2*)(img + s * 520 + ch * 16) = (u32x2){v.x, v.y}; *(LAS u32x2*)(img + s * 520 + ch * 16 + 8) = (u32x2){v.z, v.w}; }
}
__device__ __forceinline__ void kv_unit(LAS unsigned char* lds, const bf16* proj, bf16* kvbuf, int unit, int tid, int wave, int lane) {
    constexpr int KZ_OFF = 0, V_OFF = 128 * 272;
    const int n = unit & 31, h = (unit >> 5) & 3, bb = unit >> 7;
    const int rb = bb * SEQ + 128 * n;
    const float lg = __logf(1.0f - exp2f(-5.0f - (float)h)), g127 = __expf(127.0f * lg);
#pragma unroll
    for (int it = tid; it < 1024; it += 512) { const int s = it >> 3, i8 = it & 7; stage_copy(lds + KZ_OFF, proj + (size_t)(rb + s) * DIN + C_KR + h * 128 + 8 * i8, s, i8); }
    stage_v(lds + V_OFF, proj, rb, h, tid);
    __syncthreads();
    const int c = lane & 15, q = lane >> 4;
    f32x4 acc[2][8];
#pragma unroll
    for (int ei = 0; ei < 2; ++ei)
#pragma unroll
        for (int dt = 0; dt < 8; ++dt) acc[ei][dt] = (f32x4){0.f, 0.f, 0.f, 0.f};
#pragma unroll
    for (int ks = 0; ks < 4; ++ks) {
        bf16x8 bfr[2];
#pragma unroll
        for (int ei = 0; ei < 2; ++ei)
#pragma unroll
            for (int j = 0; j < 8; ++j) bfr[ei][j] = (short)*(const LAS u16*)(lds + V_OFF + (32 * ks + 8 * q + j) * 520 + (16 * (2 * wave + ei) + c) * 2);
#pragma unroll
        for (int dt = 0; dt < 8; ++dt) {
            bf16x8 af;
#pragma unroll
            for (int j = 0; j < 8; ++j) af[j] = (short)*(const LAS u16*)(lds + KZ_OFF + (32 * ks + 8 * q + j) * 272 + (16 * dt + c) * 2);
#pragma unroll
            for (int ei = 0; ei < 2; ++ei) acc[ei][dt] = MFMA16(af, bfr[ei], acc[ei][dt]);
        }
    }
#pragma unroll
    for (int ei = 0; ei < 2; ++ei) { const int e = 16 * (2 * wave + ei) + c; bf16* dst = kvbuf + ((size_t)unit * 256 + e) * 128 + 4 * q;
#pragma unroll
        for (int dt = 0; dt < 8; ++dt) { u32x2 w; w.x = pk2(acc[ei][dt][0] * g127, acc[ei][dt][1] * g127); w.y = pk2(acc[ei][dt][2] * g127, acc[ei][dt][3] * g127); *(GAS u32x2*)(dst + 16 * dt) = w; } }
    __syncthreads();
}
__device__ __forceinline__ void ret_unit(LAS unsigned char* lds, const bf16* proj, const bf16* kvbuf, bf16* aor, const float* rnorm_l, int unit, int tid, int wave, int lane) {
    constexpr int Q_OFF = 0, K_OFF = 128 * 272, V_OFF = 2 * 128 * 272;
    const int n = unit & 31, h = (unit >> 5) & 3, bb = unit >> 7;
    const int rb = bb * SEQ + 128 * n;
    const float lg = __logf(1.0f - exp2f(-5.0f - (float)h));
#pragma unroll
    for (int it = tid; it < 2048; it += 512) { const int which = it >> 10, s = (it >> 3) & 127, i8 = it & 7;
        stage_copy(lds + (which ? K_OFF : Q_OFF), proj + (size_t)(rb + s) * DIN + (which ? C_KR : C_QR) + h * 128 + 8 * i8, s, i8); }
    stage_v(lds + V_OFF, proj, rb, h, tid);
    __syncthreads();
    const int c = lane & 15, q = lane >> 4, cl = 16 * wave + c;
    bf16x8 qf[4];
#pragma unroll
    for (int ks = 0; ks < 4; ++ks) qf[ks] = *(const LAS bf16x8*)(lds + Q_OFF + cl * 272 + (32 * ks + 8 * q) * 2);
    f32x4 sT[8];
#pragma unroll
    for (int st = 0; st < 8; ++st) {
        f32x4 a = (f32x4){0.f, 0.f, 0.f, 0.f};
        if (st <= wave) {
#pragma unroll
            for (int ks = 0; ks < 4; ++ks) { const bf16x8 kf = *(const LAS bf16x8*)(lds + K_OFF + (16 * st + c) * 272 + (32 * ks + 8 * q) * 2); a = MFMA16(kf, qf[ks], a); }
#pragma unroll
            for (int r = 0; r < 4; ++r) { const int s = 16 * st + 4 * q + r; a[r] = (cl >= s) ? a[r] : 0.f; }
        }
        sT[st] = a;
    }
    f32x4 o[16];
    const bf16* stp = kvbuf + (size_t)unit * 256 * 128 + (size_t)c * 128 + 8 * q;
#pragma unroll
    for (int et = 0; et < 16; ++et) {
        f32x4 a = (f32x4){0.f, 0.f, 0.f, 0.f};
#pragma unroll
        for (int ks = 0; ks < 4; ++ks) { const bf16x8 sf = *(const GAS bf16x8*)(stp + (size_t)et * 16 * 128 + 32 * ks); a = MFMA16(sf, qf[ks], a); }
        o[et] = a;
    }
    const float xi = __expf(lg);
#pragma unroll
    for (int et = 0; et < 16; ++et) o[et] = o[et] * xi;
#pragma unroll
    for (int p = 0; p < 4; ++p) {
        if (2 * p <= wave) {
            const f32x4 ta = sT[2 * p], tb = sT[2 * p + 1];
            v4u pw; pw.x = pk2(ta[0], ta[1]); pw.y = pk2(ta[2], ta[3]); pw.z = pk2(tb[0], tb[1]); pw.w = pk2(tb[2], tb[3]);
            const bf16x8 pb = __builtin_bit_cast(bf16x8, pw);
#pragma unroll
            for (int et = 0; et < 16; ++et) {
                bf16x8 va;
#pragma unroll
                for (int j = 0; j < 8; ++j) { const int s = 32 * p + (j < 4 ? 4 * q + j : 16 + 4 * q + (j - 4)); va[j] = (short)*(const LAS u16*)(lds + V_OFF + s * 520 + (16 * et + c) * 2); }
                o[et] = MFMA16(va, pb, o[et]);
            }
        }
    }
    float sm = 0.f;
#pragma unroll
    for (int et = 0; et < 16; ++et) sm += (o[et][0] + o[et][1]) + (o[et][2] + o[et][3]);
    sm += __shfl_xor(sm, 16); sm += __shfl_xor(sm, 32);
    const float mu = sm * (1.0f / 256.0f);
    float vs = 0.f;
#pragma unroll
    for (int et = 0; et < 16; ++et) { const f32x4 d = o[et] - mu; vs += (d[0] * d[0] + d[1] * d[1]) + (d[2] * d[2] + d[3] * d[3]); }
    vs += __shfl_xor(vs, 16); vs += __shfl_xor(vs, 32);
    const float rs = __builtin_amdgcn_rsqf(vs * (1.0f / 256.0f) + EPS);
    const size_t tok = (size_t)(rb + cl);
    const bf16* grow = proj + tok * DIN + C_GR + h * 256 + 4 * q;
    bf16* orow = aor + tok * 1536 + 512 + h * 256 + 4 * q;
    const float* gn = rnorm_l + h * 256 + 4 * q;
#pragma unroll
    for (int et = 0; et < 16; ++et) {
        const u32x2 gv = *(const GAS u32x2*)(grow + 16 * et); const f32x4 gg = *(const GAS f32x4*)(gn + 16 * et);
        const float g0 = bf2f(gv.x & 0xffffu), g1 = bf2f(gv.x >> 16), g2 = bf2f(gv.y & 0xffffu), g3 = bf2f(gv.y >> 16);
        const float y0 = (o[et][0] - mu) * rs * gg.x * g0 * sigm(g0), y1 = (o[et][1] - mu) * rs * gg.y * g1 * sigm(g1), y2 = (o[et][2] - mu) * rs * gg.z * g2 * sigm(g2), y3 = (o[et][3] - mu) * rs * gg.w * g3 * sigm(g3);
        u32x2 w; w.x = pk2(y0, y1); w.y = pk2(y2, y3); *(GAS u32x2*)(orow + 16 * et) = w;
    }
    __syncthreads();
}

__device__ __forceinline__ void ret_dma(LAS unsigned char* buf, int type, const bf16* proj, const bf16* kvbuf, int unit, int wave, int lane) {
    const int n = unit & 31, h = (unit >> 5) & 3, bb = unit >> 7, rb = bb * SEQ + 128 * n;
    asm volatile("" : "+v"(lane));
#pragma unroll
    for (int i = 0; i < 4; ++i) {
        const int ins = wave * 4 + i, P = ins * 64 + lane;
        const char* src;
        if (type < 2) { const int r = P >> 4, ch = (P & 15) ^ (r & 15); src = (const char*)(proj + (size_t)(rb + r) * DIN + (type == 0 ? C_QR : C_KR) + h * 128) + ch * 16; }
        else if (type < 4) { const int r = (P >> 4) + 128 * (type - 2), ch = (P & 15) ^ (r & 15); src = (const char*)(kvbuf + ((size_t)unit * 256 + r) * 128) + ch * 16; }
        else { const int r = (P >> 5) + 64 * (type & 1), cp = P & 31, ch = (((cp >> 1) ^ (r & 7)) << 1) | (cp & 1); src = (const char*)(proj + (size_t)(rb + r) * DIN + (type < 6 ? C_VR : C_GR) + h * 256) + ch * 16; }
        __builtin_amdgcn_global_load_lds((const unsigned*)src, (LAS unsigned*)(buf + ins * 1024), 16, 0, 0);
    }
}
typedef short v4i16_t __attribute__((ext_vector_type(4)));
__device__ __forceinline__ bf16x8 tr_pair(const LAS unsigned char* p0, const LAS unsigned char* p1) {
    const v4i16_t lo = __builtin_amdgcn_ds_read_tr16_b64_v4i16((LAS v4i16_t*)p0), hi = __builtin_amdgcn_ds_read_tr16_b64_v4i16((LAS v4i16_t*)p1);
    return (bf16x8){lo[0], lo[1], lo[2], lo[3], hi[0], hi[1], hi[2], hi[3]};
}
__device__ __forceinline__ void ret_phase(LAS unsigned char* lds, const bf16* proj, const bf16* kvbuf, bf16* ao, const float* rnorm_l, int bx, int G, int wave, int lane) {
    const int nu = (512 - bx + G - 1) / G, nsteps = 8 * nu;
    { LAS float* gl = (LAS float*)(lds + RING_BYTES); const int t = wave * 64 + lane; gl[t] = ((const GAS float*)rnorm_l)[t]; gl[t + 512] = ((const GAS float*)rnorm_l)[t + 512]; }
    if (nsteps <= 0) return;
    const int c = lane & 15, q = lane >> 4, cl = 16 * wave + c;
    f32x4 sT[8], o[16]; bf16x8 qf[4];
#pragma unroll
    for (int i = 0; i < 8; ++i) sT[i] = (f32x4){0.f, 0.f, 0.f, 0.f};
#pragma unroll
    for (int i = 0; i < 16; ++i) o[i] = (f32x4){0.f, 0.f, 0.f, 0.f};
#pragma unroll
    for (int i = 0; i < 4; ++i) qf[i] = (bf16x8){0, 0, 0, 0, 0, 0, 0, 0};
    float mu = 0.f, rs = 0.f; int last_store = -100;
#pragma unroll
    for (int k0 = 0; k0 < 3; ++k0) if (k0 < nsteps) ret_dma(lds + k0 * 32768, k0 & 7, proj, kvbuf, bx + (k0 >> 3) * G, wave, lane);
    for (int k = 0; k < nsteps; ++k) {
        const int unit = bx + (k >> 3) * G, type = k & 7;
        const LAS unsigned char* buf = lds + (k & 3) * 32768;
        if (k + 3 < nsteps) ret_dma(lds + ((k + 3) & 3) * 32768, (k + 3) & 7, proj, kvbuf, bx + ((k + 3) >> 3) * G, wave, lane);
        const int later = nsteps - 1 - k;
        if (later >= 3) asm volatile("s_waitcnt vmcnt(12)" ::: "memory");
        else if (later == 2) asm volatile("s_waitcnt vmcnt(8)" ::: "memory");
        else if (later == 1) asm volatile("s_waitcnt vmcnt(4)" ::: "memory"); else asm volatile("s_waitcnt vmcnt(0)" ::: "memory");
        __builtin_amdgcn_s_barrier(); asm volatile("" ::: "memory");
        const int h = (unit >> 5) & 3;
        int co = c; asm volatile("" : "+v"(co));
        const int xq = (q ^ co) << 4;
        const LAS unsigned char* lb = buf + co * 256;
        if (type == 0) {
#pragma unroll
            for (int ks = 0; ks < 4; ++ks) qf[ks] = *(const LAS bf16x8*)(lb + wave * 4096 + (xq ^ (ks << 6)));
        } else if (type == 1) {
#pragma unroll
            for (int st = 0; st < 8; ++st) {
                f32x4 a = (f32x4){0.f, 0.f, 0.f, 0.f};
                if (st <= wave) {
#pragma unroll
                    for (int ks = 0; ks < 4; ++ks) { const bf16x8 kf = *(const LAS bf16x8*)(lb + st * 4096 + (xq ^ (ks << 6))); a = MFMA16(kf, qf[ks], a); }
#pragma unroll
                    for (int rr = 0; rr < 4; ++rr) { const int s = 16 * st + 4 * q + rr; a[rr] = (cl >= s) ? a[rr] : 0.f; }
                }
                sT[st] = a;
            }
        } else if (type < 4) {
            const float gam = GAMMA_OF(h);
#pragma unroll
            for (int e8 = 0; e8 < 8; ++e8) {
                f32x4 a = (f32x4){0.f, 0.f, 0.f, 0.f};
#pragma unroll
                for (int ks = 0; ks < 4; ++ks) { const bf16x8 sf = *(const LAS bf16x8*)(lb + e8 * 4096 + (xq ^ (ks << 6))); a = MFMA16(sf, qf[ks], a); }
                o[e8] = a * gam;
            }
            if (type == 2) {
#pragma unroll
                for (int e8 = 0; e8 < 8; ++e8) o[8 + e8] = o[e8];
            }
        } else if (type < 6) {
            const int x0 = (4 * q + (co >> 2)) & 7;
            const LAS unsigned char* vb = buf + (4 * q + (co >> 2)) * 512 + (co & 3) * 8;
            const int pbase = (type & 1) * 2;
#pragma unroll
            for (int pp = 0; pp < 2; ++pp) {
                if (2 * (pbase + pp) <= wave) {
                    const f32x4 ta = sT[2 * pp], tb = sT[2 * pp + 1];
                    v4u pw; pw.x = pk2(ta[0], ta[1]); pw.y = pk2(ta[2], ta[3]); pw.z = pk2(tb[0], tb[1]); pw.w = pk2(tb[2], tb[3]);
                    const bf16x8 pb = __builtin_bit_cast(bf16x8, pw);
#pragma unroll
                    for (int r = 0; r < 16; ++r) { const int et = r ^ 8, po = (((et & 7) ^ x0) << 5) + ((et & 8) << 5);
                        const bf16x8 va = tr_pair(vb + pp * 32 * 512 + po, vb + pp * 32 * 512 + 16 * 512 + po); o[r] = MFMA16(va, pb, o[r]); }
                }
            }
            if (type == 4) {
#pragma unroll
                for (int i = 0; i < 4; ++i) sT[i] = sT[4 + i];
            } else {
                float sm = 0.f;
#pragma unroll
                for (int r = 0; r < 16; ++r) sm += (o[r][0] + o[r][1]) + (o[r][2] + o[r][3]);
                sm += __shfl_xor(sm, 16); sm += __shfl_xor(sm, 32);
                mu = sm * (1.0f / 256.0f);
                float vs = 0.f;
#pragma unroll
                for (int r = 0; r < 16; ++r) { const f32x4 d = o[r] - mu; vs += (d[0] * d[0] + d[1] * d[1]) + (d[2] * d[2] + d[3] * d[3]); }
                vs += __shfl_xor(vs, 16); vs += __shfl_xor(vs, 32);
                rs = __builtin_amdgcn_rsqf(vs * (1.0f / 256.0f) + EPS);
            }
        } else if ((type == 6) == (wave < 4)) {
            const int n = unit & 31, bb = unit >> 7; const size_t tok = (size_t)(bb * SEQ + 128 * n + cl);
            bf16* orow = ao + tok * 1536 + 512 + h * 256 + 4 * q;
            const LAS unsigned char* gb = buf + (cl & 63) * 512 + 8 * q;
            const LAS float* gl = (const LAS float*)(lds + RING_BYTES) + h * 256 + 4 * q;
            const int xr = cl & 7; const float murs = mu * rs;
#pragma unroll
            for (int r = 0; r < 16; ++r) { const int et = r ^ 8;
                const u32x2 gv = *(const LAS u32x2*)(gb + ((((et & 7) ^ xr) | (et & 8)) << 5)); const f32x4 gg = *(const LAS f32x4*)(gl + 16 * et);
                typedef float f2_t __attribute__((ext_vector_type(2)));
                const f2_t ga = (f2_t){bf2f(gv.x & 0xffffu), __uint_as_float(gv.x & 0xffff0000u)}, gb_ = (f2_t){bf2f(gv.y & 0xffffu), __uint_as_float(gv.y & 0xffff0000u)};
                const f2_t xa = ga * -1.4426950408889634f, xb = gb_ * -1.4426950408889634f;
                f2_t ea, eb; ea.x = __builtin_amdgcn_exp2f(xa.x); ea.y = __builtin_amdgcn_exp2f(xa.y); eb.x = __builtin_amdgcn_exp2f(xb.x); eb.y = __builtin_amdgcn_exp2f(xb.y);
                const f2_t da = ea + 1.0f, db = eb + 1.0f; f2_t sa, sb; sa.x = __builtin_amdgcn_rcpf(da.x); sa.y = __builtin_amdgcn_rcpf(da.y); sb.x = __builtin_amdgcn_rcpf(db.x); sb.y = __builtin_amdgcn_rcpf(db.y);
                const f2_t ta = ((f2_t){o[r][0], o[r][1]} * rs - murs) * (f2_t){gg.x, gg.y} * ga * sa, tb = ((f2_t){o[r][2], o[r][3]} * rs - murs) * (f2_t){gg.z, gg.w} * gb_ * sb;
                const float y0 = ta.x, y1 = ta.y, y2 = tb.x, y3 = tb.y;
                u32x2 w; w.x = pk2(y0, y1); w.y = pk2(y2, y3); *(GAS u32x2*)(orow + 16 * et) = w;
            }
            last_store = k;
        }
        asm volatile("s_waitcnt lgkmcnt(0)" ::: "memory"); __builtin_amdgcn_s_barrier(); asm volatile("" ::: "memory");
    }
}

__device__ __forceinline__ void mix_dma(LAS unsigned char* buf, int k, const bf16* proj, int bx, int wave, int lane) {
    asm volatile("" : "+v"(lane));
    if (k == 0) {
        const int kh = bx & 1, n = (bx >> 1) & 31, bb = bx >> 6, rb = bb * SEQ + 128 * n;
#pragma unroll
        for (int i = 0; i < 8; ++i) {
            const int ins = wave * 8 + i, P = (ins * 64 + lane) & 2047, r = P >> 3, cp = P & 7, isv = ins >> 5;
            const int ch = isv ? ((((cp >> 1) ^ ((r >> 1) & 3)) << 1) | (cp & 1)) : (cp ^ (r & 7));
            const int grow = (n == 0 && r < 128) ? rb + r : rb - 128 + r;
            const char* src = (const char*)(proj + (size_t)grow * DIN + (isv ? C_VA : C_KA) + kh * 64) + ch * 16;
            __builtin_amdgcn_global_load_lds((const unsigned*)src, (LAS unsigned*)(buf + ins * 1024), 16, 0, 0);
        }
    } else {
        const int unit = bx + 256 * ((k - 1) >> 1), half = (k - 1) & 1;
        const int n = unit & 31, h = (unit >> 5) & 3, bb = unit >> 7, rb = bb * SEQ + 128 * n + 64 * half;
#pragma unroll
        for (int i = 0; i < 6; ++i) {
            const int ins = wave * 6 + i; const char* src;
            if (ins < 16) { const int P = ins * 64 + lane, r = P >> 4, cp = P & 15, ch = (((cp >> 1) ^ (r & 7)) << 1) | (cp & 1); src = (const char*)(proj + (size_t)(rb + r) * DIN + C_KR + h * 128) + ch * 16; }
            else { const int P = (ins - 16) * 64 + lane, r = P >> 5, cp = P & 31, ch = (((cp >> 1) ^ (r & 7)) << 1) | (cp & 1); src = (const char*)(proj + (size_t)(rb + r) * DIN + C_VR + h * 256) + ch * 16; }
            __builtin_amdgcn_global_load_lds((const unsigned*)src, (LAS unsigned*)(buf + ins * 1024), 16, 0, 0);
        }
    }
}
__device__ __forceinline__ void mix_phase(LAS unsigned char* lds, const bf16* proj, bf16* ao, bf16* kvbuf, const float* biastab, const float* sinks_l, int bx, int wave, int lane) {
    { LAS float* bl = (LAS float*)(lds + RING_BYTES + 4096); const int khh = bx & 1;
      for (int t = wave * 64 + lane; t < 640; t += 512) { const int h4 = t / 160, x = t % 160 - 16; bl[t] = (x >= 0 && x < 128) ? ((const GAS float*)biastab)[(khh * 4 + h4) * 128 + (127 - x)] * 1.4426950408889634f : 0.f; } }
    const int c = lane & 15, q = lane >> 4;
    mix_dma(lds, 0, proj, bx, wave, lane);
    {
        const int kh = bx & 1, an = (bx >> 1) & 31, abb = bx >> 6, arb = abb * SEQ + 128 * an;
        const int g = wave >> 1, qh = wave & 1, head = kh * 4 + g;
        bf16x8 qf[4][2];
#pragma unroll
        for (int qs = 0; qs < 4; ++qs) { const bf16* qsrc = proj + (size_t)(arb + 64 * qh + 16 * qs + c) * DIN + C_QA + head * 64 + 8 * q;
            qf[qs][0] = *(const GAS bf16x8*)(qsrc); qf[qs][1] = *(const GAS bf16x8*)(qsrc + 32); }
        const float sink = ((const GAS float*)sinks_l)[head];
        mix_dma(lds + 65536, 1, proj, bx, wave, lane); asm volatile("s_waitcnt vmcnt(6)" ::: "memory");
        __builtin_amdgcn_s_barrier(); asm volatile("" ::: "memory");
        int co = c; asm volatile("" : "+v"(co));
        const LAS unsigned char* buf = lds;
        const int db = 128 + co - 4 * q;
        const LAS float* tb = (const LAS float*)(lds + RING_BYTES + 4096) + g * 160 + (143 - db);
        const float sink2 = sink * 1.4426950408889634f;
        const int kx0 = (q ^ (co & 7)) << 4, kx1 = kx0 ^ 64;
        const LAS unsigned char* Kb = buf + co * 128;
        const LAS unsigned char* Vb = buf + 32768 + ((co & 1) << 4);
        const int vph = (co >> 1) & 1;
#pragma unroll 1
        for (int qs = 0; qs < 4; ++qs) {
            const int i0 = 64 * qh + 16 * qs, i = i0 + c;
            const bf16x8 q0 = qs == 0 ? qf[0][0] : qs == 1 ? qf[1][0] : qs == 2 ? qf[2][0] : qf[3][0], q1 = qs == 0 ? qf[0][1] : qs == 1 ? qf[1][1] : qs == 2 ? qf[2][1] : qf[3][1];
            f32x4 s[9];
#pragma unroll
            for (int kt = 0; kt < 9; ++kt) {
                const LAS unsigned char* kp = Kb + (i0 + 16 * kt) * 128;
                f32x4 a = (f32x4){0.f, 0.f, 0.f, 0.f};
                a = MFMA16(*(const LAS bf16x8*)(kp + kx0), q0, a); a = MFMA16(*(const LAS bf16x8*)(kp + kx1), q1, a); s[kt] = a;
            }
            float mx = -3.0e38f;
#pragma unroll
            for (int kt = 0; kt < 9; ++kt)
#pragma unroll
                for (int r = 0; r < 4; ++r) { const int K = 16 * kt + r;
                    float v = s[kt][r] * (0.125f * 1.4426950408889634f) + tb[K];
                    if (kt == 0) v = (K > db - 128) ? v : -1.0e30f;
                    if (kt == 8) v = (K <= db) ? v : -1.0e30f;
                    s[kt][r] = v; }
            if (an == 0) {
#pragma unroll
                for (int kt = 0; kt < 9; ++kt)
#pragma unroll
                    for (int r = 0; r < 4; ++r) s[kt][r] = (i0 + 16 * kt + 4 * q + r >= 128) ? s[kt][r] : -1.0e30f;
            }
#pragma unroll
            for (int kt = 0; kt < 9; ++kt) mx = fmaxf(fmaxf(mx, fmaxf(s[kt][0], s[kt][1])), fmaxf(s[kt][2], s[kt][3]));
            mx = fmaxf(mx, __shfl_xor(mx, 16)); mx = fmaxf(mx, __shfl_xor(mx, 32)); mx = fmaxf(mx, sink2);
            float sum = 0.f;
#pragma unroll
            for (int kt = 0; kt < 9; ++kt)
#pragma unroll
                for (int r = 0; r < 4; ++r) { const float pe = __builtin_amdgcn_exp2f(s[kt][r] - mx); s[kt][r] = pe; sum += pe; }
            sum += __shfl_xor(sum, 16); sum += __shfl_xor(sum, 32);
            const float inv = __builtin_amdgcn_rcpf(sum + __builtin_amdgcn_exp2f(sink2 - mx));
            f32x4 o[4];
#pragma unroll
            for (int dt = 0; dt < 4; ++dt) o[dt] = (f32x4){0.f, 0.f, 0.f, 0.f};
#pragma unroll
            for (int p = 0; p < 5; ++p) {
                const f32x4 ta = s[2 * p], tb = (2 * p + 1 < 9) ? s[2 * p + 1 < 9 ? 2 * p + 1 : 8] : (f32x4){0.f, 0.f, 0.f, 0.f};
                v4u pw; pw.x = pk2(ta[0], ta[1]); pw.y = pk2(ta[2], ta[3]); pw.z = pk2(tb[0], tb[1]); pw.w = pk2(tb[2], tb[3]);
                const bf16x8 pb = __builtin_bit_cast(bf16x8, pw);
                int r0 = i0 + 32 * p + 4 * q + (co >> 2), r1 = r0 + 16; r1 = r1 > 255 ? 255 : r1;
                const LAS unsigned char* v0 = Vb + r0 * 128; const LAS unsigned char* v1 = Vb + r1 * 128;
                const int x0 = (r0 >> 1) & 3, x1 = (r1 >> 1) & 3;
#pragma unroll
                for (int dt = 0; dt < 4; ++dt) { const int pr = 2 * (dt >> 1) + vph; const bf16x8 va = tr_pair(v0 + ((pr ^ x0) << 5) + 8 * (dt & 1), v1 + ((pr ^ x1) << 5) + 8 * (dt & 1)); o[dt] = MFMA16(va, pb, o[dt]); }
            }
            bf16* orow = ao + (size_t)(arb + i) * 1536 + head * 64 + 8 * q;
#pragma unroll
            for (int j = 0; j < 2; ++j) { const f32x4 a0 = o[2 * j] * inv, a1 = o[2 * j + 1] * inv; v4u w; w.x = pk2(a0[0], a0[1]); w.y = pk2(a0[2], a0[3]); w.z = pk2(a1[0], a1[1]); w.w = pk2(a1[2], a1[3]); *(GAS v4u*)(orow + 32 * j) = w; }
        }
        asm volatile("s_waitcnt lgkmcnt(0)" ::: "memory"); __builtin_amdgcn_s_barrier(); asm volatile("" ::: "memory");
    }
    f32x4 acc[2][8];
#pragma unroll
    for (int ei = 0; ei < 2; ++ei)
#pragma unroll
        for (int dt = 0; dt < 8; ++dt) acc[ei][dt] = (f32x4){0.f, 0.f, 0.f, 0.f};
    for (int k = 1; k < 5; ++k) {
        const LAS unsigned char* buf = lds + (k & 1) * 65536;
        if (k + 1 < 5) { mix_dma(lds + ((k + 1) & 1) * 65536, k + 1, proj, bx, wave, lane); asm volatile("s_waitcnt vmcnt(6)" ::: "memory"); }
        else asm volatile("s_waitcnt vmcnt(0)" ::: "memory");
        if (k > 1) { __builtin_amdgcn_s_barrier(); asm volatile("" ::: "memory"); }
        else { __builtin_amdgcn_s_barrier(); asm volatile("" ::: "memory"); }
        int co = c; asm volatile("" : "+v"(co));
        const int unit = bx + 256 * ((k - 1) >> 1), half = (k - 1) & 1, h = (unit >> 5) & 3;
        const int rl = 4 * q + (co >> 2), x0 = rl & 7;
        const LAS unsigned char* kb = buf + rl * 256 + ((co & 1) << 4);
        const LAS unsigned char* vb = buf + 16384 + rl * 512 + (co & 3) * 8;
        const int ph = (co >> 1) & 1;
#pragma unroll
        for (int ks = 0; ks < 2; ++ks) {
            bf16x8 bfr[2];
#pragma unroll
            for (int ei = 0; ei < 2; ++ei) { const int et = 2 * wave + ei, po = (((et & 7) ^ x0) << 5) + ((et & 8) << 5); bfr[ei] = tr_pair(vb + ks * 32 * 512 + po, vb + ks * 32 * 512 + 16 * 512 + po); }
#pragma unroll
            for (int dt = 0; dt < 8; ++dt) { const int po = (((2 * (dt >> 1) + ph) ^ x0) << 5) + 8 * (dt & 1); const bf16x8 af = tr_pair(kb + ks * 32 * 256 + po, kb + ks * 32 * 256 + 16 * 256 + po);
#pragma unroll
                for (int ei = 0; ei < 2; ++ei) acc[ei][dt] = MFMA16(af, bfr[ei], acc[ei][dt]); }
        }
        if (half == 1) {
            const float g127 = GAMMA127_OF(h);
#pragma unroll
            for (int ei = 0; ei < 2; ++ei) { const int e = 16 * (2 * wave + ei) + c; bf16* dst = kvbuf + ((size_t)unit * 256 + e) * 128 + 8 * q;
#pragma unroll
                for (int j = 0; j < 4; ++j) { const f32x4 a0 = acc[ei][2 * j] * g127, a1 = acc[ei][2 * j + 1] * g127;
                    v4u w; w.x = pk2(a0[0], a0[1]); w.y = pk2(a0[2], a0[3]); w.z = pk2(a1[0], a1[1]); w.w = pk2(a1[2], a1[3]); *(GAS v4u*)(dst + 32 * j) = w;
                    acc[ei][2 * j] = (f32x4){0.f, 0.f, 0.f, 0.f}; acc[ei][2 * j + 1] = (f32x4){0.f, 0.f, 0.f, 0.f}; } }
        }
        asm volatile("s_waitcnt lgkmcnt(0)" ::: "memory"); __builtin_amdgcn_s_barrier(); asm volatile("" ::: "memory");
    }
}

struct Args { const float* in[16]; float* out; unsigned char* ws; int ph_lo, ph_hi; };
__global__ void __launch_bounds__(NWAVES * 64, 2) skel_fwd(Args args) {
    extern __shared__ __attribute__((aligned(16))) unsigned char lds_raw[];
    LAS unsigned char* lds = (LAS unsigned char*)lds_raw;
    volatile LAS unsigned* MISC = (volatile LAS unsigned*)(lds + MISC_OFF);
    const int G = 256, bx = blockIdx.x; __builtin_assume(bx >= 0 && bx < 256);
    const int NGW = G * NWAVES, NGT = G * NWAVES * 64;
#define PH_IDS int tid = threadIdx.x; asm volatile("" : "+v"(tid)); const int lane = tid & 63, wave = __builtin_amdgcn_readfirstlane(tid >> 6), gw = bx * NWAVES + wave, gt = bx * (NWAVES * 64) + tid; int bxp = bx; asm volatile("" : "+s"(bxp)); (void)lane; (void)wave; (void)gw; (void)gt; (void)bxp;
    unsigned char* ws = args.ws;
    gu32* ctl = (gu32*)(ws + WS_CTL);
#if MK_ONE_LAUNCH
    constexpr int lo = 0, hi = N_PHASES;
#else
    const int lo = args.ph_lo, hi = args.ph_hi;
#endif
    if (threadIdx.x < 64) MISC[threadIdx.x] = 0u;
#ifdef PROBE_EPI
    if (threadIdx.x == 0) { ((volatile LAS unsigned long long*)(lds + MISC_OFF + 1024))[0] = 0ull; ((volatile LAS unsigned long long*)(lds + MISC_OFF + 1024))[1] = 0ull; }
#endif
    if (threadIdx.x == 0) { LAS unsigned long long* pt = (LAS unsigned long long*)(lds + MISC_OFF + 512);
#pragma unroll
        for (int i = 0; i < 16; ++i) pt[i] = (unsigned long long)args.in[i];
        pt[16] = (unsigned long long)args.out; pt[17] = (unsigned long long)args.ws; }
    __syncthreads();
    if (hi - lo > 1) (void)xcd_barrier_post((unsigned*)(ctl + CW_BAR), MISC + 8);
#define BAR_NOW() do { XcdBarrier b_; b_.bar = (unsigned*)((gu32*)((unsigned char*)ldptr(17) + WS_CTL) + CW_BAR); b_.x = xb_xcc_id(); b_.st = (volatile LAS unsigned*)(lds + MISC_OFF) + 8; xcd_barrier(b_); } while (0)
#ifndef PHMASK
#define PHMASK 0xFFFF
#endif
#define PHM(b) ((PHMASK >> (b)) & 1)
#ifndef REPMASK
#define REPMASK 0
#endif
#define REP(b) for (int rep_ = 0; rep_ <= ((REPMASK >> (b)) & 1); ++rep_)
#define IN(k) (lo <= (k) && (k) < hi)
#ifdef PROBE_PH
    unsigned long long tprev = __builtin_amdgcn_s_memrealtime(), psum = 0ull;
#define SEAM(k) do { if ((k) + 1 < hi) BAR_NOW(); { const unsigned long long now_ = __builtin_amdgcn_s_memrealtime(); const int ty_ = (k) == 0 ? 0 : ((k) - 1) % PH_PER + 1;     if (ty_ == PROBE_PH) psum += now_ - tprev; tprev = now_; } } while (0)
#else
#define SEAM(k) do { if ((k) + 1 < hi) BAR_NOW(); } while (0)
#endif

    auto ldptr = [&](int i) -> unsigned long long { unsigned ao_ = (unsigned)(MISC_OFF + 512 + 8 * i); asm volatile("" : "+v"(ao_));
        const unsigned long long v = *(const volatile LAS unsigned long long*)(lds + ao_);
        return ((unsigned long long)(unsigned)__builtin_amdgcn_readfirstlane((int)(v >> 32)) << 32) | (unsigned)__builtin_amdgcn_readfirstlane((int)(unsigned)v); };
#define INP(i) ((const float*)ldptr(i))
#define PH_BASE unsigned char* wq = (unsigned char*)ldptr(17);
#define WSP(T, off) ((T*)(wq + (off)))
#define RS_FILL(S_, statp, pmvar, qsp) int pmvar = -1; { pg8::Unit u0_; (void)(S_).next(0, u0_); { pmvar = u0_.pm; int t_ = threadIdx.x; asm volatile("" : "+v"(t_)); if (t_ < 256) { const pg8::f32x4 sv_ = *(const GAS pg8::f32x4*)((statp) + (size_t)(u0_.pm * 256 + t_) * 4); ((LAS float*)(lds + RING_BYTES + 8192))[t_] = __builtin_amdgcn_rsqf(((sv_[0] + sv_[1]) + (sv_[2] + sv_[3])) * (1.0f / 1024.0f) + EPS) * ((qsp) ? ((const GAS float*)(qsp))[u0_.pm * 256 + t_] : 1.0f); } } } __syncthreads();
#define RS_FILLQ(S_, statp, qsp) { pg8::Unit u0_; (void)(S_).next(0, u0_); { int t_ = threadIdx.x; asm volatile("" : "+v"(t_)); const int r_ = u0_.pm * 256 + (t_ & 255); const pg8::f32x4 sv_ = *(const GAS pg8::f32x4*)((statp) + (size_t)r_ * 4); ((LAS float*)(lds + RING_BYTES + 8192))[t_] = __builtin_amdgcn_rsqf(((sv_[0] + sv_[1]) + (sv_[2] + sv_[3])) * (1.0f / 1024.0f) + EPS) * (((qsp) && t_ >= 256) ? ((const GAS float*)(qsp))[r_] : 1.0f); } } __syncthreads();
#define RS_FILL2(S_, statp, pmvar, qsp) int pmvar = -1; { pg8::Unit u0_; (void)(S_).next(0, u0_); { pmvar = u0_.pm; int t_ = threadIdx.x; asm volatile("" : "+v"(t_)); const int pr_ = u0_.pm + 8 * (t_ >> 8); if (pr_ < M / 256) { const pg8::f32x4 sv_ = *(const GAS pg8::f32x4*)((statp) + (size_t)(pr_ * 256 + (t_ & 255)) * 4); ((LAS float*)(lds + RING_BYTES + 8192))[t_] = __builtin_amdgcn_rsqf(((sv_[0] + sv_[1]) + (sv_[2] + sv_[3])) * (1.0f / 1024.0f) + EPS) * ((qsp) ? ((const GAS float*)(qsp))[pr_ * 256 + (t_ & 255)] : 1.0f); } } } __syncthreads();

#define SEL_IN8 ColSel{88, 24, 96, 3, 12}
#define SEL_INB ColSel{96, 0, 24, 1 << 20, 0}
#define WAMAX_P(L_, mi) ((unsigned*)(WSP(unsigned, WS_CTL) + CW_WAMAX + (L_) * 512 + (mi) * 256))
#define CONVERT_A(L_, gwv, ngwv) { LAS float* scr = (LAS float*)(lds + wave * 16384); bf16* wl = WSP(bf16, WS_W) + (size_t)(L_) * W_LAYER; \
        if (PG_I8_P1) p0_amax(INP(2) + (size_t)(L_) * D * DIN, D, DIN, (gwv), (ngwv), lane, 2, INP(1) + (L_) * D, WAMAX_P(L_, 0), SEL_IN8); \
        if (PG_I8_UP) p0_amax(INP(11) + (size_t)(L_) * D * NUP, D, NUP, (gwv), (ngwv), lane, 1, INP(10) + (L_) * D, WAMAX_P(L_, 1), ColSel{NUP / 32, NUP / 32, 0, 1 << 20, 0}); \
        p0_matrix<false>(INP(6) + (size_t)(L_) * 512 * D, 512, D, wl + W_OA, 1536, scr, (gwv), (ngwv), lane, 3, nullptr); \
        p0_matrix<false>(INP(7) + (size_t)(L_) * D * D, D, D, wl + W_OA + 512, 1536, scr, (gwv), (ngwv), lane, 3, nullptr); \
        p0_matrix<false>(INP(14) + (size_t)(L_) * DFF * D, DFF, D, wl + W_DN, DFF, scr, (gwv), (ngwv), lane, 3, nullptr); }
#define CONVERT_B(L_, gwv, ngwv) { LAS float* scr = (LAS float*)(lds + wave * 16384); bf16* wl = WSP(bf16, WS_W) + (size_t)(L_) * W_LAYER; \
        if (PG_I8_P1) { p0_matrix_sel<true>(INP(2) + (size_t)(L_) * D * DIN, D, DIN, wl + W_IN8, D, scr, (gwv), (ngwv), lane, 2, INP(1) + (L_) * D, WAMAX_P(L_, 0), SEL_IN8); \
                        p0_matrix_sel<false>(INP(2) + (size_t)(L_) * D * DIN, D, DIN, wl + W_IN, D, scr, (gwv), (ngwv), lane, 2, INP(1) + (L_) * D, nullptr, SEL_INB); } \
        else p0_matrix<false>(INP(2) + (size_t)(L_) * D * DIN, D, DIN, wl + W_IN, D, scr, (gwv), (ngwv), lane, 2, INP(1) + (L_) * D); \
        if (PG_I8_UP) p0_matrix<true>(INP(11) + (size_t)(L_) * D * NUP, D, NUP, wl + W_UP, D, scr, (gwv), (ngwv), lane, 1, INP(10) + (L_) * D, WAMAX_P(L_, 1)); \
        else p0_matrix<false>(INP(11) + (size_t)(L_) * D * NUP, D, NUP, wl + W_UP, D, scr, (gwv), (ngwv), lane, 1, INP(10) + (L_) * D); \
        p0_matrix<false>(INP(8) + (size_t)(L_) * D * D, D, D, wl + W_O, D, scr, (gwv), (ngwv), lane, 3, nullptr); }
    if (PHM(0) && IN(0)) { PH_IDS PH_BASE
        CONVERT_A(0, gw, NGW)
        float* biastab = WSP(float, WS_BIAS); float* costab = WSP(float, WS_COS); float* sintab = WSP(float, WS_SIN);
        for (int t = gt; t < 1024; t += NGT) { const int head = t >> 7, dist = t & 127;
            int bucket = dist; if (dist >= 16) { bucket = 16 + (int)(log2f((float)dist * (1.0f / 16.0f)) * (16.0f / 3.0f)); bucket = bucket > 31 ? 31 : bucket; }
            ((GAS float*)biastab)[t] = ((const GAS float*)INP(4))[bucket * 8 + head]; }
        for (int t = gt; t < SEQ * 64; t += NGT) { const int pos = t >> 6, i = t & 63;
            const float fr = exp2f(-(float)i * (13.287712379549449f / 64.0f)); const float ang = (float)pos * fr;
            const double kk = rint((double)ang * 0.15915494309189535); const float rr = (float)((double)ang - kk * 6.283185307179586);
            ((GAS float*)costab)[t] = __cosf(rr); ((GAS float*)sintab)[t] = __sinf(rr); }
        xg_rows(INP(0), WSP(bf16, WS_XN), WSP(float, WS_STAT), WSP(signed char, WS_XQ), WSP(float, WS_QS), WSP(float, WS_AMX), gw, NGW, lane);
        xg_rows(INP(0) + (size_t)MH * D, WSP(bf16, WS_XN1), WSP(float, WS_STAT + 256 * 1024), WSP(signed char, WS_XQ) + (size_t)MH * D, WSP(float, WS_QS) + MH, WSP(float, WS_AMX) + (size_t)MH * 4, gw, NGW, lane);
        if (PG_I8_P1 || PG_I8_UP) BAR_NOW();
        CONVERT_B(0, gw, NGW)
        SEAM(0);
    }

    for (int l = 0; l < DEPTH; ++l) {
        const int pl = 1 + l * PH_PER;
#define WL (WSP(bf16, WS_W) + (size_t)l * W_LAYER)
#define XNP WSP(bf16, (hf ? WS_XN1 : WS_XN))
#define STAT_MIX WSP(float, WS_STAT + (size_t)hf * 256 * 1024)
#define STAT_FFN WSP(float, WS_STAT + (size_t)(2 + hf) * 256 * 1024)
#define AMX_MIX (WSP(float, WS_AMX) + (size_t)hf * MH * 4)
#define AMX_FFN (WSP(float, WS_AMX + 512 * 1024) + (size_t)hf * MH * 4)
        for (int hf = 0; hf < 2; ++hf) {
            const int pb = pl + hf * 6;
            const int einst = (l * 2 + hf) * 2;
#ifdef PROBE_XBAR
            if (IN(pb + 0)) { for (int xb_ = 0; xb_ < PROBE_XBAR; ++xb_) BAR_NOW(); }
#endif
            if (PHM(2) && IN(pb + 0)) { PH_BASE
                const float* qsh = PG_I8_P1 ? WSP(float, WS_QS) + (size_t)hf * MH : nullptr;
                if (PG_I8_P1) {
                    pg8::StaticOrder S; S.init(MH, 12 * 256, G, bx);
                    RS_FILLQ(S, STAT_MIX, qsh)
                    { pg8::Gemm g{XNP, WL + W_IN + (size_t)3 * 256 * D, MH, 12 * 256, D};
                      pg8::EpiBf16Rs<false, 0, 3, 0> E{WSP(bf16, WS_RA), DIN, WSP(float, WS_COS), WSP(float, WS_SIN), nullptr};
                      pg8::gemm_phase<pg8::EpiBf16Rs<false, 0, 3, 0>, pg8::StaticOrder, PG_ALIGN_P1, PG_SP2_P1>(lds, g, S, E); }
                    { pg8::StaticOrder S2; S2.init(MH, 11 * 256, G, bx);
                      pg8::Gemm g{(const bf16*)(WSP(signed char, WS_XQ) + (size_t)hf * MH * D), WL + W_IN8, MH, 11 * 256, D / 2};
                      pg8::EpiBf16Rs<true, 3, 12, 256> E{WSP(bf16, WS_RA), DIN, WSP(float, WS_COS), WSP(float, WS_SIN), WAMAX_P(l, 0)};
                      pg8::gemm_phase<pg8::EpiBf16Rs<true, 3, 12, 256>, pg8::StaticOrder, PG_ALIGN_P1, PG_SP2_P1>(lds, g, S2, E); }
                } else {
                    pg8::Gemm g{XNP, WL + W_IN, MH, DIN, D}; pg8::StaticOrder S; S.init(MH, DIN, G, bx);
                    RS_FILLQ(S, STAT_MIX, qsh)
                    pg8::EpiBf16Rs<false, 0, 0, 0> E{WSP(bf16, WS_RA), DIN, WSP(float, WS_COS), WSP(float, WS_SIN), nullptr};
                    pg8::gemm_phase<pg8::EpiBf16Rs<false, 0, 0, 0>, pg8::StaticOrder, PG_ALIGN_P1, PG_SP2_P1>(lds, g, S, E);
                }
                { int bxo = bx; asm volatile("" : "+s"(bxo));
                  if (l + 1 < DEPTH && bxo >= 192) { PH_IDS if (hf == 0) CONVERT_A(l + 1, (bxo - 192) * NWAVES + wave, 512) else CONVERT_B(l + 1, (bxo - 192) * NWAVES + wave, 512) } }
                SEAM(pb + 0);
            }
            if (PHM(3) && IN(pb + 1)) { PH_IDS PH_BASE
                mix_phase(lds, WSP(bf16, WS_RA), WSP(bf16, WS_AOA), WSP(bf16, WS_KV), WSP(float, WS_BIAS), INP(3) + l * 8, bxp, wave, lane);
                SEAM(pb + 1);
            }
            if (PHM(4) && IN(pb + 2)) { PH_IDS PH_BASE scan_phase(WSP(bf16, WS_KV), gt, NGT); SEAM(pb + 2); }
            if (PHM(5) && IN(pb + 3)) { PH_IDS PH_BASE
                ret_phase(lds, WSP(bf16, WS_RA), WSP(bf16, WS_KV), WSP(bf16, WS_AOA), INP(5) + l * 1024, bxp, G, wave, lane);
                SEAM(pb + 3);
            }
            if (PHM(6) && IN(pb + 4)) { PH_BASE
                pg8::Gemm g{WSP(bf16, WS_AOA), WL + W_OA, MH, D, 1536}; pg8::StaticOrder S; S.init(MH, D, G, bx);
                pg8::EpiGate2 E{WSP(bf16, WS_MG), D, WSP(bf16, WS_RA) + C_GA, WSP(bf16, WS_RA) + C_GT, DIN};
                pg8::gemm_phase<pg8::EpiGate2, pg8::StaticOrder, true, true>(lds, g, S, E);
                SEAM(pb + 4);
            }
            if (PHM(7) && IN(pb + 5)) { PH_BASE
                pg8::Gemm g{WSP(bf16, WS_MG), WL + W_O, MH, D, D}; pg8::StaticOrder S; S.init(MH, D, G, bx);
                pg8::PanelRms st{WSP(unsigned, WS_XSLOT), (unsigned*)(WSP(unsigned, WS_CTL) + CW_SEAM + (size_t)einst * 4096), WSP(unsigned, WS_CTL), EPS, 0x700u, AMX_MIX, WSP(float, WS_QS) + (size_t)hf * MH};
                pg8::EpiRmsRes<PG_I8_UP> E{XNP, nullptr, D, INP(9) + l * D, STAT_FFN, WSP(signed char, WS_XQ) + (size_t)hf * MH * D, AMX_FFN, st};
                pg8::gemm_phase<pg8::EpiRmsRes<PG_I8_UP>, pg8::StaticOrder, false, true>(lds, g, S, E);
                if (hf == 1) SEAM(pb + 5);
            }
        }
        if (PHM(9) && IN(pl + 12)) { PH_BASE
            pg8::Gemm g{PG_I8_UP ? (const bf16*)WSP(signed char, WS_XQ) : WSP(bf16, WS_XN), WL + W_UP, M, NUP, PG_I8_UP ? D / 2 : D}; pg8::StaticOrder S; S.init(M, NUP, G, bx);
            const float* qsf = PG_I8_UP ? WSP(float, WS_QS) : nullptr;
            RS_FILL2(S, WSP(float, WS_STAT + 2 * 256 * 1024), pmc, qsf)
#ifdef STAGGER_UP
            {
                const unsigned long long t0_ = __builtin_amdgcn_s_memrealtime(); const unsigned long long dl_ = (unsigned long long)(((bx >> 3) & 3) * STAGGER_UP);
                while (__builtin_amdgcn_s_memrealtime() - t0_ < dl_) __builtin_amdgcn_s_sleep(4);
            }
#endif
            pg8::EpiConv E{WSP(bf16, WS_G), WSP(bf16, WS_H), INP(12) + (size_t)l * 3 * DFF, INP(13) + (size_t)l * DFF, DFF, WSP(float, WS_STAT + 2 * 256 * 1024), EPS, pmc, qsf, WAMAX_P(l, 1)};
            pg8::gemm_phase<pg8::EpiConv, pg8::StaticOrder, PG_ALIGN_UP, true>(lds, g, S, E);
            SEAM(pl + 12);
        }
        for (int hf = 0; hf < 2; ++hf) {
            const int einst = (l * 2 + hf) * 2;
            if (PHM(11) && IN(pl + 13 + hf)) { PH_BASE
                bf16* Gh = WSP(bf16, WS_G) + (size_t)hf * MH * DFF; bf16* Hh = WSP(bf16, WS_H) + (size_t)hf * (MH / 64) * 6 * DFF;
                pg8::Gemm g{Gh, WL + W_DN, MH, D, DFF}; pg8::StaticOrder S; S.init(MH, D, G, bx);
                { pg8::Unit u0; int tf_ = threadIdx.x; asm volatile("" : "+v"(tf_)); (void)S.next(0, u0); conv_fixup(Hh, Gh, INP(12) + (size_t)l * 3 * DFF, INP(13) + (size_t)l * DFF, u0.pm, tf_); }
                asm volatile("s_waitcnt vmcnt(0)" ::: "memory"); __syncthreads();
                pg8::PanelRms st{WSP(unsigned, WS_XSLOT + 512 * 1024), (unsigned*)(WSP(unsigned, WS_CTL) + CW_SEAM + (size_t)(einst + 1) * 4096), WSP(unsigned, WS_CTL), EPS, 0x780u, AMX_FFN, WSP(float, WS_QS) + (size_t)hf * MH};
                pg8::EpiRmsRes<PG_I8_P1> E{XNP, (l + 1 < DEPTH) ? nullptr : (float*)ldptr(16) + (size_t)hf * MH * D, D, INP(15) + l * D, STAT_MIX, WSP(signed char, WS_XQ) + (size_t)hf * MH * D, AMX_MIX, st};
                pg8::gemm_phase<pg8::EpiRmsRes<PG_I8_P1>, pg8::StaticOrder, false, true>(lds, g, S, E);
                if (hf == 1) SEAM(pl + 13 + hf);
            }
        }
    }
#ifdef PROBE_EPI
    if (bx == 0 && threadIdx.x == 0) { const unsigned long long ps_ = ((volatile LAS unsigned long long*)(lds + MISC_OFF + 1024))[PROBE_EPI_MODE]; const unsigned long long t0_ = __builtin_amdgcn_s_memrealtime(); while (__builtin_amdgcn_s_memrealtime() - t0_ < (unsigned long long)PROBE_AMP * ps_) __builtin_amdgcn_s_sleep(8); }
#endif
#ifdef PROBE_PH
    if (bx == 0) { const unsigned long long t0_ = __builtin_amdgcn_s_memrealtime(); while (__builtin_amdgcn_s_memrealtime() - t0_ < (unsigned long long)PROBE_AMP * psum) __builtin_amdgcn_s_sleep(8); }
#endif
#undef IN
#undef SEAM
}

extern "C" void kernel_launch(void* const* d_in, const int* in_sizes, int n_in, void* d_out, int out_size, void* d_ws, size_t ws_size, hipStream_t stream) {
    static int grid = 0;
    if (grid == 0) {
        if (n_in != 16 || in_sizes[0] != M * D || out_size != M * D || ws_size < WS_END) { fprintf(stderr, "kernel_launch: unexpected shapes / workspace (n_in %d, ws %zu < %zu)\n", n_in, ws_size, (size_t)WS_END); grid = -1; return; }
        int dev = 0, cus = 0, per_cu = 0;
        if (hipGetDevice(&dev) != hipSuccess || hipDeviceGetAttribute(&cus, hipDeviceAttributeMultiprocessorCount, dev) != hipSuccess) { grid = -1; return; }
        if (hipFuncSetAttribute((const void*)skel_fwd, hipFuncAttributeMaxDynamicSharedMemorySize, LDS_BYTES) != hipSuccess) { fprintf(stderr, "kernel_launch: hipFuncSetAttribute failed\n"); grid = -1; return; }
        if (hipOccupancyMaxActiveBlocksPerMultiprocessor(&per_cu, (const void*)skel_fwd, NWAVES * 64, LDS_BYTES) != hipSuccess || per_cu < 1) fprintf(stderr, "kernel_launch: occupancy query reports %d\n", per_cu);
        (void)hipGetLastError();
        grid = cus;
        if (grid != 256) { fprintf(stderr, "kernel_launch: this kernel needs exactly 256 CUs (one 256x256 unit per workgroup in the fused-norm GEMM phases), got %d\n", grid); grid = -1; return; }
    }
    if (grid < 0) return;
    (void)hipMemsetAsync((char*)d_ws + WS_CTL, 0, CTL_ZERO_BYTES, stream);
    Args a{};
    for (int i = 0; i < 16; ++i) a.in[i] = (const float*)d_in[i];
    a.out = (float*)d_out; a.ws = (unsigned char*)d_ws;
#if MK_ONE_LAUNCH
    a.ph_lo = 0; a.ph_hi = N_PHASES;
    hipLaunchKernelGGL(skel_fwd, dim3(grid), dim3(NWAVES * 64), LDS_BYTES, stream, a);
#else
    for (int p = 0; p < N_PHASES; ++p) { a.ph_lo = p; a.ph_hi = p + 1; hipLaunchKernelGGL(skel_fwd, dim3(grid), dim3(NWAVES * 64), LDS_BYTES, stream, a); }
#endif
}
```

```cpp
#include <hip/hip_runtime.h>
#include <cstdio>
#include <cstdint>
#include <cmath>
#define MK_ONE_LAUNCH 1
#define PG_ALIGN_P1 true
#define PG_ALIGN_UP true
#define PG_NST 16
#define PG_SP2_P1 true
#define PG_I8_P1 true
#define PG_I8_UP true
__device__ __forceinline__ float gsel4(int h, float a, float b, float c, float d) { return h == 0 ? a : (h == 1 ? b : (h == 2 ? c : d)); }
#define GAMMA_OF(h) gsel4((h), 0.96875f, 0.984375f, 0.9921875f, 0.99609375f)
#define LOG2_GAMMA_OF(h) gsel4((h), -0.04580368961312479f, -0.02272007650008353f, -0.011315313227834146f, -0.005646563141142063f)
#define GAMMA127_OF(h) gsel4((h), 0.01773731465374751f, 0.13532968927456346f, 0.3693230522678801f, 0.6083133121044885f)
#define GAMMA128_OF(h) gsel4((h), 0.017183023570817902f, 0.1332151628796484f, 0.3664377159220373f, 0.6059370882290803f)
namespace pg8 {
#define PG8_LAS __attribute__((address_space(3)))
typedef unsigned short bf16_t;
typedef short bf16x8 __attribute__((ext_vector_type(8)));
typedef float f32x4 __attribute__((ext_vector_type(4)));
typedef unsigned u32x4 __attribute__((ext_vector_type(4)));
typedef int i32x4 __attribute__((ext_vector_type(4)));
typedef unsigned u32x2 __attribute__((ext_vector_type(2)));
constexpr int BM = 256, BK = 64, HALF = 128, HTB = HALF * BK * 2  , STAGE_BYTES = 8 * HTB, NXCD = 8, WGM = 8;

__host__ __device__ __forceinline__ int lds_byte(int r, int c) { const int st = (r >> 4) * 2 + (c >> 5), rr = r & 15, cc = c & 31, ob = rr * 64 + cc * 2; return st * 1024 + (ob ^ (((ob >> 9) & 1) << 5)); }
__host__ __device__ __forceinline__ void stage_rc(int b, int& R, int& C) { const int st = b / 1024, sb = b % 1024, swz = sb ^ (((sb >> 9) & 1) << 5); R = (st >> 1) * 16 + swz / 64; C = (st & 1) * 32 + (swz % 64) / 2; }
__host__ __device__ __forceinline__ int perm32(int rho) { const int n = rho >> 4, i = rho & 15; return 8 * (i >> 2) + 4 * n + (i & 3); }

struct Unit { int pm, pn; };
struct Gemm { const bf16_t* A; const bf16_t* Bt; int M, N, K; };

struct StaticOrder {
    int nM, nN, nwg, G, c;
    __host__ __device__ __forceinline__ void init(int M, int N, int G_, int c_) { nM = M / BM; nN = N / BM; nwg = nM * nN; G = G_; c = c_; }
    __host__ __device__ __forceinline__ bool next(int i, Unit& u) const {
        const long L = (long)i * G + c; if (L >= nwg) return false;
        int wgid = (int)L; { const int q = nwg / NXCD, r = nwg % NXCD, xcd = wgid % NXCD, off = wgid / NXCD; wgid = (xcd < r ? xcd * (q + 1) : r * (q + 1) + (xcd - r) * q) + off; }
        const int nig = WGM * nN, gid = wgid / nig, fm = gid * WGM, gsz = (nM - fm) < WGM ? (nM - fm) : WGM;
        u.pm = fm + ((wgid % nig) % gsz); u.pn = (wgid % nig) / gsz; return true;
    }
    __device__ __forceinline__ void a_ready(const Unit&) const {}
    __device__ __forceinline__ void done(const Unit&) const {}
};

__device__ __forceinline__ unsigned cvt_pk_bf16(float lo, float hi) { unsigned r; asm volatile("v_cvt_pk_bf16_f32 %0, %1, %2" : "=v"(r) : "v"(lo), "v"(hi)); return r; }
typedef float f32x2 __attribute__((ext_vector_type(2)));
__device__ __forceinline__ f32x2 gelu_pk(f32x2 v) {
    const f32x2 av = __builtin_elementwise_abs(v), d = av * 0.2316418882f + 1.0f;
    f32x2 t; t.x = __builtin_amdgcn_rcpf(d.x); t.y = __builtin_amdgcn_rcpf(d.y);
    f32x2 q = t * 0.5307027145f + (-0.7265760135f); q = q * t + 0.7107068705f; q = q * t + (-0.142248368f); q = q * t + 0.127414796f; q = q * t;
    const f32x2 s = (v * v) * (-0.72134752044f);
    f32x2 e; e.x = __builtin_amdgcn_exp2f(s.x); e.y = __builtin_amdgcn_exp2f(s.y);
    const f32x2 m = v * (q * e), r = v - m;
    f32x2 o; o.x = v.x < 0.f ? m.x : r.x; o.y = v.y < 0.f ? m.y : r.y; return o;
}

template <int ACT  > struct EpiBf16 {
    static constexpr bool PERM = true, AFTER_DRAIN = false, HAS_MID = false, I8 = false; static constexpr int MID_T = -1, NST = 0, PID = 0; static_assert(ACT == 0 || ACT == 1, "EpiBf16: ACT is 0 (none) or 1 (gelu_pk)");
    bf16_t* O; int ldc; const float* bias; int split_cols; size_t split_stride; float scale0;
    __device__ __forceinline__ void operator()(const f32x4 (&acc)[2][2][4][2], const Unit& u, int wr, int wc, int fr, int fq) const {
        const int row0 = u.pm * BM + wr * 64 + fr; int colt = u.pn * BM; bf16_t* base = O;
        float sc = 1.f; if (split_cols) { const int t = colt / split_cols; base += (size_t)t * split_stride; colt -= t * split_cols; if (t == 0) sc = scale0; }
        const int col0 = colt + wc * 32 + 8 * fq, bcol0 = u.pn * BM + wc * 32 + 8 * fq;
        f32x4 bv[2][2];
#pragma unroll
        for (int bj = 0; bj < 2; ++bj)
#pragma unroll
            for (int n = 0; n < 2; ++n) bv[bj][n] = bias ? *(const f32x4*)(bias + bcol0 + bj * HALF + 4 * n) : (f32x4){0.f, 0.f, 0.f, 0.f};
#pragma unroll
        for (int ai = 0; ai < 2; ++ai)
#pragma unroll
            for (int m = 0; m < 4; ++m) { bf16_t* rowp = base + (size_t)(row0 + ai * HALF + m * 16) * ldc + col0;
#pragma unroll
                for (int bj = 0; bj < 2; ++bj) { f32x4 v0 = acc[ai][bj][m][0] + bv[bj][0], v1 = acc[ai][bj][m][1] + bv[bj][1];
                    if (ACT == 1) { f32x2 a = gelu_pk((f32x2){v0[0], v0[1]}), b = gelu_pk((f32x2){v0[2], v0[3]}), c = gelu_pk((f32x2){v1[0], v1[1]}), d = gelu_pk((f32x2){v1[2], v1[3]});
                        v0 = (f32x4){a.x, a.y, b.x, b.y}; v1 = (f32x4){c.x, c.y, d.x, d.y}; }
                    v0 = v0 * sc; v1 = v1 * sc; u32x4 w; w.x = cvt_pk_bf16(v0[0], v0[1]); w.y = cvt_pk_bf16(v0[2], v0[3]); w.z = cvt_pk_bf16(v1[0], v1[1]); w.w = cvt_pk_bf16(v1[2], v1[3]);
                    *(u32x4*)(rowp + bj * HALF) = w; } }
    }
};

template <class Epi, class Sched, bool ALIGN_EPI = false, bool SP2 = false>
__device__ __forceinline__ void gemm_phase(PG8_LAS unsigned char* lds, const Gemm g, const Sched& S, const Epi& E) {
    int tid_o = threadIdx.x; asm volatile("" : "+v"(tid_o));
    const int tid = tid_o, wid = __builtin_amdgcn_readfirstlane(tid >> 6), lane = tid & 63, wr = wid >> 2, wc = wid & 3, fr = lane & 15, fq = lane >> 4;
    const int K = g.K, nt = K / BK;
    unsigned voffA[2], voffB[2];
#pragma unroll
    for (int i = 0; i < 2; ++i) { int R, C; stage_rc(tid * 16 + i * 8192, R, C); const int Rb = Epi::PERM ? ((R & ~31) + perm32(R & 31)) : R;
        voffA[i] = (unsigned)(R * K + C) * 2u; voffB[i] = (unsigned)(Rb * K + C) * 2u; }
    const size_t kstep = (size_t)(BK * 2);
    const size_t hstep = (size_t)HALF * K * 2;
    const size_t tstep = 2 * hstep;
    const unsigned ldsw = (unsigned)wid * 1024u;
    const int aoff = lds_byte(wr * 64 + fr, fq * 8), boff = lds_byte(wc * 32 + fr, fq * 8);
#define PG8_SA(b, h) (((b) * 2 + (h)) * HTB)
#define PG8_SB(b, h) ((4 + (b) * 2 + (h)) * HTB)
#define PG8_STAGE(bufoff, gbase, voff) do { _Pragma("unroll") for (int _i = 0; _i < 2; ++_i) \
        __builtin_amdgcn_global_load_lds((const unsigned*)((const char*)(gbase) + (voff)[_i]), (PG8_LAS unsigned*)(lds + (bufoff) + ldsw + _i * 8192), 16, 0, 0); } while (0)
#define PG8_LDA(dst, b, h) do { _Pragma("unroll") for (int m = 0; m < 4; ++m) _Pragma("unroll") for (int k = 0; k < 2; ++k) dst[m][k] = *(const PG8_LAS bf16x8*)(lds + PG8_SA(b, h) + aoff + m * 2048 + k * 1024); } while (0)
#define PG8_LDB(dst, b, h) do { _Pragma("unroll") for (int n = 0; n < 2; ++n) _Pragma("unroll") for (int k = 0; k < 2; ++k) dst[n][k] = *(const PG8_LAS bf16x8*)(lds + PG8_SB(b, h) + boff + n * 2048 + k * 1024); } while (0)
#define PG8_MMA(ai, bj, At, Bt) do { __builtin_amdgcn_s_setprio(1); _Pragma("unroll") for (int m = 0; m < 4; ++m) _Pragma("unroll") for (int n = 0; n < 2; ++n) _Pragma("unroll") for (int k = 0; k < 2; ++k) \
        { if constexpr (Epi::I8) acc[ai][bj][m][n] = __builtin_bit_cast(f32x4, __builtin_amdgcn_mfma_i32_16x16x64_i8(__builtin_bit_cast(i32x4, Bt[n][k]), __builtin_bit_cast(i32x4, At[m][k]), __builtin_bit_cast(i32x4, acc[ai][bj][m][n]), 0, 0, 0)); \
          else acc[ai][bj][m][n] = __builtin_amdgcn_mfma_f32_16x16x32_bf16(Bt[n][k], At[m][k], acc[ai][bj][m][n], 0, 0, 0); } __builtin_amdgcn_s_setprio(0); } while (0)
#define PG8_WAIT_V(n) asm volatile("s_waitcnt vmcnt(" #n ")" ::: "memory")
#define PG8_WAIT_L(n) asm volatile("s_waitcnt lgkmcnt(" #n ")" ::: "memory")
#define PG8_BAR __builtin_amdgcn_s_barrier()
#define PG8_SCHED __builtin_amdgcn_sched_barrier(0)
    Unit cur, nxt; int ui = 0;
    if (!S.next(0, cur)) return;
#ifdef PROBE_EPI
    unsigned long long pe_prev = __builtin_amdgcn_s_memrealtime();
#endif
    f32x4 acc[2][2][4][2];
#pragma unroll
    for (int a = 0; a < 2; ++a)
#pragma unroll
        for (int b = 0; b < 2; ++b)
#pragma unroll
            for (int m = 0; m < 4; ++m)
#pragma unroll
                for (int n = 0; n < 2; ++n) acc[a][b][m][n] = (f32x4){0.f, 0.f, 0.f, 0.f};
    bf16x8 At[4][2], B0[2][2], B1[2][2];
    const char* cA = (const char*)g.A + (size_t)cur.pm * tstep; const char* cB = (const char*)g.Bt + (size_t)cur.pn * tstep;
    S.a_ready(cur);
    if constexpr (SP2) {
        PG8_STAGE(PG8_SB(0, 0), cB, voffB); PG8_STAGE(PG8_SB(0, 1), cB + hstep, voffB); PG8_STAGE(PG8_SA(0, 0), cA, voffA); PG8_STAGE(PG8_SA(0, 1), cA + hstep, voffA);
        if (wr == 1) PG8_BAR;
        PG8_WAIT_V(2); PG8_BAR;
        PG8_STAGE(PG8_SB(1, 0), cB + kstep, voffB); PG8_STAGE(PG8_SA(1, 0), cA + kstep, voffA); PG8_STAGE(PG8_SB(1, 1), cB + hstep + kstep, voffB);
        PG8_WAIT_V(6); PG8_BAR;
    } else {
        PG8_STAGE(PG8_SB(0, 0), cB, voffB); PG8_STAGE(PG8_SA(0, 0), cA, voffA); PG8_STAGE(PG8_SB(0, 1), cB + hstep, voffB); PG8_STAGE(PG8_SA(0, 1), cA + hstep, voffA);
        if (wr == 1) PG8_BAR;
        PG8_WAIT_V(4); PG8_BAR;
        PG8_STAGE(PG8_SB(1, 0), cB + kstep, voffB); PG8_STAGE(PG8_SA(1, 0), cA + kstep, voffA); PG8_STAGE(PG8_SB(1, 1), cB + hstep + kstep, voffB);
        PG8_WAIT_V(6); PG8_BAR;
    }
#ifndef PG8_EARLY
#define PG8_EARLY PG8_STAGE(PG8_SA(1, 1), nA + kstep + hstep, voffA);
#endif
    int fresh = 0;
    for (;;) {
        const bool has_next = S.next(ui + 1, nxt);
        const char* nA = has_next ? (const char*)g.A + (size_t)nxt.pm * tstep : cA; const char* nB = has_next ? (const char*)g.Bt + (size_t)nxt.pn * tstep : cB;
        for (int t = 0; t < nt; t += 2) {
            const bool last = (t == nt - 2);
            const char* a1 = cA + (size_t)(t + 1) * kstep;
            const char* a2 = last ? nA : cA + (size_t)(t + 2) * kstep; const char* b2 = last ? nB : cB + (size_t)(t + 2) * kstep;
            const char* a3 = a2 + kstep; const char* b3 = b2 + kstep;
            if (last && has_next) S.a_ready(nxt);
            if constexpr (SP2) {
            int fresh_now = 0;
            if constexpr (Epi::NST != 0) { int tt = t; asm volatile("" : "+s"(tt)); fresh_now = (tt == 0) ? fresh : 0; }
#define PG8_WAIT_VF() do { static_assert(Epi::NST == 0 || Epi::NST == 14 || Epi::NST == 16, "NST"); \
        if constexpr (Epi::NST == 16) asm volatile("s_waitcnt vmcnt(26)\n\ts_cmp_lg_u32 %0, 0\n\ts_cbranch_scc1 .Lpg8f%=\n\ts_waitcnt vmcnt(8)\n.Lpg8f%=:" :: "s"(fresh_now) : "memory", "scc"); \
        else if constexpr (Epi::NST == 14) asm volatile("s_waitcnt vmcnt(24)\n\ts_cmp_lg_u32 %0, 0\n\ts_cbranch_scc1 .Lpg8g%=\n\ts_waitcnt vmcnt(8)\n.Lpg8g%=:" :: "s"(fresh_now) : "memory", "scc"); \
        else PG8_WAIT_V(8); } while (0)
            PG8_LDB(B0, 0, 0); PG8_LDB(B1, 0, 1); PG8_SCHED; PG8_LDA(At, 0, 0); PG8_STAGE(PG8_SA(1, 1), a1 + hstep, voffA);
            PG8_WAIT_VF(); PG8_WAIT_L(0); PG8_BAR; PG8_MMA(0, 0, At, B0); PG8_MMA(0, 1, At, B1); PG8_BAR; PG8_SCHED;
            PG8_LDA(At, 0, 1); PG8_STAGE(PG8_SB(0, 0), b2, voffB); PG8_STAGE(PG8_SB(0, 1), b2 + hstep, voffB); PG8_STAGE(PG8_SA(0, 0), a2, voffA);
            PG8_WAIT_VF(); PG8_WAIT_L(0); PG8_BAR; PG8_MMA(1, 0, At, B0); PG8_MMA(1, 1, At, B1); PG8_BAR; PG8_SCHED;
            PG8_LDB(B0, 1, 0); PG8_LDB(B1, 1, 1); PG8_SCHED; PG8_LDA(At, 1, 0); PG8_STAGE(PG8_SA(0, 1), a2 + hstep, voffA);
            PG8_WAIT_VF(); PG8_WAIT_L(0); PG8_BAR; PG8_MMA(0, 0, At, B0); PG8_MMA(0, 1, At, B1); PG8_BAR; PG8_SCHED;
            PG8_LDA(At, 1, 1); PG8_STAGE(PG8_SB(1, 0), b3, voffB); PG8_STAGE(PG8_SB(1, 1), b3 + hstep, voffB); PG8_STAGE(PG8_SA(1, 0), a3, voffA);
            PG8_WAIT_V(8); PG8_WAIT_L(0); PG8_BAR; PG8_MMA(1, 0, At, B0); PG8_MMA(1, 1, At, B1); PG8_BAR; PG8_SCHED;
#undef PG8_WAIT_VF
            } else {
            PG8_LDB(B0, 0, 0); PG8_SCHED; PG8_LDA(At, 0, 0); PG8_STAGE(PG8_SA(1, 1), a1 + hstep, voffA);
            PG8_WAIT_L(8); PG8_BAR; PG8_WAIT_L(0); PG8_MMA(0, 0, At, B0); PG8_BAR; PG8_SCHED;
            PG8_LDB(B1, 0, 1); PG8_STAGE(PG8_SB(0, 0), b2, voffB);
            PG8_BAR; PG8_WAIT_L(0); PG8_MMA(0, 1, At, B1); PG8_BAR;
            PG8_LDA(At, 0, 1); PG8_STAGE(PG8_SA(0, 0), a2, voffA);
            PG8_BAR; PG8_WAIT_L(0); PG8_MMA(1, 0, At, B0); PG8_BAR; PG8_SCHED;
            PG8_STAGE(PG8_SB(0, 1), b2 + hstep, voffB);
            PG8_WAIT_V(6); PG8_BAR; PG8_MMA(1, 1, At, B1); PG8_BAR;
            PG8_LDB(B0, 1, 0); PG8_SCHED; PG8_LDA(At, 1, 0); PG8_STAGE(PG8_SA(0, 1), a2 + hstep, voffA);
            PG8_WAIT_L(8); PG8_BAR; PG8_WAIT_L(0); PG8_MMA(0, 0, At, B0); PG8_BAR; PG8_SCHED;
            PG8_LDB(B1, 1, 1); PG8_STAGE(PG8_SB(1, 0), b3, voffB);
            PG8_BAR; PG8_WAIT_L(0); PG8_MMA(0, 1, At, B1); PG8_BAR;
            PG8_LDA(At, 1, 1); PG8_STAGE(PG8_SA(1, 0), a3, voffA);
            PG8_BAR; PG8_WAIT_L(0); PG8_MMA(1, 0, At, B0); PG8_BAR; PG8_SCHED;
            PG8_STAGE(PG8_SB(1, 1), b3 + hstep, voffB);
            PG8_WAIT_V(6); PG8_BAR; PG8_MMA(1, 1, At, B1); PG8_BAR;
            }
            if constexpr (Epi::HAS_MID) { if (t == Epi::MID_T) E.mid(acc, cur, wr, wc, fr, fq); }
        }
#ifdef PROBE_EPI
        const unsigned long long pe_t0 = __builtin_amdgcn_s_memrealtime();
#endif
        if constexpr (ALIGN_EPI) { if (wr == 0) PG8_BAR; }
        if constexpr (SP2 && ALIGN_EPI && Epi::NST != 0) { PG8_EARLY fresh = 1; }
        if constexpr (Epi::I8) {
#pragma unroll
            for (int a = 0; a < 2; ++a)
#pragma unroll
                for (int b = 0; b < 2; ++b)
#pragma unroll
                    for (int m = 0; m < 4; ++m)
#pragma unroll
                        for (int n = 0; n < 2; ++n) acc[a][b][m][n] = __builtin_convertvector(__builtin_bit_cast(i32x4, acc[a][b][m][n]), f32x4);
        }
        if constexpr (!Epi::AFTER_DRAIN) { E(acc, cur, wr, wc, fr, fq); S.done(cur); }
#ifdef PROBE_EPI
        if constexpr (Epi::PID == PROBE_EPI) { const unsigned long long now_ = __builtin_amdgcn_s_memrealtime();
            if (tid == 0) { volatile PG8_LAS unsigned long long* pa_ = (volatile PG8_LAS unsigned long long*)(lds + 143360 + 1024); pa_[0] += now_ - pe_t0; pa_[1] += now_ - pe_prev; }
            pe_prev = now_; }
#endif
        if (!has_next) break;
#pragma unroll
        for (int a = 0; a < 2; ++a)
#pragma unroll
            for (int b = 0; b < 2; ++b)
#pragma unroll
                for (int m = 0; m < 4; ++m)
#pragma unroll
                    for (int n = 0; n < 2; ++n) acc[a][b][m][n] = (f32x4){0.f, 0.f, 0.f, 0.f};
        cur = nxt; cA = nA; cB = nB; ++ui;
        if constexpr (ALIGN_EPI) { if (wr == 1) PG8_BAR; }
    }
    PG8_WAIT_V(0);
    if constexpr (!ALIGN_EPI) { if (wr == 0) PG8_BAR; }
    PG8_BAR;
    if constexpr (Epi::AFTER_DRAIN) { E.fused(acc, cur, wr, wc, fr, fq, lds, wid, lane); S.done(cur); }
#undef PG8_SA
#undef PG8_SB
#undef PG8_STAGE
#undef PG8_LDA
#undef PG8_LDB
#undef PG8_MMA
#undef PG8_WAIT_V
#undef PG8_WAIT_L
#undef PG8_BAR
#undef PG8_SCHED
}
}
namespace pg8 {
#define PG8_GAS __attribute__((address_space(1)))
#define ST16(p, v) (*(PG8_GAS u32x4*)(p) = (v))
constexpr int RSL_OFF = 131072 + 8192;
__device__ __forceinline__ const PG8_LAS float* rs_lds() { extern __shared__ __attribute__((aligned(16))) unsigned char lds_dyn_[]; return (const PG8_LAS float*)((PG8_LAS unsigned char*)lds_dyn_ + RSL_OFF); }
__device__ __forceinline__ void pair_swap(const u32x4 w0, const u32x4 w1, int odd, u32x4& dA, u32x4& dB) {
    const u32x4 snd = odd ? w0 : w1; u32x4 rcv;
    rcv.x = (unsigned)__builtin_amdgcn_update_dpp(0, (int)snd.x, 0xB1, 0xf, 0xf, false); rcv.y = (unsigned)__builtin_amdgcn_update_dpp(0, (int)snd.y, 0xB1, 0xf, 0xf, false);
    rcv.z = (unsigned)__builtin_amdgcn_update_dpp(0, (int)snd.z, 0xB1, 0xf, 0xf, false); rcv.w = (unsigned)__builtin_amdgcn_update_dpp(0, (int)snd.w, 0xB1, 0xf, 0xf, false);
    dA = odd ? rcv : w0; dB = odd ? w1 : rcv;
}
__device__ __forceinline__ float bfbits2f(unsigned b16) { return __uint_as_float(b16 << 16); }
__device__ __forceinline__ float sigmoidf_(float x) { return __builtin_amdgcn_rcpf(1.0f + __builtin_amdgcn_exp2f(x * -1.4426950408889634f)); }
struct EpiGateA {
    static constexpr bool PERM = true, AFTER_DRAIN = false, HAS_MID = false, I8 = false; static constexpr int MID_T = -1, NST = 0, PID = 0;
    bf16_t* O; int ldc; const bf16_t* gate; int ldg;
    __device__ __forceinline__ void operator()(const f32x4 (&acc)[2][2][4][2], const Unit& u, int wr, int wc, int fr, int fq) const {
        const int row0 = u.pm * BM + wr * 64 + fr, col0 = u.pn * BM + wc * 32 + 8 * fq;
#pragma unroll
        for (int ai = 0; ai < 2; ++ai)
#pragma unroll
            for (int m = 0; m < 4; ++m) { const size_t r = (size_t)(row0 + ai * HALF + m * 16);
#pragma unroll
                for (int bj = 0; bj < 2; ++bj) { const int c = col0 + bj * HALF;
                    const u32x4 gv = *(const PG8_GAS u32x4*)(gate + r * ldg + c);
                    const f32x4 v0 = acc[ai][bj][m][0], v1 = acc[ai][bj][m][1];
                    float o[8];
                    o[0] = v0[0] * sigmoidf_(bfbits2f(gv.x & 0xffffu)); o[1] = v0[1] * sigmoidf_(bfbits2f(gv.x >> 16));
                    o[2] = v0[2] * sigmoidf_(bfbits2f(gv.y & 0xffffu)); o[3] = v0[3] * sigmoidf_(bfbits2f(gv.y >> 16));
                    o[4] = v1[0] * sigmoidf_(bfbits2f(gv.z & 0xffffu)); o[5] = v1[1] * sigmoidf_(bfbits2f(gv.z >> 16));
                    o[6] = v1[2] * sigmoidf_(bfbits2f(gv.w & 0xffffu)); o[7] = v1[3] * sigmoidf_(bfbits2f(gv.w >> 16));
                    u32x4 w; w.x = cvt_pk_bf16(o[0], o[1]); w.y = cvt_pk_bf16(o[2], o[3]); w.z = cvt_pk_bf16(o[4], o[5]); w.w = cvt_pk_bf16(o[6], o[7]);
                    *(PG8_GAS u32x4*)(O + r * ldc + c) = w; }
                if (m == 3) asm volatile("" ::: "memory"); }
    }
};
struct EpiGateR {
    static constexpr bool PERM = true, AFTER_DRAIN = false, HAS_MID = false, I8 = false; static constexpr int MID_T = -1, NST = 0, PID = 0;
    bf16_t* O; int ldc; const bf16_t* gate; int ldg;
    __device__ __forceinline__ void operator()(const f32x4 (&acc)[2][2][4][2], const Unit& u, int wr, int wc, int fr, int fq) const {
        const int row0 = u.pm * BM + wr * 64 + fr, col0 = u.pn * BM + wc * 32 + 8 * fq;
#pragma unroll
        for (int ai = 0; ai < 2; ++ai)
#pragma unroll
            for (int m = 0; m < 4; ++m) { const size_t r = (size_t)(row0 + ai * HALF + m * 16);
#pragma unroll
                for (int bj = 0; bj < 2; ++bj) { const int c = col0 + bj * HALF;
                    const u32x4 gv = *(const PG8_GAS u32x4*)(gate + r * ldg + c);
                    const u32x4 tv = *(const PG8_GAS u32x4*)(O + r * ldc + c);
                    const f32x4 v0 = acc[ai][bj][m][0], v1 = acc[ai][bj][m][1];
                    float o[8];
                    o[0] = bfbits2f(tv.x & 0xffffu) + v0[0] * sigmoidf_(bfbits2f(gv.x & 0xffffu)); o[1] = bfbits2f(tv.x >> 16) + v0[1] * sigmoidf_(bfbits2f(gv.x >> 16));
                    o[2] = bfbits2f(tv.y & 0xffffu) + v0[2] * sigmoidf_(bfbits2f(gv.y & 0xffffu)); o[3] = bfbits2f(tv.y >> 16) + v0[3] * sigmoidf_(bfbits2f(gv.y >> 16));
                    o[4] = bfbits2f(tv.z & 0xffffu) + v1[0] * sigmoidf_(bfbits2f(gv.z & 0xffffu)); o[5] = bfbits2f(tv.z >> 16) + v1[1] * sigmoidf_(bfbits2f(gv.z >> 16));
                    o[6] = bfbits2f(tv.w & 0xffffu) + v1[2] * sigmoidf_(bfbits2f(gv.w & 0xffffu)); o[7] = bfbits2f(tv.w >> 16) + v1[3] * sigmoidf_(bfbits2f(gv.w >> 16));
                    u32x4 w; w.x = cvt_pk_bf16(o[0], o[1]); w.y = cvt_pk_bf16(o[2], o[3]); w.z = cvt_pk_bf16(o[4], o[5]); w.w = cvt_pk_bf16(o[6], o[7]);
                    *(PG8_GAS u32x4*)(O + r * ldc + c) = w; }
                if (m == 3) asm volatile("" ::: "memory"); }
    }
};
struct EpiF32 {
    static constexpr bool PERM = true, AFTER_DRAIN = false, HAS_MID = false, I8 = false; static constexpr int MID_T = -1, NST = 0, PID = 0;
    float* O; int ldc;
    __device__ __forceinline__ void operator()(const f32x4 (&acc)[2][2][4][2], const Unit& u, int wr, int wc, int fr, int fq) const {
        const int row0 = u.pm * BM + wr * 64 + fr, col0 = u.pn * BM + wc * 32 + 8 * fq;
#pragma unroll
        for (int ai = 0; ai < 2; ++ai)
#pragma unroll
            for (int m = 0; m < 4; ++m) { float* rowp = O + (size_t)(row0 + ai * HALF + m * 16) * ldc + col0;
#pragma unroll
                for (int bj = 0; bj < 2; ++bj) { *(PG8_GAS f32x4*)(rowp + bj * HALF) = acc[ai][bj][m][0]; *(PG8_GAS f32x4*)(rowp + bj * HALF + 4) = acc[ai][bj][m][1]; } }
    }
};

__device__ __forceinline__ float dpp_f(float v, int ctrl_sel) {
    const int iv = __builtin_bit_cast(int, v); int r;
    switch (ctrl_sel) { case 0: r = __builtin_amdgcn_update_dpp(0, iv, 0x111, 0xf, 0xf, true); break;
                        case 1: r = __builtin_amdgcn_update_dpp(0, iv, 0x112, 0xf, 0xf, true); break;
                        case 2: r = __builtin_amdgcn_update_dpp(0, iv, 0x10F, 0xf, 0xf, true); break;
                        default: r = __builtin_amdgcn_update_dpp(0, iv, 0x10E, 0xf, 0xf, true); break; }
    return __builtin_bit_cast(float, r);
}
__device__ __forceinline__ float gelu_tanh_f(float x) { const float u2 = 1.5957691216057308f * (x + 0.044715f * x * x * x); return x * __builtin_amdgcn_rcpf(1.0f + __expf(-u2)); }
struct EpiConv {
    static constexpr bool PERM = true, AFTER_DRAIN = false, HAS_MID = false, I8 = PG_I8_UP; static constexpr int MID_T = -1, NST = PG_NST ? 14 : 0  , PID = 1;
    bf16_t* G; bf16_t* H; const float* cw; const float* cb; int dff; const float* stat; float eps; int pmc;
    const float* qs; const unsigned* wsc;
    __device__ __forceinline__ void operator()(const f32x4 (&acc)[2][2][4][2], const Unit& u, int wr, int wc, int fr, int fq) const {
        const int colb = u.pn * HALF + wc * 32 + 8 * fq;
        float ts0 = 1.0f, ts1 = 1.0f;
        if constexpr (I8) { ts0 = __uint_as_float(((const PG8_GAS unsigned*)wsc)[u.pn * 8 + wc]) * (1.0f / 127.0f); ts1 = __uint_as_float(((const PG8_GAS unsigned*)wsc)[u.pn * 8 + 4 + wc]) * (1.0f / 127.0f); }
        f32x2 w02[4], w12[4], w22[4], wb2[4];
#pragma unroll
        for (int h = 0; h < 2; ++h) { const f32x4 a = *(const PG8_GAS f32x4*)(cw + colb + 4 * h), b = *(const PG8_GAS f32x4*)(cw + dff + colb + 4 * h), c = *(const PG8_GAS f32x4*)(cw + 2 * dff + colb + 4 * h), d = *(const PG8_GAS f32x4*)(cb + colb + 4 * h);
            w02[2 * h] = (f32x2){a[0], a[1]}; w02[2 * h + 1] = (f32x2){a[2], a[3]}; w12[2 * h] = (f32x2){b[0], b[1]}; w12[2 * h + 1] = (f32x2){b[2], b[3]};
            w22[2 * h] = (f32x2){c[0], c[1]}; w22[2 * h + 1] = (f32x2){c[2], c[3]}; wb2[2 * h] = (f32x2){d[0], d[1]}; wb2[2 * h + 1] = (f32x2){d[2], d[3]}; }
#pragma unroll
        for (int ai = 0; ai < 2; ++ai) {
            const int row64 = u.pm * BM + ai * HALF + wr * 64, grp = row64 >> 6;
            float rsc[4];
            {
                const int tb_ = (u.pm == pmc) ? 0 : 256;
#pragma unroll
                for (int m = 0; m < 4; ++m) rsc[m] = rs_lds()[tb_ + ((row64 + m * 16 + fr) & 255)];
            }
            float rsv[4];
#pragma unroll
            for (int m = 0; m < 4; ++m) { rsv[m] = rsc[m] * ts1; rsc[m] *= ts0; }
            if (fr >= 14) { const f32x4 v0 = acc[ai][0][3][0] * rsc[3], v1 = acc[ai][0][3][1] * rsc[3]; u32x4 w; w.x = cvt_pk_bf16(v0[0], v0[1]); w.y = cvt_pk_bf16(v0[2], v0[3]); w.z = cvt_pk_bf16(v1[0], v1[1]); w.w = cvt_pk_bf16(v1[2], v1[3]);
                *(PG8_GAS u32x4*)(H + (size_t)(grp * 6 + (fr - 14)) * dff + colb) = w; }
            if (fr < 2) { const f32x4 v0 = acc[ai][0][0][0] * rsc[0], v1 = acc[ai][0][0][1] * rsc[0], x0 = acc[ai][1][0][0] * rsv[0], x1 = acc[ai][1][0][1] * rsv[0]; u32x4 w, x;
                w.x = cvt_pk_bf16(v0[0], v0[1]); w.y = cvt_pk_bf16(v0[2], v0[3]); w.z = cvt_pk_bf16(v1[0], v1[1]); w.w = cvt_pk_bf16(v1[2], v1[3]);
                x.x = cvt_pk_bf16(x0[0], x0[1]); x.y = cvt_pk_bf16(x0[2], x0[3]); x.z = cvt_pk_bf16(x1[0], x1[1]); x.w = cvt_pk_bf16(x1[2], x1[3]);
                *(PG8_GAS u32x4*)(H + (size_t)(grp * 6 + 2 + fr) * dff + colb) = w; *(PG8_GAS u32x4*)(H + (size_t)(grp * 6 + 4 + fr) * dff + colb) = x; }
            f32x2 ap[4];
#pragma unroll
            for (int pr = 0; pr < 4; ++pr) ap[pr] = (f32x2){0.f, 0.f};
#pragma unroll
            for (int m = 0; m < 4; ++m) {
                f32x2 o2[4];
#pragma unroll
                for (int pr = 0; pr < 4; ++pr) { const int n = pr >> 1, i = (pr & 1) * 2;
                    const f32x2 a2 = (f32x2){acc[ai][0][m][n][i], acc[ai][0][m][n][i + 1]} * rsc[m];
                    const f32x2 v2 = (f32x2){acc[ai][1][m][n][i], acc[ai][1][m][n][i + 1]} * rsv[m];
                    f32x2 p1 = (f32x2){dpp_f(a2.x, 0), dpp_f(a2.y, 0)}, p2 = (f32x2){dpp_f(a2.x, 1), dpp_f(a2.y, 1)};
                    if (m > 0) { p1 += (f32x2){dpp_f(ap[pr].x, 2), dpp_f(ap[pr].y, 2)}; p2 += (f32x2){dpp_f(ap[pr].x, 3), dpp_f(ap[pr].y, 3)}; }
                    ap[pr] = a2;
                    const f32x2 ac = wb2[pr] + w02[pr] * p2 + w12[pr] * p1 + w22[pr] * a2;
                    const f32x2 u2 = (ac + (ac * ac) * ac * 0.044715f) * (-1.5957691216057308f * 1.4426950408889634f);
                    f32x2 e; e.x = __builtin_amdgcn_exp2f(u2.x); e.y = __builtin_amdgcn_exp2f(u2.y);
                    const f32x2 d = e + 1.0f; f32x2 r; r.x = __builtin_amdgcn_rcpf(d.x); r.y = __builtin_amdgcn_rcpf(d.y);
                    o2[pr] = (ac * r) * v2; }
                u32x4 w; w.x = cvt_pk_bf16(o2[0].x, o2[0].y); w.y = cvt_pk_bf16(o2[1].x, o2[1].y); w.z = cvt_pk_bf16(o2[2].x, o2[2].y); w.w = cvt_pk_bf16(o2[3].x, o2[3].y);
                *(PG8_GAS u32x4*)(G + (size_t)(row64 + m * 16 + fr) * dff + colb) = w;
            }
        }
    }
};

struct PanelRms {
    unsigned* xbuf;
    unsigned* cnt;
    unsigned* tmo;
    float eps; unsigned code;
    const float* amx_in;
    float* qs_out;
    template <bool quant> __device__ __forceinline__ bool run(const f32x4 (&v)[2][2][4][2], const f32x4 (&gv)[2][2], const Unit& u, int wr, int wc, int fr, int fq, PG8_LAS unsigned char* lds, int wid, int lane, u32x4 (&pre)[2][4][2], const bf16_t* xb, int ldc, int col0) const {
        PG8_LAS float* P = (PG8_LAS float*)lds;
        PG8_LAS float* PX = (PG8_LAS float*)(lds + 4096);
        PG8_LAS float* S = (PG8_LAS float*)(lds + 8192);
        PG8_LAS float* S2 = (PG8_LAS float*)(lds + 9216);
        PG8_LAS unsigned* flag = (PG8_LAS unsigned*)(lds + 8192 + 2048);
        const int row = wid * 32 + (lane & 31);
        f32x4 ao = (f32x4){0.f, 0.f, 0.f, 0.f};
        if (quant && lane < 32) ao = *(const PG8_GAS f32x4*)(amx_in + (size_t)(u.pm * BM + row) * 4);
#pragma unroll
        for (int ai = 0; ai < 2; ++ai)
#pragma unroll
            for (int m = 0; m < 4; ++m) {
                float s = 0.f, mx = 0.f;
#pragma unroll
                for (int bj = 0; bj < 2; ++bj)
#pragma unroll
                    for (int n = 0; n < 2; ++n) { const f32x4 x = v[ai][bj][m][n]; s += (x[0] * x[0] + x[1] * x[1]) + (x[2] * x[2] + x[3] * x[3]);
                        if (quant) { const f32x4 y = x * gv[bj][n]; mx = fmaxf(mx, fmaxf(fmaxf(fabsf(y[0]), fabsf(y[1])), fmaxf(fabsf(y[2]), fabsf(y[3])))); } }
                s += __shfl_xor(s, 16); s += __shfl_xor(s, 32);
                if (quant) { mx = fmaxf(mx, __shfl_xor(mx, 16)); mx = fmaxf(mx, __shfl_xor(mx, 32)); }
                if (fq == 0) { P[(ai * HALF + wr * 64 + m * 16 + fr) * 4 + wc] = s; if (quant) PX[(ai * HALF + wr * 64 + m * 16 + fr) * 4 + wc] = mx; }
            }
        asm volatile("s_waitcnt lgkmcnt(0)" ::: "memory"); __builtin_amdgcn_s_barrier(); asm volatile("" ::: "memory");
        if (lane < 32) {
            const float t = (P[row * 4 + 0] + P[row * 4 + 1]) + (P[row * 4 + 2] + P[row * 4 + 3]);
            const float tm = quant ? fmaxf(fmaxf(PX[row * 4 + 0], PX[row * 4 + 1]), fmaxf(PX[row * 4 + 2], PX[row * 4 + 3])) : 0.f;
            __hip_atomic_store((PG8_GAS unsigned long long*)(xbuf + ((size_t)(u.pm * BM + row) * 4 + u.pn) * 2), ((unsigned long long)__float_as_uint(tm) << 32) | (unsigned long long)__float_as_uint(t), __ATOMIC_RELAXED, __HIP_MEMORY_SCOPE_AGENT);
        }
        asm volatile("" ::: "memory");
#pragma unroll
        for (int ai = 0; ai < 2; ++ai)
#pragma unroll
            for (int m = 0; m < 4; ++m) { const size_t off = (size_t)(u.pm * BM + ai * HALF + wr * 64 + m * 16 + fr) * ldc + col0;
#pragma unroll
                for (int bj = 0; bj < 2; ++bj) pre[ai][m][bj] = *(const PG8_GAS u32x4*)(xb + off + bj * 32); }
        asm volatile("s_waitcnt vmcnt(14)" ::: "memory");
        if (lane == 0) __hip_atomic_fetch_add((PG8_GAS unsigned*)cnt + 64 * u.pm, 1u, __ATOMIC_RELAXED, __HIP_MEMORY_SCOPE_AGENT);
        if (wid == 0) {
            bool dead = false; const unsigned want = 8u * 4u;
            for (unsigned spins = 0;; ++spins) {
                if ((unsigned)__builtin_amdgcn_readfirstlane(__hip_atomic_load((const PG8_GAS unsigned*)cnt + 64 * u.pm, __ATOMIC_RELAXED, __HIP_MEMORY_SCOPE_AGENT)) >= want) break;
                if (spins > (1u << 20)) {
                    if (lane == 0) { unsigned expect = 0u; __hip_atomic_compare_exchange_strong(tmo + 1, &expect, code | (unsigned)(u.pm & 0xff), __ATOMIC_RELAXED, __ATOMIC_RELAXED, __HIP_MEMORY_SCOPE_AGENT);
                                     __hip_atomic_store(tmo, 1u, __ATOMIC_RELAXED, __HIP_MEMORY_SCOPE_AGENT); }
                    dead = true; break; }
                __builtin_amdgcn_s_sleep(2);
            }
            __builtin_amdgcn_fence(__ATOMIC_ACQUIRE, "agent");
            if (lane == 0) flag[0] = dead ? 1u : 0u;
        }
        asm volatile("s_waitcnt vmcnt(0) lgkmcnt(0)" ::: "memory"); __builtin_amdgcn_s_barrier(); asm volatile("" ::: "memory");
        const bool bad = flag[0] != 0u;
        if (lane < 32) {
            const PG8_GAS unsigned long long* slot = (const PG8_GAS unsigned long long*)(xbuf + (size_t)(u.pm * BM + row) * 8); float q = 0.f; f32x4 bm;
#pragma unroll
            for (int t = 0; t < 4; ++t) { const unsigned long long w = __hip_atomic_load(slot + t, __ATOMIC_RELAXED, __HIP_MEMORY_SCOPE_AGENT); q += __uint_as_float((unsigned)w); bm[t] = __uint_as_float((unsigned)(w >> 32)); }
            const float rinv = __builtin_amdgcn_rsqf(q * (1.0f / 1024.0f) + eps);
            S[row] = rinv;
            if (quant) { const f32x4 bt = ao + bm * rinv;
                const float B = fmaxf(fmaxf(bt[0], bt[1]), fmaxf(bt[2], bt[3])) * 1.004f + 1e-20f;
                S2[row] = 127.0f * __builtin_amdgcn_rcpf(B); if (u.pn == 0) ((PG8_GAS float*)qs_out)[u.pm * BM + row] = B * (1.0f / 127.0f); }
        }
        asm volatile("s_waitcnt lgkmcnt(0)" ::: "memory"); __builtin_amdgcn_s_barrier(); asm volatile("" ::: "memory");
        return bad;
    }
};
__device__ __forceinline__ unsigned pack_i8x4(const f32x4 q) {
    return __builtin_amdgcn_perm(__float_as_uint(q[1]), __float_as_uint(q[0]), 0x0c0c0400u) | __builtin_amdgcn_perm(__float_as_uint(q[3]), __float_as_uint(q[2]), 0x04000c0cu);
}
__device__ __forceinline__ float amax4(const f32x4 a) { return fmaxf(fmaxf(fabsf(a[0]), fabsf(a[1])), fmaxf(fabsf(a[2]), fabsf(a[3]))); }
template <bool QUANT  > struct EpiRmsRes {
    static constexpr bool PERM = true, AFTER_DRAIN = true, HAS_MID = false, I8 = false; static constexpr int MID_T = -1, NST = 0, PID = 0;
    bf16_t* xb; float* outf; int ldc; const float* g1; float* stat; signed char* xq; float* amx; PanelRms st;
    __device__ __forceinline__ void fused(f32x4 (&acc)[2][2][4][2], const Unit& u, int wr, int wc, int fr, int fq, PG8_LAS unsigned char* lds, int wid, int lane) const {
        const PG8_LAS float* S = (const PG8_LAS float*)(lds + 8192);
        const PG8_LAS float* S2 = (const PG8_LAS float*)(lds + 9216);
        PG8_LAS float* P = (PG8_LAS float*)lds;
        PG8_LAS float* PX = (PG8_LAS float*)(lds + 4096);
        const int col0 = u.pn * BM + wc * 64 + 8 * fq, odd = fr & 1;
        u32x4 pre[2][4][2];
        f32x4 gv[2][2];
#pragma unroll
        for (int bj = 0; bj < 2; ++bj)
#pragma unroll
            for (int n = 0; n < 2; ++n) gv[bj][n] = *(const PG8_GAS f32x4*)(g1 + col0 + bj * 32 + 4 * n);
        (void)st.template run<QUANT>(acc, gv, u, wr, wc, fr, fq, lds, wid, lane, pre, xb, ldc, col0);
#pragma unroll
        for (int ai = 0; ai < 2; ++ai)
#pragma unroll
            for (int m = 0; m < 4; ++m) { const int r = ai * HALF + wr * 64 + m * 16 + fr; const float sr = S[r]; const size_t off = (size_t)(u.pm * BM + r) * ldc + col0;
                const float s2r = QUANT ? S2[r] : 0.f;
                float ps = 0.f, pmx = 0.f; u32x4 w[2];
#pragma unroll
                for (int bj = 0; bj < 2; ++bj) { const u32x4 pb = pre[ai][m][bj];
                    const f32x4 b0 = (f32x4){bfbits2f(pb.x & 0xffffu), bfbits2f(pb.x >> 16), bfbits2f(pb.y & 0xffffu), bfbits2f(pb.y >> 16)};
                    const f32x4 b1 = (f32x4){bfbits2f(pb.z & 0xffffu), bfbits2f(pb.z >> 16), bfbits2f(pb.w & 0xffffu), bfbits2f(pb.w >> 16)};
                    const f32x4 o0 = b0 + acc[ai][bj][m][0] * sr * gv[bj][0], o1 = b1 + acc[ai][bj][m][1] * sr * gv[bj][1];
                    if (outf) { *(PG8_GAS f32x4*)(outf + off + bj * 32) = o0; *(PG8_GAS f32x4*)(outf + off + bj * 32 + 4) = o1; }
                    else { w[bj].x = cvt_pk_bf16(o0[0], o0[1]); w[bj].y = cvt_pk_bf16(o0[2], o0[3]); w[bj].z = cvt_pk_bf16(o1[0], o1[1]); w[bj].w = cvt_pk_bf16(o1[2], o1[3]);
                        ps += ((o0[0] * o0[0] + o0[1] * o0[1]) + (o0[2] * o0[2] + o0[3] * o0[3])) + ((o1[0] * o1[0] + o1[1] * o1[1]) + (o1[2] * o1[2] + o1[3] * o1[3]));
                        pmx = fmaxf(pmx, fmaxf(amax4(o0), amax4(o1)));
                        if constexpr (QUANT) { u32x2 qw; qw.x = pack_i8x4(o0 * s2r + 12582912.0f); qw.y = pack_i8x4(o1 * s2r + 12582912.0f);
                            *(PG8_GAS u32x2*)(xq + off + bj * 32) = qw; } } }
                if (!outf) { u32x4 dA, dB; pair_swap(w[0], w[1], odd, dA, dB);
                    bf16_t* pA = xb + (size_t)(u.pm * BM + r - odd) * ldc + col0 + 32 * odd; *(PG8_GAS u32x4*)pA = dA; *(PG8_GAS u32x4*)(pA + ldc) = dB; }
                if (!outf) { ps += __shfl_xor(ps, 16); ps += __shfl_xor(ps, 32); pmx = fmaxf(pmx, __shfl_xor(pmx, 16)); pmx = fmaxf(pmx, __shfl_xor(pmx, 32)); if (fq == 0) { P[r * 4 + wc] = ps; PX[r * 4 + wc] = pmx; } } }
        if (!outf) {
            asm volatile("s_waitcnt lgkmcnt(0)" ::: "memory"); __builtin_amdgcn_s_barrier(); asm volatile("" ::: "memory");
            const int row = wid * 32 + (lane & 31);
            if (lane < 32) { ((PG8_GAS float*)stat)[(size_t)(u.pm * BM + row) * 4 + u.pn] = (P[row * 4 + 0] + P[row * 4 + 1]) + (P[row * 4 + 2] + P[row * 4 + 3]);
                ((PG8_GAS float*)amx)[(size_t)(u.pm * BM + row) * 4 + u.pn] = fmaxf(fmaxf(PX[row * 4 + 0], PX[row * 4 + 1]), fmaxf(PX[row * 4 + 2], PX[row * 4 + 3])); }
        }
    }
};
template <bool I8E, int THR, int OFF_HI, int TB> struct EpiBf16Rs {
    static constexpr bool PERM = true, AFTER_DRAIN = false, HAS_MID = false, I8 = I8E; static constexpr int MID_T = -1, NST = PG_NST, PID = I8E ? 2 : 3;
    bf16_t* O; int ldc; const float* costab; const float* sintab; const unsigned* wsc;
    __device__ __forceinline__ void operator()(const f32x4 (&acc)[2][2][4][2], const Unit& u, int wr, int wc, int fr, int fq) const {
        const int pn = u.pn + (u.pn >= THR ? OFF_HI : 0);
        const int row0 = u.pm * BM + wr * 64 + fr, col0 = pn * BM + wc * 32 + 8 * fq;
        float ts[2] = {1.0f, 1.0f};
        if constexpr (I8) { ts[0] = __uint_as_float(((const PG8_GAS unsigned*)wsc)[u.pn * 8 + wc]) * (1.0f / 127.0f); ts[1] = __uint_as_float(((const PG8_GAS unsigned*)wsc)[u.pn * 8 + 4 + wc]) * (1.0f / 127.0f); }
        const bool rot = !I8E && (pn >= 3) && (pn <= 6);
        float sc[2][4];
        {
#pragma unroll
            for (int ai = 0; ai < 2; ++ai)
#pragma unroll
                for (int m = 0; m < 4; ++m) sc[ai][m] = rs_lds()[TB + ((row0 + ai * HALF + m * 16) & 255)];
        }
        if (!rot) {
            const int odd = fr & 1; const int colL = pn * BM + wc * 64 + 32 * odd + 8 * fq;
#pragma unroll
            for (int ai = 0; ai < 2; ++ai)
#pragma unroll
                for (int m = 0; m < 4; ++m) { const int rr = row0 + ai * HALF + m * 16;
                    u32x4 w[2];
#pragma unroll
                    for (int bj = 0; bj < 2; ++bj) { const float sb = sc[ai][m] * ts[bj]; const f32x4 v0 = acc[ai][bj][m][0] * sb, v1 = acc[ai][bj][m][1] * sb;
                        w[bj].x = cvt_pk_bf16(v0[0], v0[1]); w[bj].y = cvt_pk_bf16(v0[2], v0[3]); w[bj].z = cvt_pk_bf16(v1[0], v1[1]); w[bj].w = cvt_pk_bf16(v1[2], v1[3]); }
                    const u32x4 snd = odd ? w[0] : w[1];
                    u32x4 rcv;
                    rcv.x = (unsigned)__builtin_amdgcn_update_dpp(0, (int)snd.x, 0xB1, 0xf, 0xf, false); rcv.y = (unsigned)__builtin_amdgcn_update_dpp(0, (int)snd.y, 0xB1, 0xf, 0xf, false);
                    rcv.z = (unsigned)__builtin_amdgcn_update_dpp(0, (int)snd.z, 0xB1, 0xf, 0xf, false); rcv.w = (unsigned)__builtin_amdgcn_update_dpp(0, (int)snd.w, 0xB1, 0xf, 0xf, false);
                    const u32x4 dA = odd ? rcv : w[0], dB = odd ? w[1] : rcv;
                    bf16_t* pA = O + (size_t)(rr - odd) * ldc + colL; bf16_t* pB = O + (size_t)(rr - odd + 1) * ldc + colL;
                    ST16(pA, dA); ST16(pB, dB); }
        } else {
            const bool isk = pn >= 5; const int hb = 2 * ((pn - 3) & 1);
            float lgs[2];
#pragma unroll
            for (int bj = 0; bj < 2; ++bj) { const float lg2 = LOG2_GAMMA_OF(hb + bj); lgs[bj] = isk ? -lg2 : lg2; }
            const float kmul = isk ? 0.08838834764831845f : 1.0f;
#pragma unroll
            for (int ai = 0; ai < 2; ++ai)
#pragma unroll
                for (int m = 0; m < 4; ++m) { const int ri = row0 + ai * HALF + m * 16; bf16_t* rowp = O + (size_t)ri * ldc + col0;
                    const int toff = (ri & 4095) * 64 + 4 * (4 * wc + fq); const f32x4 cs = *(const PG8_GAS f32x4*)(costab + toff), sn = *(const PG8_GAS f32x4*)(sintab + toff);
                    const float cpos = (float)(ri & 127);
#pragma unroll
                    for (int bj = 0; bj < 2; ++bj) { const float scl = sc[ai][m] * (kmul * ts[bj]) * __builtin_amdgcn_exp2f(lgs[bj] * cpos);
                        const f32x4 x1 = acc[ai][bj][m][0], x2 = acc[ai][bj][m][1];
                        const f32x4 v0 = (x1 * cs - x2 * sn) * scl, v1 = (x1 * sn + x2 * cs) * scl;
                        u32x4 w; w.x = cvt_pk_bf16(v0[0], v0[1]); w.y = cvt_pk_bf16(v0[2], v0[3]); w.z = cvt_pk_bf16(v1[0], v1[1]); w.w = cvt_pk_bf16(v1[2], v1[3]);
                        ST16(rowp + bj * HALF, w); } }
        }
    }
};
struct EpiNull {
    static constexpr bool PERM = true, AFTER_DRAIN = false, HAS_MID = false, I8 = false; static constexpr int MID_T = -1, NST = 0, PID = 0;
    float* sink;
    __device__ __forceinline__ void operator()(const f32x4 (&acc)[2][2][4][2], const Unit& u, int wr, int wc, int fr, int fq) const {
        f32x4 t = acc[0][0][0][0];
#pragma unroll
        for (int ai = 0; ai < 2; ++ai)
#pragma unroll
            for (int bj = 0; bj < 2; ++bj)
#pragma unroll
                for (int m = 0; m < 4; ++m)
#pragma unroll
                    for (int n = 0; n < 2; ++n) t += acc[ai][bj][m][n];
        if (t[0] + t[1] + t[2] + t[3] == 123456.789f) sink[0] = t[0];
    }
};

struct EpiGate2 {
    static constexpr bool PERM = true, AFTER_DRAIN = false, HAS_MID = true, I8 = false; static constexpr int MID_T = 6, NST = 0, PID = 0;
    bf16_t* O; int ldc; const bf16_t* ga; const bf16_t* gr; int ldg;
    static __device__ __forceinline__ f32x2 expneg2(unsigned w) { const f32x2 x = (f32x2){bfbits2f(w & 0xffffu), __uint_as_float(w & 0xffff0000u)} * -1.4426950408889634f; f32x2 e; e.x = __builtin_amdgcn_exp2f(x.x); e.y = __builtin_amdgcn_exp2f(x.y); return e; }
    static __device__ __forceinline__ f32x2 rcp2(f32x2 d) { f32x2 r; r.x = __builtin_amdgcn_rcpf(d.x); r.y = __builtin_amdgcn_rcpf(d.y); return r; }
    __device__ __forceinline__ void mid(f32x4 (&acc)[2][2][4][2], const Unit& u, int wr, int wc, int fr, int fq) const {
        int fro = fr; asm volatile("" : "+v"(fro));
        const int row0 = u.pm * BM + wr * 64 + fro, col0 = u.pn * BM + wc * 64 + 8 * fq;
#pragma unroll
        for (int ai = 0; ai < 2; ++ai)
#pragma unroll
            for (int m = 0; m < 4; ++m) { const size_t r = (size_t)(row0 + ai * HALF + m * 16);
#pragma unroll
                for (int bj = 0; bj < 2; ++bj) { const int c = col0 + bj * 32;
                    const u32x4 a = *(const PG8_GAS u32x4*)(ga + r * ldg + c), g = *(const PG8_GAS u32x4*)(gr + r * ldg + c);
                    const unsigned aw[4] = {a.x, a.y, a.z, a.w}, gw_[4] = {g.x, g.y, g.z, g.w};
                    f32x2 rho[4];
#pragma unroll
                    for (int k = 0; k < 4; ++k) rho[k] = (expneg2(gw_[k]) + 1.0f) * rcp2(expneg2(aw[k]) + 1.0f);
                    acc[ai][bj][m][0] = acc[ai][bj][m][0] * (f32x4){rho[0].x, rho[0].y, rho[1].x, rho[1].y};
                    acc[ai][bj][m][1] = acc[ai][bj][m][1] * (f32x4){rho[2].x, rho[2].y, rho[3].x, rho[3].y}; }
                if (m & 1) asm volatile("" ::: "memory"); }
    }
    __device__ __forceinline__ void operator()(const f32x4 (&acc)[2][2][4][2], const Unit& u, int wr, int wc, int fr, int fq) const {
        const int row0 = u.pm * BM + wr * 64 + fr, col0 = u.pn * BM + wc * 64 + 8 * fq, odd = fr & 1;
#pragma unroll
        for (int ai = 0; ai < 2; ++ai)
#pragma unroll
            for (int m = 0; m < 4; ++m) { const size_t r = (size_t)(row0 + ai * HALF + m * 16);
                u32x4 w[2];
#pragma unroll
                for (int bj = 0; bj < 2; ++bj) { const int c = col0 + bj * 32;
                    const u32x4 gv = *(const PG8_GAS u32x4*)(gr + r * ldg + c);
                    const f32x4 v0 = acc[ai][bj][m][0], v1 = acc[ai][bj][m][1];
                    const f32x2 s0 = rcp2(expneg2(gv.x) + 1.0f), s1 = rcp2(expneg2(gv.y) + 1.0f), s2 = rcp2(expneg2(gv.z) + 1.0f), s3 = rcp2(expneg2(gv.w) + 1.0f);
                    const f32x2 o0 = (f32x2){v0[0], v0[1]} * s0, o1 = (f32x2){v0[2], v0[3]} * s1, o2 = (f32x2){v1[0], v1[1]} * s2, o3 = (f32x2){v1[2], v1[3]} * s3;
                    w[bj].x = cvt_pk_bf16(o0.x, o0.y); w[bj].y = cvt_pk_bf16(o1.x, o1.y); w[bj].z = cvt_pk_bf16(o2.x, o2.y); w[bj].w = cvt_pk_bf16(o3.x, o3.y); }
                u32x4 dA, dB; pair_swap(w[0], w[1], odd, dA, dB);
                bf16_t* pA = O + (r - odd) * ldc + col0 + 32 * odd;
                *(PG8_GAS u32x4*)pA = dA; *(PG8_GAS u32x4*)(pA + ldc) = dB;
                if (m == 3) asm volatile("" ::: "memory"); }
    }
};
}

constexpr int NWAVES = 8;
constexpr int D = 1024, BATCH = 8, SEQ = 4096, DEPTH = 4;
constexpr int M = BATCH * SEQ, MH = M / 2;
constexpr int DIN = 5888, DFF = 2816, NUP = 2 * DFF;
constexpr int C_QA = 0, C_KA = 512, C_VA = 640, C_QR = 768, C_KR = 1280, C_VR = 1792, C_GR = 2816, C_GA = 3840, C_GT = 4864;
constexpr float EPS = 1e-6f;
#ifndef MK_ONE_LAUNCH
#define MK_ONE_LAUNCH 0
#endif
constexpr int PH_PER = 15;
constexpr int N_PHASES = 1 + DEPTH * PH_PER;

constexpr size_t MiB = 1u << 20;
constexpr size_t WS_CTL = 0, CTL_ZERO_BYTES = 1 * MiB;
constexpr size_t WS_BIAS = 1 * MiB;
constexpr size_t WS_AMX = 5 * MiB;
constexpr size_t WS_COS = 2 * MiB, WS_SIN = 3 * MiB;
constexpr size_t WS_STAT = 4 * MiB;
constexpr size_t WS_W = 6 * MiB;
constexpr size_t W_IN = 0, W_OA = W_IN + (size_t)DIN * D, W_OR = W_OA + (size_t)D * 512, W_O = W_OR + (size_t)D * D, W_UP = W_O + (size_t)D * D, W_DN = W_UP + (size_t)NUP * D, W_LAYER = W_DN + (size_t)D * DFF;
static_assert(W_LAYER * 2 == 33 * MiB, "weights per layer");
constexpr size_t W_IN8 = W_UP + (size_t)NUP * D / 2;
constexpr size_t WS_RA = WS_W + 4 * 33 * MiB;
constexpr size_t WS_RB = WS_RA + 184 * MiB;
constexpr size_t WS_XN = WS_RB;
constexpr size_t WS_XN1 = WS_XN + 32 * MiB;
constexpr size_t WS_AOA = WS_XN1 + 32 * MiB;
constexpr size_t WS_AOR = WS_AOA + 16 * MiB;
constexpr size_t WS_KV = WS_AOA + 48 * MiB;
constexpr size_t WS_MG = WS_KV;
constexpr size_t WS_G = WS_RA;
constexpr size_t WS_H = WS_AOA;
constexpr size_t WS_XQ = WS_KV + 32 * MiB;
constexpr size_t WS_XSLOT = WS_XQ + 32 * MiB;
constexpr size_t WS_QS = WS_XSLOT + 1 * MiB;
constexpr size_t WS_END = WS_QS + 1 * MiB;
static_assert((size_t)MH * DIN * 2 == 184 * MiB && (size_t)M * DFF * 2 <= 184 * MiB && (size_t)(M / 64) * 6 * DFF * 2 <= 48 * MiB && WS_END <= 512 * MiB, "ws map");
constexpr int CW_WAMAX = 131072;
constexpr int CW_BAR = 4096, CW_SEAM = 16384;

constexpr int RING_BYTES = 131072;
constexpr int LDS_BYTES = 147456;
constexpr int MISC_OFF = 143360;

#define GAS __attribute__((address_space(1)))
#define LAS __attribute__((address_space(3)))
typedef unsigned short bf16;
typedef unsigned v4u __attribute__((ext_vector_type(4)));
typedef float f32x4 __attribute__((ext_vector_type(4)));
typedef short bf16x8 __attribute__((ext_vector_type(8)));
typedef GAS unsigned gu32;
typedef GAS unsigned long long gu64;
#define RLX_AGENT __ATOMIC_RELAXED, __HIP_MEMORY_SCOPE_AGENT
#define LDS_WAIT() asm volatile("s_waitcnt lgkmcnt(0)" ::: "memory")
#define VM_WAIT() asm volatile("s_waitcnt vmcnt(0)" ::: "memory")
__device__ __forceinline__ unsigned long long rt() { return __builtin_amdgcn_s_memrealtime(); }
__device__ __forceinline__ unsigned f2bf(float f) { unsigned u = __builtin_bit_cast(unsigned, f); return (u + 0x7fffu + ((u >> 16) & 1u)) >> 16; }
typedef float pk2_f32x2_t __attribute__((ext_vector_type(2))); typedef __bf16 pk2_bf16x2_t __attribute__((ext_vector_type(2)));
__device__ __forceinline__ unsigned pk2(float lo, float hi) { const pk2_f32x2_t v = {lo, hi}; return __builtin_bit_cast(unsigned, __builtin_convertvector(v, pk2_bf16x2_t)); }

#define XB_TMO      128
#define XB_XCNT(j)  (256  + 64 * (j))
#define XB_XSUB(j)  (1280 + 64 * (j))
#define XB_XGEN(j)  (2304 + 64 * (j))
#define XB_TOP      3328
#define XB_TOPGEN   3392
#define XCD_BAR_WORDS 3456
#define XB_SPIN_CAP (1u << 18)

__device__ __forceinline__ unsigned xb_ld(unsigned* p)              { return __hip_atomic_load(p, __ATOMIC_RELAXED, __HIP_MEMORY_SCOPE_AGENT); }
__device__ __forceinline__ unsigned xb_add(unsigned* p, unsigned v) { return __hip_atomic_fetch_add(p, v, __ATOMIC_RELAXED, __HIP_MEMORY_SCOPE_AGENT); }
__device__ __forceinline__ unsigned xb_xcc_id() { return (unsigned)__builtin_amdgcn_s_getreg((3 << 11) | 20) & 0xFu; }
#define XB_SPIN(cond, bar) do { unsigned _sp = 0; while (cond) { __builtin_amdgcn_s_sleep(1); \
    if ((++_sp & 255u) == 0u) { if (xb_ld(&(bar)[XB_TMO])) break; if (_sp > XB_SPIN_CAP) { atomicAdd(&(bar)[XB_TMO], 1u); break; } } } } while (0)

struct XcdBarrier {
    unsigned* bar; unsigned x;
    volatile LAS unsigned* st;
};

__device__ __forceinline__ XcdBarrier xcd_barrier_post(unsigned* bar, volatile LAS unsigned* st) {
    XcdBarrier b; b.bar = bar; b.x = xb_xcc_id(); b.st = st;
    if (threadIdx.x == 0) (void)xb_add(&bar[XB_XCNT(b.x)], 1u);
    return b;
}
__device__ __forceinline__ void xcd_barrier_complete(unsigned* bar, unsigned x, unsigned& nloc, unsigned& nx) {
    const unsigned G = gridDim.x * gridDim.y * gridDim.z;
    unsigned sum, cnt, mine, sp = 0u;
    for (;;) {
        sum = 0u; cnt = 0u; mine = 0u;
#pragma unroll
        for (unsigned j = 0; j < 16; ++j) { const unsigned c = xb_ld(&bar[XB_XCNT(j)]); sum += c; cnt += (c > 0u) ? 1u : 0u; mine = (j == x) ? c : mine; }
        if (sum == G) break;
        __builtin_amdgcn_s_sleep(1);
        if ((++sp & 255u) == 0u) { if (xb_ld(&bar[XB_TMO])) break; if (sp > XB_SPIN_CAP) { atomicAdd(&bar[XB_TMO], 1u); break; } }
    }
    nloc = mine > 0u ? mine : 1u; nx = cnt > 0u ? cnt : 1u;
}

__device__ __forceinline__ void xcd_barrier(const XcdBarrier& b) {
    asm volatile("s_waitcnt vmcnt(0)" ::: "memory");
    __syncthreads();
    int tid0_ = threadIdx.x; asm volatile("" : "+v"(tid0_));
    if (tid0_ == 0) {
        unsigned* bar = b.bar;
        __builtin_amdgcn_s_waitcnt(0);
        unsigned nloc = b.st[0], nx = b.st[1];
        if (nloc == 0u) { xcd_barrier_complete(bar, b.x, nloc, nx); b.st[0] = nloc; b.st[1] = nx; }
        const unsigned old = xb_add(&bar[XB_XSUB(b.x)], 1u);
        const unsigned gen = old / nloc;
        if (old + 1u == (gen + 1u) * nloc) {
            __builtin_amdgcn_fence(__ATOMIC_RELEASE, "agent");
            asm volatile("s_waitcnt vmcnt(0)" ::: "memory");
            const unsigned og = xb_add(&bar[XB_TOP], 1u);
            const unsigned tg = og / nx;
            if (og + 1u == (tg + 1u) * nx) xb_add(&bar[XB_TOPGEN], 1u);
            else XB_SPIN(xb_ld(&bar[XB_TOPGEN]) == tg, bar);
            __builtin_amdgcn_fence(__ATOMIC_ACQUIRE, "agent");
            xb_add(&bar[XB_XGEN(b.x)], 1u);
            asm volatile("s_waitcnt vmcnt(0)" ::: "memory");
        } else {
            XB_SPIN(xb_ld(&bar[XB_XGEN(b.x)]) == gen, bar);
            __builtin_amdgcn_fence(__ATOMIC_ACQUIRE, "agent");
            asm volatile("s_waitcnt vmcnt(0)" ::: "memory");
        }
    }
    __syncthreads();
}
typedef unsigned u32x2 __attribute__((ext_vector_type(2)));
typedef unsigned short u16;
#define MFMA16(a, b, c) __builtin_amdgcn_mfma_f32_16x16x32_bf16((a), (b), (c), 0, 0, 0)
__device__ __forceinline__ float bf2f(unsigned b) { return __uint_as_float(b << 16); }
__device__ __forceinline__ float wave_sum(float v) {
#pragma unroll
    for (int o = 1; o < 64; o <<= 1) v += __shfl_xor(v, o);
    return v;
}
__device__ __forceinline__ float sigm(float x) { return __builtin_amdgcn_rcpf(1.0f + __builtin_amdgcn_exp2f(x * -1.4426950408889634f)); }
__device__ __forceinline__ float tanh_fast(float x) { const float e = __expf(-2.0f * fabsf(x)); const float t = (1.0f - e) / (1.0f + e); return x < 0.f ? -t : t; }
__device__ __forceinline__ float gelu_tanh(float x) { const float u = 0.7978845608028654f * (x + 0.044715f * x * x * x); return 0.5f * x * (1.0f + tanh_fast(u)); }

struct ColSel { int cnt, split, gap, rt_split, rt_gap; };
__device__ __forceinline__ int p0_row(int ro, int N, int rmode) {
    if (rmode == 1) { const int hv = ro >= (N >> 1), nn = hv ? ro - (N >> 1) : ro; ro = 256 * (nn >> 7) + 128 * hv + (nn & 127); }
    else if (rmode == 2 && ro >= C_QR && ro < C_VR) { const int jj = ro & 127; ro = (ro & ~127) + ((jj & 63) >> 2) * 8 + ((jj >> 6) << 2) + (jj & 3); }
    else if (rmode == 2 || rmode == 3) { const int x = ro & 255; ro = (ro & ~255) + 128 * ((x >> 5) & 1) + 32 * (x >> 6) + (x & 31); }
    return ro;
}
__device__ __forceinline__ int p0_rowc(int col, int N, int rmode, const ColSel cs) { int ro = p0_row(col, N, rmode); if ((ro >> 8) >= cs.rt_split) ro -= 256 * cs.rt_gap; return ro; }
__device__ __forceinline__ void p0_load_item(const float* W, int N, int item, int lane, const ColSel cs, f32x4 (&wv)[8]) {
    const int kb = item / cs.cnt, j = item % cs.cnt, nb = j + (j >= cs.split ? cs.gap : 0), k0 = 64 * kb;
    const float* base = W + (size_t)(k0 + (lane >> 3)) * N + 32 * nb + 4 * (lane & 7);
#pragma unroll
    for (int i = 0; i < 8; ++i) wv[i] = *(const GAS f32x4*)(base + (size_t)(8 * i) * N);
}
__device__ __forceinline__ unsigned p0_pack8(const float (&q)[4]) {
    return __builtin_amdgcn_perm(__float_as_uint(q[1]), __float_as_uint(q[0]), 0x0c0c0400u) | __builtin_amdgcn_perm(__float_as_uint(q[3]), __float_as_uint(q[2]), 0x04000c0cu);
}
template <bool Q8>
__device__ __forceinline__ void p0_store_item(const f32x4 (&wv)[8], int K, int N, bf16* WT, int ldw, LAS float* scr, int item, int lane, int rmode, const float* gk, const unsigned* wamax, const ColSel cs) {
    const int kb = item / cs.cnt, j_ = item % cs.cnt, nb = j_ + (j_ >= cs.split ? cs.gap : 0), k0 = 64 * kb;
    float qsc = 1.0f;
    if (Q8) { const int blk = p0_rowc(32 * nb, N, rmode, cs) >> 5; qsc = 127.0f * __builtin_amdgcn_rcpf(fmaxf(__uint_as_float(((const GAS unsigned*)wamax)[blk]), 1e-20f)); }
#pragma unroll
    for (int i = 0; i < 8; ++i) { const int kk = 8 * i + (lane >> 3); const float gs = (gk ? ((const GAS float*)gk)[k0 + kk] : 1.0f) * qsc; LAS float* d = scr + kk * 33 + 4 * (lane & 7);
        d[0] = wv[i].x * gs; d[1] = wv[i].y * gs; d[2] = wv[i].z * gs; d[3] = wv[i].w * gs; }
    LDS_WAIT(); asm volatile("" ::: "memory");
    const int c = lane & 7;
#pragma unroll
    for (int j = 0; j < 4; ++j) { const int n = (lane >> 3) + 8 * j; const LAS float* s = scr + (8 * c) * 33 + n;
        const int ro = p0_rowc(32 * nb + n, N, rmode, cs);
        if (Q8) { const float qa[4] = {s[0 * 33] + 12582912.0f, s[1 * 33] + 12582912.0f, s[2 * 33] + 12582912.0f, s[3 * 33] + 12582912.0f}, qb[4] = {s[4 * 33] + 12582912.0f, s[5 * 33] + 12582912.0f, s[6 * 33] + 12582912.0f, s[7 * 33] + 12582912.0f};
            u32x2 o; o.x = p0_pack8(qa); o.y = p0_pack8(qb);
            *(GAS u32x2*)((signed char*)WT + (size_t)ro * ldw + k0 + 8 * c) = o; }
        else { v4u o; o.x = pk2(s[0 * 33], s[1 * 33]); o.y = pk2(s[2 * 33], s[3 * 33]); o.z = pk2(s[4 * 33], s[5 * 33]); o.w = pk2(s[6 * 33], s[7 * 33]);
            *(GAS v4u*)(WT + (size_t)ro * ldw + k0 + 8 * c) = o; } }
    LDS_WAIT(); asm volatile("" ::: "memory");
}
template <bool Q8>
__device__ __forceinline__ void p0_matrix_sel(const float* W, int K, int N, bf16* WT, int ldw, LAS float* scr, int gw, int NGW, int lane, int rmode, const float* gk, const unsigned* wamax, const ColSel cs) {
    const int nitems = (K / 64) * cs.cnt;
    f32x4 wa[8], wb[8];
    int it = gw;
    if (it < nitems) p0_load_item(W, N, it, lane, cs, wa);
    while (it < nitems) {
        const int it1 = it + NGW, it2 = it1 + NGW;
        if (it1 < nitems) p0_load_item(W, N, it1, lane, cs, wb);
        p0_store_item<Q8>(wa, K, N, WT, ldw, scr, it, lane, rmode, gk, wamax, cs);
        if (it1 >= nitems) break;
        if (it2 < nitems) p0_load_item(W, N, it2, lane, cs, wa);
        p0_store_item<Q8>(wb, K, N, WT, ldw, scr, it1, lane, rmode, gk, wamax, cs);
        it = it2;
    }
}
template <bool Q8>
__device__ __forceinline__ void p0_matrix(const float* W, int K, int N, bf16* WT, int ldw, LAS float* scr, int gw, int NGW, int lane, int rmode, const float* gk, const unsigned* wamax = nullptr) {
    p0_matrix_sel<Q8>(W, K, N, WT, ldw, scr, gw, NGW, lane, rmode, gk, wamax, ColSel{N / 32, N / 32, 0, 1 << 20, 0});
}
__device__ __forceinline__ void p0_amax_item(const f32x4 (&wv)[8], int N, int item, int lane, int rmode, const float* gk, unsigned* wamax, const ColSel cs) {
    const int kb = item / cs.cnt, j = item % cs.cnt, nb = j + (j >= cs.split ? cs.gap : 0), k0 = 64 * kb;
    float mx = 0.f;
#pragma unroll
    for (int i = 0; i < 8; ++i) { const float gs = fabsf(((const GAS float*)gk)[k0 + 8 * i + (lane >> 3)]); mx = fmaxf(mx, gs * fmaxf(fmaxf(fabsf(wv[i].x), fabsf(wv[i].y)), fmaxf(fabsf(wv[i].z), fabsf(wv[i].w)))); }
#pragma unroll
    for (int o = 1; o < 64; o <<= 1) mx = fmaxf(mx, __shfl_xor(mx, o));
    if (lane == 0) __hip_atomic_fetch_max((GAS unsigned*)wamax + (p0_rowc(32 * nb, N, rmode, cs) >> 5), __float_as_uint(mx), __ATOMIC_RELAXED, __HIP_MEMORY_SCOPE_AGENT);
}
__device__ __forceinline__ void p0_amax(const float* W, int K, int N, int gw, int NGW, int lane, int rmode, const float* gk, unsigned* wamax, const ColSel cs) {
    const int nitems = (K / 64) * cs.cnt;
    f32x4 wa[8], wb[8];
    int it = gw;
    if (it < nitems) p0_load_item(W, N, it, lane, cs, wa);
    while (it < nitems) {
        const int it1 = it + NGW, it2 = it1 + NGW;
        if (it1 < nitems) p0_load_item(W, N, it1, lane, cs, wb);
        p0_amax_item(wa, N, it, lane, rmode, gk, wamax, cs);
        if (it1 >= nitems) break;
        if (it2 < nitems) p0_load_item(W, N, it2, lane, cs, wa);
        p0_amax_item(wb, N, it1, lane, rmode, gk, wamax, cs);
        it = it2;
    }
}

__device__ __forceinline__ void rms_rows(const float* x, const float* g, bf16* xn, int gw, int NGW, int lane) {
    f32x4 gg[4];
#pragma unroll
    for (int j = 0; j < 4; ++j) gg[j] = *((const f32x4*)g + lane + 64 * j);
    for (int m = gw; m < MH; m += NGW) {
        const GAS f32x4* xr = (const GAS f32x4*)(x + (size_t)m * D) + lane;
        f32x4 v[4]; float s = 0.f;
#pragma unroll
        for (int j = 0; j < 4; ++j) { v[j] = xr[64 * j]; s += (v[j].x * v[j].x + v[j].y * v[j].y) + (v[j].z * v[j].z + v[j].w * v[j].w); }
        const float r = __builtin_amdgcn_rsqf(wave_sum(s) * (1.f / D) + EPS);
        GAS u32x2* o = (GAS u32x2*)(xn + (size_t)m * D) + lane;
#pragma unroll
        for (int j = 0; j < 4; ++j) { u32x2 w; w.x = pk2(v[j].x * r * gg[j].x, v[j].y * r * gg[j].y); w.y = pk2(v[j].z * r * gg[j].z, v[j].w * r * gg[j].w); o[64 * j] = w; }
    }
}
__device__ __forceinline__ void xg_rows(const float* x, bf16* xg, float* stat, signed char* xq, float* qs, float* amx, int gw, int NGW, int lane) {
    for (int m0 = gw * 4; m0 < MH; m0 += NGW * 4) {
        f32x4 v[4][4];
#pragma unroll
        for (int r = 0; r < 4; ++r) { const GAS f32x4* xr = (const GAS f32x4*)(x + (size_t)(m0 + r) * D) + lane;
#pragma unroll
            for (int j = 0; j < 4; ++j) v[r][j] = xr[64 * j]; }
#pragma unroll
        for (int r = 0; r < 4; ++r) { float s = 0.f, mx = 0.f;
#pragma unroll
            for (int j = 0; j < 4; ++j) { s += (v[r][j].x * v[r][j].x + v[r][j].y * v[r][j].y) + (v[r][j].z * v[r][j].z + v[r][j].w * v[r][j].w);
                mx = fmaxf(mx, fmaxf(fmaxf(fabsf(v[r][j].x), fabsf(v[r][j].y)), fmaxf(fabsf(v[r][j].z), fabsf(v[r][j].w)))); }
            s = wave_sum(s);
#pragma unroll
            for (int o = 1; o < 64; o <<= 1) mx = fmaxf(mx, __shfl_xor(mx, o));
            const float B = fmaxf(mx, 1e-20f), s2 = 127.0f * __builtin_amdgcn_rcpf(B);
            GAS u32x2* o = (GAS u32x2*)(xg + (size_t)(m0 + r) * D) + lane;
            GAS unsigned* oq = (GAS unsigned*)(xq + (size_t)(m0 + r) * D) + lane;
#pragma unroll
            for (int j = 0; j < 4; ++j) { u32x2 w; w.x = pk2(v[r][j].x, v[r][j].y); w.y = pk2(v[r][j].z, v[r][j].w); o[64 * j] = w;
                if (PG_I8_P1) { const float qa[4] = {v[r][j].x * s2 + 12582912.0f, v[r][j].y * s2 + 12582912.0f, v[r][j].z * s2 + 12582912.0f, v[r][j].w * s2 + 12582912.0f}; oq[64 * j] = p0_pack8(qa); } }
            if (lane == 0) { *(GAS f32x4*)(stat + (size_t)(m0 + r) * 4) = (f32x4){s, 0.f, 0.f, 0.f}; *(GAS f32x4*)(amx + (size_t)(m0 + r) * 4) = (f32x4){mx, mx, mx, mx}; ((GAS float*)qs)[m0 + r] = B * (1.0f / 127.0f); } }
    }
}
__device__ __forceinline__ void resid_rows(const bf16* z, const float* xsrc, float* xdst, const float* gpost, const float* gnext, bf16* xn, int gw, int NGW, int lane) {
    for (int m = gw; m < MH; m += NGW) {
        const GAS u32x2* zr = (const GAS u32x2*)(z + (size_t)m * D) + lane;
        const GAS f32x4* xr = (const GAS f32x4*)(xsrc + (size_t)m * D) + lane;
        f32x4 v[4], xv[4]; float s = 0.f;
#pragma unroll
        for (int j = 0; j < 4; ++j) { const u32x2 zb = zr[64 * j]; v[j] = (f32x4){bf2f(zb.x & 0xffffu), bf2f(zb.x >> 16), bf2f(zb.y & 0xffffu), bf2f(zb.y >> 16)}; xv[j] = xr[64 * j]; s += (v[j].x * v[j].x + v[j].y * v[j].y) + (v[j].z * v[j].z + v[j].w * v[j].w); }
        const float r = __builtin_amdgcn_rsqf(wave_sum(s) * (1.f / D) + EPS);
        float s2 = 0.f;
        GAS f32x4* xo = (GAS f32x4*)(xdst + (size_t)m * D) + lane;
#pragma unroll
        for (int j = 0; j < 4; ++j) { const f32x4 gp = *((const f32x4*)gpost + lane + 64 * j); v[j] = xv[j] + v[j] * r * gp; xo[64 * j] = v[j];
            s2 += (v[j].x * v[j].x + v[j].y * v[j].y) + (v[j].z * v[j].z + v[j].w * v[j].w); }
        if (gnext) {
            const float r2 = __builtin_amdgcn_rsqf(wave_sum(s2) * (1.f / D) + EPS);
            GAS u32x2* o = (GAS u32x2*)(xn + (size_t)m * D) + lane;
#pragma unroll
            for (int j = 0; j < 4; ++j) { const f32x4 gn = *((const f32x4*)gnext + lane + 64 * j); u32x2 w; w.x = pk2(v[j].x * r2 * gn.x, v[j].y * r2 * gn.y); w.y = pk2(v[j].z * r2 * gn.z, v[j].w * r2 * gn.w); o[64 * j] = w; }
        }
    }
}
__device__ __forceinline__ void conv_phase(const bf16* U, bf16* G, const float* cw, const float* cb, int gt, int NGT) {
    constexpr int CG = DFF / 8, NIT = (MH / 32) * CG;
    for (int it = gt; it < NIT; it += NGT) {
        const int cg = it % CG, rg = it / CG, c0 = cg * 8, t0 = rg * 32;
        float w0[8], w1[8], w2[8], bb[8];
#pragma unroll
        for (int e = 0; e < 8; ++e) { w0[e] = cw[c0 + e]; w1[e] = cw[DFF + c0 + e]; w2[e] = cw[2 * DFF + c0 + e]; bb[e] = cb[c0 + e]; }
        float a2[8], a1[8];
        if ((t0 & (SEQ - 1)) == 0) {
#pragma unroll
            for (int e = 0; e < 8; ++e) { a2[e] = 0.f; a1[e] = 0.f; }
        } else {
            const v4u p2 = *(const GAS v4u*)(U + (size_t)(t0 - 2) * NUP + c0), p1 = *(const GAS v4u*)(U + (size_t)(t0 - 1) * NUP + c0);
            a2[0] = bf2f(p2.x & 0xffffu); a2[1] = bf2f(p2.x >> 16); a2[2] = bf2f(p2.y & 0xffffu); a2[3] = bf2f(p2.y >> 16); a2[4] = bf2f(p2.z & 0xffffu); a2[5] = bf2f(p2.z >> 16); a2[6] = bf2f(p2.w & 0xffffu); a2[7] = bf2f(p2.w >> 16);
            a1[0] = bf2f(p1.x & 0xffffu); a1[1] = bf2f(p1.x >> 16); a1[2] = bf2f(p1.y & 0xffffu); a1[3] = bf2f(p1.y >> 16); a1[4] = bf2f(p1.z & 0xffffu); a1[5] = bf2f(p1.z >> 16); a1[6] = bf2f(p1.w & 0xffffu); a1[7] = bf2f(p1.w >> 16);
        }
#pragma unroll 4
        for (int t = 0; t < 32; ++t) {
            const v4u pa = *(const GAS v4u*)(U + (size_t)(t0 + t) * NUP + c0), pv = *(const GAS v4u*)(U + (size_t)(t0 + t) * NUP + DFF + c0);
            float a0[8], vv[8], o[8];
            a0[0] = bf2f(pa.x & 0xffffu); a0[1] = bf2f(pa.x >> 16); a0[2] = bf2f(pa.y & 0xffffu); a0[3] = bf2f(pa.y >> 16); a0[4] = bf2f(pa.z & 0xffffu); a0[5] = bf2f(pa.z >> 16); a0[6] = bf2f(pa.w & 0xffffu); a0[7] = bf2f(pa.w >> 16);
            vv[0] = bf2f(pv.x & 0xffffu); vv[1] = bf2f(pv.x >> 16); vv[2] = bf2f(pv.y & 0xffffu); vv[3] = bf2f(pv.y >> 16); vv[4] = bf2f(pv.z & 0xffffu); vv[5] = bf2f(pv.z >> 16); vv[6] = bf2f(pv.w & 0xffffu); vv[7] = bf2f(pv.w >> 16);
#pragma unroll
            for (int e = 0; e < 8; ++e) { const float ac = bb[e] + w0[e] * a2[e] + w1[e] * a1[e] + w2[e] * a0[e]; o[e] = gelu_tanh(ac) * vv[e]; a2[e] = a1[e]; a1[e] = a0[e]; }
            v4u w; w.x = pk2(o[0], o[1]); w.y = pk2(o[2], o[3]); w.z = pk2(o[4], o[5]); w.w = pk2(o[6], o[7]);
            *(GAS v4u*)(G + (size_t)(t0 + t) * DFF + c0) = w;
        }
    }
}
__device__ __forceinline__ void ld8(const bf16* p, float (&o)[8]) { const v4u v = *(const GAS v4u*)p; o[0] = bf2f(v.x & 0xffffu); o[1] = bf2f(v.x >> 16); o[2] = bf2f(v.y & 0xffffu); o[3] = bf2f(v.y >> 16); o[4] = bf2f(v.z & 0xffffu); o[5] = bf2f(v.z >> 16); o[6] = bf2f(v.w & 0xffffu); o[7] = bf2f(v.w >> 16); }
__device__ __forceinline__ void up8(const v4u v, float (&o)[8]) { o[0] = bf2f(v.x & 0xffffu); o[1] = bf2f(v.x >> 16); o[2] = bf2f(v.y & 0xffffu); o[3] = bf2f(v.y >> 16); o[4] = bf2f(v.z & 0xffffu); o[5] = bf2f(v.z >> 16); o[6] = bf2f(v.w & 0xffffu); o[7] = bf2f(v.w >> 16); }
__device__ __forceinline__ void conv_fixup(const bf16* H, bf16* G, const float* cw, const float* cb, int pm, int tid) {
    if (tid >= DFF / 8) return;
    asm volatile("" : "+s"(pm));
    const int c0 = 8 * tid;
    v4u ld[4][6];
#pragma unroll
    for (int g = 0; g < 4; ++g) { const int grp = 4 * pm + g; const bool seq0 = ((grp * 64) & (SEQ - 1)) == 0; const int gp = seq0 ? grp : grp - 1;
        ld[g][0] = *(const GAS v4u*)(H + (size_t)(gp * 6 + 0) * DFF + c0);  ld[g][1] = *(const GAS v4u*)(H + (size_t)(gp * 6 + 1) * DFF + c0);
        ld[g][2] = *(const GAS v4u*)(H + (size_t)(grp * 6 + 2) * DFF + c0); ld[g][3] = *(const GAS v4u*)(H + (size_t)(grp * 6 + 3) * DFF + c0);
        ld[g][4] = *(const GAS v4u*)(H + (size_t)(grp * 6 + 4) * DFF + c0); ld[g][5] = *(const GAS v4u*)(H + (size_t)(grp * 6 + 5) * DFF + c0); }
    float w0[8], w1[8], w2[8], bb[8];
#pragma unroll
    for (int h = 0; h < 2; ++h) { const f32x4 a = *(const GAS f32x4*)(cw + c0 + 4 * h), b = *(const GAS f32x4*)(cw + DFF + c0 + 4 * h), c = *(const GAS f32x4*)(cw + 2 * DFF + c0 + 4 * h), d = *(const GAS f32x4*)(cb + c0 + 4 * h);
#pragma unroll
        for (int i = 0; i < 4; ++i) { w0[4 * h + i] = a[i]; w1[4 * h + i] = b[i]; w2[4 * h + i] = c[i]; bb[4 * h + i] = d[i]; } }
#pragma unroll
    for (int g = 0; g < 4; ++g) { const int grp = 4 * pm + g; const float pz = (((grp * 64) & (SEQ - 1)) == 0) ? 0.f : 1.f;
        float p62[8], p63[8], a0[8], a1[8], v0[8], v1[8], o0[8], o1[8];
        up8(ld[g][0], p62); up8(ld[g][1], p63); up8(ld[g][2], a0); up8(ld[g][3], a1); up8(ld[g][4], v0); up8(ld[g][5], v1);
#pragma unroll
        for (int e = 0; e < 8; ++e) { const float q62 = p62[e] * pz, q63 = p63[e] * pz;
            o0[e] = pg8::gelu_tanh_f(bb[e] + w0[e] * q62 + w1[e] * q63 + w2[e] * a0[e]) * v0[e];
            o1[e] = pg8::gelu_tanh_f(bb[e] + w0[e] * q63 + w1[e] * a0[e] + w2[e] * a1[e]) * v1[e]; }
        v4u x; x.x = pk2(o0[0], o0[1]); x.y = pk2(o0[2], o0[3]); x.z = pk2(o0[4], o0[5]); x.w = pk2(o0[6], o0[7]); *(GAS v4u*)(G + (size_t)(grp * 64) * DFF + c0) = x;
        v4u y; y.x = pk2(o1[0], o1[1]); y.y = pk2(o1[2], o1[3]); y.z = pk2(o1[4], o1[5]); y.w = pk2(o1[6], o1[7]); *(GAS v4u*)(G + (size_t)(grp * 64 + 1) * DFF + c0) = y; }
}
__device__ __forceinline__ void scan_phase(bf16* KV, int gt, int NGT) {
    constexpr int NIT = 16 * (256 * 128 / 4);
    for (int it = gt; it < NIT; it += NGT) {
        const int p = it / 8192, idx = it % 8192, h = p & 3;
        const float gc = GAMMA128_OF(h);
        GAS u32x2* base = (GAS u32x2*)(KV + (size_t)p * 32 * 32768) + idx;
        u32x2 ld[32];
#pragma unroll
        for (int n = 0; n < 32; ++n) ld[n] = base[(size_t)n * 8192];
        float s0 = 0.f, s1 = 0.f, s2 = 0.f, s3 = 0.f;
#pragma unroll
        for (int n = 0; n < 32; ++n) {
            u32x2 w; w.x = pk2(s0, s1); w.y = pk2(s2, s3); base[(size_t)n * 8192] = w;
            s0 = gc * s0 + bf2f(ld[n].x & 0xffffu); s1 = gc * s1 + bf2f(ld[n].x >> 16); s2 = gc * s2 + bf2f(ld[n].y & 0xffffu); s3 = gc * s3 + bf2f(ld[n].y >> 16);
        }
    }
}

__device__ __forceinline__ void attn_unit(LAS unsigned char* lds, const bf16* proj, bf16* aoa, const float* biastab, const float* sinks_l, int unit, int tid, int wave, int lane) {
    constexpr int KST = 144, VST = 136, K_OFF = 0, V_OFF = 256 * KST, B_OFF = V_OFF + 256 * VST;
    const int kh = unit & 1, n = (unit >> 1) & 31, bb = unit >> 6;
    const int rb = bb * SEQ + 128 * n;
#pragma unroll
    for (int it = tid; it < 2048; it += 512) {
        const int j = it >> 3, ch = it & 7;
        v4u kv = (v4u){0u, 0u, 0u, 0u}, vv = (v4u){0u, 0u, 0u, 0u};
        if (n > 0 || j >= 128) { const bf16* src = proj + (size_t)(rb - 128 + j) * DIN; kv = *(const GAS v4u*)(src + C_KA + kh * 64 + ch * 8); vv = *(const GAS v4u*)(src + C_VA + kh * 64 + ch * 8); }
        *(LAS v4u*)(lds + K_OFF + j * KST + ch * 16) = kv;
        *(LAS u32x2*)(lds + V_OFF + j * VST + ch * 16) = (u32x2){vv.x, vv.y};
        *(LAS u32x2*)(lds + V_OFF + j * VST + ch * 16 + 8) = (u32x2){vv.z, vv.w};
    }
    { LAS float* bl = (LAS float*)(lds + B_OFF); bl[tid] = biastab[(kh * 4 + (tid >> 7)) * 128 + (tid & 127)]; }
    __syncthreads();
    const int g = wave >> 1, qh = wave & 1, head = kh * 4 + g;
    const float sink = sinks_l[head];
    const int c = lane & 15, q = lane >> 4;
    const LAS float* bl = (const LAS float*)(lds + B_OFF) + g * 128;
    for (int qs = 0; qs < 4; ++qs) {
        const int i0 = 64 * qh + 16 * qs, i = i0 + c;
        const bf16* qsrc = proj + (size_t)(rb + i) * DIN + C_QA + head * 64 + 8 * q;
        const bf16x8 qf0 = *(const GAS bf16x8*)(qsrc), qf1 = *(const GAS bf16x8*)(qsrc + 32);
        f32x4 s[9];
#pragma unroll
        for (int kt = 0; kt < 9; ++kt) {
            const LAS unsigned char* kp = lds + K_OFF + (i0 + 16 * kt + c) * KST + 16 * q;
            const bf16x8 k0 = *(const LAS bf16x8*)kp, k1 = *(const LAS bf16x8*)(kp + 64);
            f32x4 a = (f32x4){0.f, 0.f, 0.f, 0.f};
            a = MFMA16(k0, qf0, a); a = MFMA16(k1, qf1, a); s[kt] = a;
        }
        float mx = -3.0e38f;
#pragma unroll
        for (int kt = 0; kt < 9; ++kt)
#pragma unroll
            for (int r = 0; r < 4; ++r) {
                const int j = i0 + 16 * kt + 4 * q + r, dist = 128 + i - j;
                const bool ok = (dist >= 0) && (dist < 128) && (n > 0 || j >= 128);
                const float v = ok ? s[kt][r] * 0.125f + bl[dist & 127] : -1.0e30f;
                s[kt][r] = v; mx = fmaxf(mx, v);
            }
        mx = fmaxf(mx, __shfl_xor(mx, 16)); mx = fmaxf(mx, __shfl_xor(mx, 32)); mx = fmaxf(mx, sink);
        float sum = 0.f;
#pragma unroll
        for (int kt = 0; kt < 9; ++kt)
#pragma unroll
            for (int r = 0; r < 4; ++r) { const float p = __expf(s[kt][r] - mx); s[kt][r] = p; sum += p; }
        sum += __shfl_xor(sum, 16); sum += __shfl_xor(sum, 32);
        const float inv = __builtin_amdgcn_rcpf(sum + __expf(sink - mx));
        f32x4 o[4];
#pragma unroll
        for (int dt = 0; dt < 4; ++dt) o[dt] = (f32x4){0.f, 0.f, 0.f, 0.f};
#pragma unroll
        for (int p = 0; p < 5; ++p) {
            const f32x4 ta = s[2 * p], tb = (2 * p + 1 < 9) ? s[2 * p + 1 < 9 ? 2 * p + 1 : 8] : (f32x4){0.f, 0.f, 0.f, 0.f};
            v4u pw; pw.x = pk2(ta[0], ta[1]); pw.y = pk2(ta[2], ta[3]); pw.z = pk2(tb[0], tb[1]); pw.w = pk2(tb[2], tb[3]);
            const bf16x8 pb = __builtin_bit_cast(bf16x8, pw);
#pragma unroll
            for (int dt = 0; dt < 4; ++dt) {
                bf16x8 va;
#pragma unroll
                for (int j = 0; j < 8; ++j) { int key = i0 + 32 * p + (j < 4 ? 4 * q + j : 16 + 4 * q + (j - 4)); key = key > 255 ? 255 : key;
                    va[j] = (short)*(const LAS u16*)(lds + V_OFF + key * VST + (16 * dt + c) * 2); }
                o[dt] = MFMA16(va, pb, o[dt]);
            }
        }
        bf16* orow = aoa + (size_t)(rb + i) * 1536 + head * 64 + 4 * q;
#pragma unroll
        for (int dt = 0; dt < 4; ++dt) { u32x2 w; w.x = pk2(o[dt][0] * inv, o[dt][1] * inv); w.y = pk2(o[dt][2] * inv, o[dt][3] * inv); *(GAS u32x2*)(orow + 16 * dt) = w; }
    }
    __syncthreads();
}

__device__ __forceinline__ void stage_copy(LAS unsigned char* img, const bf16* src, int s, int i8) {
    const v4u x1 = *(const GAS v4u*)(src), x2 = *(const GAS v4u*)(src + 64);
    *(LAS v4u*)(img + s * 272 + i8 * 16) = x1; *(LAS v4u*)(img + s * 272 + 128 + i8 * 16) = x2;
}
__device__ __forceinline__ void stage_v(LAS unsigned char* img, const bf16* proj, int rb, int h, int tid) {
#pragma unroll
    for (int it = tid; it < 4096; it += 512) { const int s = it >> 5, ch = it & 31;
        const v4u v = *(const GAS v4u*)(proj + (size_t)(rb + s) * DIN + C_VR + h * 256 + 8 * ch);
        *(LAS u32x2*)(img + s * 520 + ch * 16) = (u32x2){v.x, v.y}; *(LAS u32x2*)(img + s * 520 + ch * 16 + 8) = (u32x2){v.z, v.w}; }
}
__device__ __forceinline__ void kv_unit(LAS unsigned char* lds, const bf16* proj, bf16* kvbuf, int unit, int tid, int wave, int lane) {
    constexpr int KZ_OFF = 0, V_OFF = 128 * 272;
    const int n = unit & 31, h = (unit >> 5) & 3, bb = unit >> 7;
    const int rb = bb * SEQ + 128 * n;
    const float lg = __logf(1.0f - exp2f(-5.0f - (float)h)), g127 = __expf(127.0f * lg);
#pragma unroll
    for (int it = tid; it < 1024; it += 512) { const int s = it >> 3, i8 = it & 7; stage_copy(lds + KZ_OFF, proj + (size_t)(rb + s) * DIN + C_KR + h * 128 + 8 * i8, s, i8); }
    stage_v(lds + V_OFF, proj, rb, h, tid);
    __syncthreads();
    const int c = lane & 15, q = lane >> 4;
    f32x4 acc[2][8];
#pragma unroll
    for (int ei = 0; ei < 2; ++ei)
#pragma unroll
        for (int dt = 0; dt < 8; ++dt) acc[ei][dt] = (f32x4){0.f, 0.f, 0.f, 0.f};
#pragma unroll
    for (int ks = 0; ks < 4; ++ks) {
        bf16x8 bfr[2];
#pragma unroll
        for (int ei = 0; ei < 2; ++ei)
#pragma unroll
            for (int j = 0; j < 8; ++j) bfr[ei][j] = (short)*(const LAS u16*)(lds + V_OFF + (32 * ks + 8 * q + j) * 520 + (16 * (2 * wave + ei) + c) * 2);
#pragma unroll
        for (int dt = 0; dt < 8; ++dt) {
            bf16x8 af;
#pragma unroll
            for (int j = 0; j < 8; ++j) af[j] = (short)*(const LAS u16*)(lds + KZ_OFF + (32 * ks + 8 * q + j) * 272 + (16 * dt + c) * 2);
#pragma unroll
            for (int ei = 0; ei < 2; ++ei) acc[ei][dt] = MFMA16(af, bfr[ei], acc[ei][dt]);
        }
    }
#pragma unroll
    for (int ei = 0; ei < 2; ++ei) { const int e = 16 * (2 * wave + ei) + c; bf16* dst = kvbuf + ((size_t)unit * 256 + e) * 128 + 4 * q;
#pragma unroll
        for (int dt = 0; dt < 8; ++dt) { u32x2 w; w.x = pk2(acc[ei][dt][0] * g127, acc[ei][dt][1] * g127); w.y = pk2(acc[ei][dt][2] * g127, acc[ei][dt][3] * g127); *(GAS u32x2*)(dst + 16 * dt) = w; } }
    __syncthreads();
}
__device__ __forceinline__ void ret_unit(LAS unsigned char* lds, const bf16* proj, const bf16* kvbuf, bf16* aor, const float* rnorm_l, int unit, int tid, int wave, int lane) {
    constexpr int Q_OFF = 0, K_OFF = 128 * 272, V_OFF = 2 * 128 * 272;
    const int n = unit & 31, h = (unit >> 5) & 3, bb = unit >> 7;
    const int rb = bb * SEQ + 128 * n;
    const float lg = __logf(1.0f - exp2f(-5.0f - (float)h));
#pragma unroll
    for (int it = tid; it < 2048; it += 512) { const int which = it >> 10, s = (it >> 3) & 127, i8 = it & 7;
        stage_copy(lds + (which ? K_OFF : Q_OFF), proj + (size_t)(rb + s) * DIN + (which ? C_KR : C_QR) + h * 128 + 8 * i8, s, i8); }
    stage_v(lds + V_OFF, proj, rb, h, tid);
    __syncthreads();
    const int c = lane & 15, q = lane >> 4, cl = 16 * wave + c;
    bf16x8 qf[4];
#pragma unroll
    for (int ks = 0; ks < 4; ++ks) qf[ks] = *(const LAS bf16x8*)(lds + Q_OFF + cl * 272 + (32 * ks + 8 * q) * 2);
    f32x4 sT[8];
#pragma unroll
    for (int st = 0; st < 8; ++st) {
        f32x4 a = (f32x4){0.f, 0.f, 0.f, 0.f};
        if (st <= wave) {
#pragma unroll
            for (int ks = 0; ks < 4; ++ks) { const bf16x8 kf = *(const LAS bf16x8*)(lds + K_OFF + (16 * st + c) * 272 + (32 * ks + 8 * q) * 2); a = MFMA16(kf, qf[ks], a); }
#pragma unroll
            for (int r = 0; r < 4; ++r) { const int s = 16 * st + 4 * q + r; a[r] = (cl >= s) ? a[r] : 0.f; }
        }
        sT[st] = a;
    }
    f32x4 o[16];
    const bf16* stp = kvbuf + (size_t)unit * 256 * 128 + (size_t)c * 128 + 8 * q;
#pragma unroll
    for (int et = 0; et < 16; ++et) {
        f32x4 a = (f32x4){0.f, 0.f, 0.f, 0.f};
#pragma unroll
        for (int ks = 0; ks < 4; ++ks) { const bf16x8 sf = *(const GAS bf16x8*)(stp + (size_t)et * 16 * 128 + 32 * ks); a = MFMA16(sf, qf[ks], a); }
        o[et] = a;
    }
    const float xi = __expf(lg);
#pragma unroll
    for (int et = 0; et < 16; ++et) o[et] = o[et] * xi;
#pragma unroll
    for (int p = 0; p < 4; ++p) {
        if (2 * p <= wave) {
            const f32x4 ta = sT[2 * p], tb = sT[2 * p + 1];
            v4u pw; pw.x = pk2(ta[0], ta[1]); pw.y = pk2(ta[2], ta[3]); pw.z = pk2(tb[0], tb[1]); pw.w = pk2(tb[2], tb[3]);
            const bf16x8 pb = __builtin_bit_cast(bf16x8, pw);
#pragma unroll
            for (int et = 0; et < 16; ++et) {
                bf16x8 va;
#pragma unroll
                for (int j = 0; j < 8; ++j) { const int s = 32 * p + (j < 4 ? 4 * q + j : 16 + 4 * q + (j - 4)); va[j] = (short)*(const LAS u16*)(lds + V_OFF + s * 520 + (16 * et + c) * 2); }
                o[et] = MFMA16(va, pb, o[et]);
            }
        }
    }
    float sm = 0.f;
#pragma unroll
    for (int et = 0; et < 16; ++et) sm += (o[et][0] + o[et][1]) + (o[et][2] + o[et][3]);
    sm += __shfl_xor(sm, 16); sm += __shfl_xor(sm, 32);
    const float mu = sm * (1.0f / 256.0f);
    float vs = 0.f;
#pragma unroll
    for (int et = 0; et < 16; ++et) { const f32x4 d = o[et] - mu; vs += (d[0] * d[0] + d[1] * d[1]) + (d[2] * d[2] + d[3] * d[3]); }
    vs += __shfl_xor(vs, 16); vs += __shfl_xor(vs, 32);
    const float rs = __builtin_amdgcn_rsqf(vs * (1.0f / 256.0f) + EPS);
    const size_t tok = (size_t)(rb + cl);
    const bf16* grow = proj + tok * DIN + C_GR + h * 256 + 4 * q;
    bf16* orow = aor + tok * 1536 + 512 + h * 256 + 4 * q;
    const float* gn = rnorm_l + h * 256 + 4 * q;
#pragma unroll
    for (int et = 0; et < 16; ++et) {
        const u32x2 gv = *(const GAS u32x2*)(grow + 16 * et); const f32x4 gg = *(const GAS f32x4*)(gn + 16 * et);
        const float g0 = bf2f(gv.x & 0xffffu), g1 = bf2f(gv.x >> 16), g2 = bf2f(gv.y & 0xffffu), g3 = bf2f(gv.y >> 16);
        const float y0 = (o[et][0] - mu) * rs * gg.x * g0 * sigm(g0), y1 = (o[et][1] - mu) * rs * gg.y * g1 * sigm(g1), y2 = (o[et][2] - mu) * rs * gg.z * g2 * sigm(g2), y3 = (o[et][3] - mu) * rs * gg.w * g3 * sigm(g3);
        u32x2 w; w.x = pk2(y0, y1); w.y = pk2(y2, y3); *(GAS u32x2*)(orow + 16 * et) = w;
    }
    __syncthreads();
}

__device__ __forceinline__ void ret_dma(LAS unsigned char* buf, int type, const bf16* proj, const bf16* kvbuf, int unit, int wave, int lane) {
    const int n = unit & 31, h = (unit >> 5) & 3, bb = unit >> 7, rb = bb * SEQ + 128 * n;
    asm volatile("" : "+v"(lane));
#pragma unroll
    for (int i = 0; i < 4; ++i) {
        const int ins = wave * 4 + i, P = ins * 64 + lane;
        const char* src;
        if (type < 2) { const int r = P >> 4, ch = (P & 15) ^ (r & 15); src = (const char*)(proj + (size_t)(rb + r) * DIN + (type == 0 ? C_QR : C_KR) + h * 128) + ch * 16; }
        else if (type < 4) { const int r = (P >> 4) + 128 * (type - 2), ch = (P & 15) ^ (r & 15); src = (const char*)(kvbuf + ((size_t)unit * 256 + r) * 128) + ch * 16; }
        else { const int r = (P >> 5) + 64 * (type & 1), cp = P & 31, ch = (((cp >> 1) ^ (r & 7)) << 1) | (cp & 1); src = (const char*)(proj + (size_t)(rb + r) * DIN + (type < 6 ? C_VR : C_GR) + h * 256) + ch * 16; }
        __builtin_amdgcn_global_load_lds((const unsigned*)src, (LAS unsigned*)(buf + ins * 1024), 16, 0, 0);
    }
}
typedef short v4i16_t __attribute__((ext_vector_type(4)));
__device__ __forceinline__ bf16x8 tr_pair(const LAS unsigned char* p0, const LAS unsigned char* p1) {
    const v4i16_t lo = __builtin_amdgcn_ds_read_tr16_b64_v4i16((LAS v4i16_t*)p0), hi = __builtin_amdgcn_ds_read_tr16_b64_v4i16((LAS v4i16_t*)p1);
    return (bf16x8){lo[0], lo[1], lo[2], lo[3], hi[0], hi[1], hi[2], hi[3]};
}
__device__ __forceinline__ void ret_phase(LAS unsigned char* lds, const bf16* proj, const bf16* kvbuf, bf16* ao, const float* rnorm_l, int bx, int G, int wave, int lane) {
    const int nu = (512 - bx + G - 1) / G, nsteps = 8 * nu;
    { LAS float* gl = (LAS float*)(lds + RING_BYTES); const int t = wave * 64 + lane; gl[t] = ((const GAS float*)rnorm_l)[t]; gl[t + 512] = ((const GAS float*)rnorm_l)[t + 512]; }
    if (nsteps <= 0) return;
    const int c = lane & 15, q = lane >> 4, cl = 16 * wave + c;
    f32x4 sT[8], o[16]; bf16x8 qf[4];
#pragma unroll
    for (int i = 0; i < 8; ++i) sT[i] = (f32x4){0.f, 0.f, 0.f, 0.f};
#pragma unroll
    for (int i = 0; i < 16; ++i) o[i] = (f32x4){0.f, 0.f, 0.f, 0.f};
#pragma unroll
    for (int i = 0; i < 4; ++i) qf[i] = (bf16x8){0, 0, 0, 0, 0, 0, 0, 0};
    float mu = 0.f, rs = 0.f; int last_store = -100;
#pragma unroll
    for (int k0 = 0; k0 < 3; ++k0) if (k0 < nsteps) ret_dma(lds + k0 * 32768, k0 & 7, proj, kvbuf, bx + (k0 >> 3) * G, wave, lane);
    for (int k = 0; k < nsteps; ++k) {
        const int unit = bx + (k >> 3) * G, type = k & 7;
        const LAS unsigned char* buf = lds + (k & 3) * 32768;
        if (k + 3 < nsteps) ret_dma(lds + ((k + 3) & 3) * 32768, (k + 3) & 7, proj, kvbuf, bx + ((k + 3) >> 3) * G, wave, lane);
        const int later = nsteps - 1 - k;
        if (later >= 3) asm volatile("s_waitcnt vmcnt(12)" ::: "memory");
        else if (later == 2) asm volatile("s_waitcnt vmcnt(8)" ::: "memory");
        else if (later == 1) asm volatile("s_waitcnt vmcnt(4)" ::: "memory"); else asm volatile("s_waitcnt vmcnt(0)" ::: "memory");
        __builtin_amdgcn_s_barrier(); asm volatile("" ::: "memory");
        const int h = (unit >> 5) & 3;
        int co = c; asm volatile("" : "+v"(co));
        const int xq = (q ^ co) << 4;
        const LAS unsigned char* lb = buf + co * 256;
        if (type == 0) {
#pragma unroll
            for (int ks = 0; ks < 4; ++ks) qf[ks] = *(const LAS bf16x8*)(lb + wave * 4096 + (xq ^ (ks << 6)));
        } else if (type == 1) {
#pragma unroll
            for (int st = 0; st < 8; ++st) {
                f32x4 a = (f32x4){0.f, 0.f, 0.f, 0.f};
                if (st <= wave) {
#pragma unroll
                    for (int ks = 0; ks < 4; ++ks) { const bf16x8 kf = *(const LAS bf16x8*)(lb + st * 4096 + (xq ^ (ks << 6))); a = MFMA16(kf, qf[ks], a); }
#pragma unroll
                    for (int rr = 0; rr < 4; ++rr) { const int s = 16 * st + 4 * q + rr; a[rr] = (cl >= s) ? a[rr] : 0.f; }
                }
                sT[st] = a;
            }
        } else if (type < 4) {
            const float gam = GAMMA_OF(h);
#pragma unroll
            for (int e8 = 0; e8 < 8; ++e8) {
                f32x4 a = (f32x4){0.f, 0.f, 0.f, 0.f};
#pragma unroll
                for (int ks = 0; ks < 4; ++ks) { const bf16x8 sf = *(const LAS bf16x8*)(lb + e8 * 4096 + (xq ^ (ks << 6))); a = MFMA16(sf, qf[ks], a); }
                o[e8] = a * gam;
            }
            if (type == 2) {
#pragma unroll
                for (int e8 = 0; e8 < 8; ++e8) o[8 + e8] = o[e8];
            }
        } else if (type < 6) {
            const int x0 = (4 * q + (co >> 2)) & 7;
            const LAS unsigned char* vb = buf + (4 * q + (co >> 2)) * 512 + (co & 3) * 8;
            const int pbase = (type & 1) * 2;
#pragma unroll
            for (int pp = 0; pp < 2; ++pp) {
                if (2 * (pbase + pp) <= wave) {
                    const f32x4 ta = sT[2 * pp], tb = sT[2 * pp + 1];
                    v4u pw; pw.x = pk2(ta[0], ta[1]); pw.y = pk2(ta[2], ta[3]); pw.z = pk2(tb[0], tb[1]); pw.w = pk2(tb[2], tb[3]);
                    const bf16x8 pb = __builtin_bit_cast(bf16x8, pw);
#pragma unroll
                    for (int r = 0; r < 16; ++r) { const int et = r ^ 8, po = (((et & 7) ^ x0) << 5) + ((et & 8) << 5);
                        const bf16x8 va = tr_pair(vb + pp * 32 * 512 + po, vb + pp * 32 * 512 + 16 * 512 + po); o[r] = MFMA16(va, pb, o[r]); }
                }
            }
            if (type == 4) {
#pragma unroll
                for (int i = 0; i < 4; ++i) sT[i] = sT[4 + i];
            } else {
                float sm = 0.f;
#pragma unroll
                for (int r = 0; r < 16; ++r) sm += (o[r][0] + o[r][1]) + (o[r][2] + o[r][3]);
                sm += __shfl_xor(sm, 16); sm += __shfl_xor(sm, 32);
                mu = sm * (1.0f / 256.0f);
                float vs = 0.f;
#pragma unroll
                for (int r = 0; r < 16; ++r) { const f32x4 d = o[r] - mu; vs += (d[0] * d[0] + d[1] * d[1]) + (d[2] * d[2] + d[3] * d[3]); }
                vs += __shfl_xor(vs, 16); vs += __shfl_xor(vs, 32);
                rs = __builtin_amdgcn_rsqf(vs * (1.0f / 256.0f) + EPS);
            }
        } else if ((type == 6) == (wave < 4)) {
            const int n = unit & 31, bb = unit >> 7; const size_t tok = (size_t)(bb * SEQ + 128 * n + cl);
            bf16* orow = ao + tok * 1536 + 512 + h * 256 + 4 * q;
            const LAS unsigned char* gb = buf + (cl & 63) * 512 + 8 * q;
            const LAS float* gl = (const LAS float*)(lds + RING_BYTES) + h * 256 + 4 * q;
            const int xr = cl & 7; const float murs = mu * rs;
#pragma unroll
            for (int r = 0; r < 16; ++r) { const int et = r ^ 8;
                const u32x2 gv = *(const LAS u32x2*)(gb + ((((et & 7) ^ xr) | (et & 8)) << 5)); const f32x4 gg = *(const LAS f32x4*)(gl + 16 * et);
                typedef float f2_t __attribute__((ext_vector_type(2)));
                const f2_t ga = (f2_t){bf2f(gv.x & 0xffffu), __uint_as_float(gv.x & 0xffff0000u)}, gb_ = (f2_t){bf2f(gv.y & 0xffffu), __uint_as_float(gv.y & 0xffff0000u)};
                const f2_t xa = ga * -1.4426950408889634f, xb = gb_ * -1.4426950408889634f;
                f2_t ea, eb; ea.x = __builtin_amdgcn_exp2f(xa.x); ea.y = __builtin_amdgcn_exp2f(xa.y); eb.x = __builtin_amdgcn_exp2f(xb.x); eb.y = __builtin_amdgcn_exp2f(xb.y);
                const f2_t da = ea + 1.0f, db = eb + 1.0f; f2_t sa, sb; sa.x = __builtin_amdgcn_rcpf(da.x); sa.y = __builtin_amdgcn_rcpf(da.y); sb.x = __builtin_amdgcn_rcpf(db.x); sb.y = __builtin_amdgcn_rcpf(db.y);
                const f2_t ta = ((f2_t){o[r][0], o[r][1]} * rs - murs) * (f2_t){gg.x, gg.y} * ga * sa, tb = ((f2_t){o[r][2], o[r][3]} * rs - murs) * (f2_t){gg.z, gg.w} * gb_ * sb;
                const float y0 = ta.x, y1 = ta.y, y2 = tb.x, y3 = tb.y;
                u32x2 w; w.x = pk2(y0, y1); w.y = pk2(y2, y3); *(GAS u32x2*)(orow + 16 * et) = w;
            }
            last_store = k;
        }
        asm volatile("s_waitcnt lgkmcnt(0)" ::: "memory"); __builtin_amdgcn_s_barrier(); asm volatile("" ::: "memory");
    }
}

__device__ __forceinline__ void mix_dma(LAS unsigned char* buf, int k, const bf16* proj, int bx, int wave, int lane) {
    asm volatile("" : "+v"(lane));
    if (k == 0) {
        const int kh = bx & 1, n = (bx >> 1) & 31, bb = bx >> 6, rb = bb * SEQ + 128 * n;
#pragma unroll
        for (int i = 0; i < 8; ++i) {
            const int ins = wave * 8 + i, P = (ins * 64 + lane) & 2047, r = P >> 3, cp = P & 7, isv = ins >> 5;
            const int ch = isv ? ((((cp >> 1) ^ ((r >> 1) & 3)) << 1) | (cp & 1)) : (cp ^ (r & 7));
            const int grow = (n == 0 && r < 128) ? rb + r : rb - 128 + r;
            const char* src = (const char*)(proj + (size_t)grow * DIN + (isv ? C_VA : C_KA) + kh * 64) + ch * 16;
            __builtin_amdgcn_global_load_lds((const unsigned*)src, (LAS unsigned*)(buf + ins * 1024), 16, 0, 0);
        }
    } else {
        const int unit = bx + 256 * ((k - 1) >> 1), half = (k - 1) & 1;
        const int n = unit & 31, h = (unit >> 5) & 3, bb = unit >> 7, rb = bb * SEQ + 128 * n + 64 * half;
#pragma unroll
        for (int i = 0; i < 6; ++i) {
            const int ins = wave * 6 + i; const char* src;
            if (ins < 16) { const int P = ins * 64 + lane, r = P >> 4, cp = P & 15, ch = (((cp >> 1) ^ (r & 7)) << 1) | (cp & 1); src = (const char*)(proj + (size_t)(rb + r) * DIN + C_KR + h * 128) + ch * 16; }
            else { const int P = (ins - 16) * 64 + lane, r = P >> 5, cp = P & 31, ch = (((cp >> 1) ^ (r & 7)) << 1) | (cp & 1); src = (const char*)(proj + (size_t)(rb + r) * DIN + C_VR + h * 256) + ch * 16; }
            __builtin_amdgcn_global_load_lds((const unsigned*)src, (LAS unsigned*)(buf + ins * 1024), 16, 0, 0);
        }
    }
}
__device__ __forceinline__ void mix_phase(LAS unsigned char* lds, const bf16* proj, bf16* ao, bf16* kvbuf, const float* biastab, const float* sinks_l, int bx, int wave, int lane) {
    { LAS float* bl = (LAS float*)(lds + RING_BYTES + 4096); const int khh = bx & 1;
      for (int t = wave * 64 + lane; t < 640; t += 512) { const int h4 = t / 160, x = t % 160 - 16; bl[t] = (x >= 0 && x < 128) ? ((const GAS float*)biastab)[(khh * 4 + h4) * 128 + (127 - x)] * 1.4426950408889634f : 0.f; } }
    const int c = lane & 15, q = lane >> 4;
    mix_dma(lds, 0, proj, bx, wave, lane);
    {
        const int kh = bx & 1, an = (bx >> 1) & 31, abb = bx >> 6, arb = abb * SEQ + 128 * an;
        const int g = wave >> 1, qh = wave & 1, head = kh * 4 + g;
        bf16x8 qf[4][2];
#pragma unroll
        for (int qs = 0; qs < 4; ++qs) { const bf16* qsrc = proj + (size_t)(arb + 64 * qh + 16 * qs + c) * DIN + C_QA + head * 64 + 8 * q;
            qf[qs][0] = *(const GAS bf16x8*)(qsrc); qf[qs][1] = *(const GAS bf16x8*)(qsrc + 32); }
        const float sink = ((const GAS float*)sinks_l)[head];
        mix_dma(lds + 65536, 1, proj, bx, wave, lane); asm volatile("s_waitcnt vmcnt(6)" ::: "memory");
        __builtin_amdgcn_s_barrier(); asm volatile("" ::: "memory");
        int co = c; asm volatile("" : "+v"(co));
        const LAS unsigned char* buf = lds;
        const int db = 128 + co - 4 * q;
        const LAS float* tb = (const LAS float*)(lds + RING_BYTES + 4096) + g * 160 + (143 - db);
        const float sink2 = sink * 1.4426950408889634f;
        const int kx0 = (q ^ (co & 7)) << 4, kx1 = kx0 ^ 64;
        const LAS unsigned char* Kb = buf + co * 128;
        const LAS unsigned char* Vb = buf + 32768 + ((co & 1) << 4);
        const int vph = (co >> 1) & 1;
#pragma unroll 1
        for (int qs = 0; qs < 4; ++qs) {
            const int i0 = 64 * qh + 16 * qs, i = i0 + c;
            const bf16x8 q0 = qs == 0 ? qf[0][0] : qs == 1 ? qf[1][0] : qs == 2 ? qf[2][0] : qf[3][0], q1 = qs == 0 ? qf[0][1] : qs == 1 ? qf[1][1] : qs == 2 ? qf[2][1] : qf[3][1];
            f32x4 s[9];
#pragma unroll
            for (int kt = 0; kt < 9; ++kt) {
                const LAS unsigned char* kp = Kb + (i0 + 16 * kt) * 128;
                f32x4 a = (f32x4){0.f, 0.f, 0.f, 0.f};
                a = MFMA16(*(const LAS bf16x8*)(kp + kx0), q0, a); a = MFMA16(*(const LAS bf16x8*)(kp + kx1), q1, a); s[kt] = a;
            }
            float mx = -3.0e38f;
#pragma unroll
            for (int kt = 0; kt < 9; ++kt)
#pragma unroll
                for (int r = 0; r < 4; ++r) { const int K = 16 * kt + r;
                    float v = s[kt][r] * (0.125f * 1.4426950408889634f) + tb[K];
                    if (kt == 0) v = (K > db - 128) ? v : -1.0e30f;
                    if (kt == 8) v = (K <= db) ? v : -1.0e30f;
                    s[kt][r] = v; }
            if (an == 0) {
#pragma unroll
                for (int kt = 0; kt < 9; ++kt)
#pragma unroll
                    for (int r = 0; r < 4; ++r) s[kt][r] = (i0 + 16 * kt + 4 * q + r >= 128) ? s[kt][r] : -1.0e30f;
            }
#pragma unroll
            for (int kt = 0; kt < 9; ++kt) mx = fmaxf(fmaxf(mx, fmaxf(s[kt][0], s[kt][1])), fmaxf(s[kt][2], s[kt][3]));
            mx = fmaxf(mx, __shfl_xor(mx, 16)); mx = fmaxf(mx, __shfl_xor(mx, 32)); mx = fmaxf(mx, sink2);
            float sum = 0.f;
#pragma unroll
            for (int kt = 0; kt < 9; ++kt)
#pragma unroll
                for (int r = 0; r < 4; ++r) { const float pe = __builtin_amdgcn_exp2f(s[kt][r] - mx); s[kt][r] = pe; sum += pe; }
            sum += __shfl_xor(sum, 16); sum += __shfl_xor(sum, 32);
            const float inv = __builtin_amdgcn_rcpf(sum + __builtin_amdgcn_exp2f(sink2 - mx));
            f32x4 o[4];
#pragma unroll
            for (int dt = 0; dt < 4; ++dt) o[dt] = (f32x4){0.f, 0.f, 0.f, 0.f};
#pragma unroll
            for (int p = 0; p < 5; ++p) {
                const f32x4 ta = s[2 * p], tb = (2 * p + 1 < 9) ? s[2 * p + 1 < 9 ? 2 * p + 1 : 8] : (f32x4){0.f, 0.f, 0.f, 0.f};
                v4u pw; pw.x = pk2(ta[0], ta[1]); pw.y = pk2(ta[2], ta[3]); pw.z = pk2(tb[0], tb[1]); pw.w = pk2(tb[2], tb[3]);
                const bf16x8 pb = __builtin_bit_cast(bf16x8, pw);
                int r0 = i0 + 32 * p + 4 * q + (co >> 2), r1 = r0 + 16; r1 = r1 > 255 ? 255 : r1;
                const LAS unsigned char* v0 = Vb + r0 * 128; const LAS unsigned char* v1 = Vb + r1 * 128;
                const int x0 = (r0 >> 1) & 3, x1 = (r1 >> 1) & 3;
#pragma unroll
                for (int dt = 0; dt < 4; ++dt) { const int pr = 2 * (dt >> 1) + vph; const bf16x8 va = tr_pair(v0 + ((pr ^ x0) << 5) + 8 * (dt & 1), v1 + ((pr ^ x1) << 5) + 8 * (dt & 1)); o[dt] = MFMA16(va, pb, o[dt]); }
            }
            bf16* orow = ao + (size_t)(arb + i) * 1536 + head * 64 + 8 * q;
#pragma unroll
            for (int j = 0; j < 2; ++j) { const f32x4 a0 = o[2 * j] * inv, a1 = o[2 * j + 1] * inv; v4u w; w.x = pk2(a0[0], a0[1]); w.y = pk2(a0[2], a0[3]); w.z = pk2(a1[0], a1[1]); w.w = pk2(a1[2], a1[3]); *(GAS v4u*)(orow + 32 * j) = w; }
        }
        asm volatile("s_waitcnt lgkmcnt(0)" ::: "memory"); __builtin_amdgcn_s_barrier(); asm volatile("" ::: "memory");
    }
    f32x4 acc[2][8];
#pragma unroll
    for (int ei = 0; ei < 2; ++ei)
#pragma unroll
        for (int dt = 0; dt < 8; ++dt) acc[ei][dt] = (f32x4){0.f, 0.f, 0.f, 0.f};
    for (int k = 1; k < 5; ++k) {
        const LAS unsigned char* buf = lds + (k & 1) * 65536;
        if (k + 1 < 5) { mix_dma(lds + ((k + 1) & 1) * 65536, k + 1, proj, bx, wave, lane); asm volatile("s_waitcnt vmcnt(6)" ::: "memory"); }
        else asm volatile("s_waitcnt vmcnt(0)" ::: "memory");
        if (k > 1) { __builtin_amdgcn_s_barrier(); asm volatile("" ::: "memory"); }
        else { __builtin_amdgcn_s_barrier(); asm volatile("" ::: "memory"); }
        int co = c; asm volatile("" : "+v"(co));
        const int unit = bx + 256 * ((k - 1) >> 1), half = (k - 1) & 1, h = (unit >> 5) & 3;
        const int rl = 4 * q + (co >> 2), x0 = rl & 7;
        const LAS unsigned char* kb = buf + rl * 256 + ((co & 1) << 4);
        const LAS unsigned char* vb = buf + 16384 + rl * 512 + (co & 3) * 8;
        const int ph = (co >> 1) & 1;
#pragma unroll
        for (int ks = 0; ks < 2; ++ks) {
            bf16x8 bfr[2];
#pragma unroll
            for (int ei = 0; ei < 2; ++ei) { const int et = 2 * wave + ei, po = (((et & 7) ^ x0) << 5) + ((et & 8) << 5); bfr[ei] = tr_pair(vb + ks * 32 * 512 + po, vb + ks * 32 * 512 + 16 * 512 + po); }
#pragma unroll
            for (int dt = 0; dt < 8; ++dt) { const int po = (((2 * (dt >> 1) + ph) ^ x0) << 5) + 8 * (dt & 1); const bf16x8 af = tr_pair(kb + ks * 32 * 256 + po, kb + ks * 32 * 256 + 16 * 256 + po);
#pragma unroll
                for (int ei = 0; ei < 2; ++ei) acc[ei][dt] = MFMA16(af, bfr[ei], acc[ei][dt]); }
        }
        if (half == 1) {
            const float g127 = GAMMA127_OF(h);
#pragma unroll
            for (int ei = 0; ei < 2; ++ei) { const int e = 16 * (2 * wave + ei) + c; bf16* dst = kvbuf + ((size_t)unit * 256 + e) * 128 + 8 * q;
#pragma unroll
                for (int j = 0; j < 4; ++j) { const f32x4 a0 = acc[ei][2 * j] * g127, a1 = acc[ei][2 * j + 1] * g127;
                    v4u w; w.x = pk2(a0[0], a0[1]); w.y = pk2(a0[2], a0[3]); w.z = pk2(a1[0], a1[1]); w.w = pk2(a1[2], a1[3]); *(GAS v4u*)(dst + 32 * j) = w;
                    acc[ei][2 * j] = (f32x4){0.f, 0.f, 0.f, 0.f}; acc[ei][2 * j + 1] = (f32x4){0.f, 0.f, 0.f, 0.f}; } }
        }
        asm volatile("s_waitcnt lgkmcnt(0)" ::: "memory"); __builtin_amdgcn_s_barrier(); asm volatile("" ::: "memory");
    }
}

struct Args { const float* in[16]; float* out; unsigned char* ws; int ph_lo, ph_hi; };
__global__ void __launch_bounds__(NWAVES * 64, 2) skel_fwd(Args args) {
    extern __shared__ __attribute__((aligned(16))) unsigned char lds_raw[];
    LAS unsigned char* lds = (LAS unsigned char*)lds_raw;
    volatile LAS unsigned* MISC = (volatile LAS unsigned*)(lds + MISC_OFF);
    const int G = 256, bx = blockIdx.x; __builtin_assume(bx >= 0 && bx < 256);
    const int NGW = G * NWAVES, NGT = G * NWAVES * 64;
#define PH_IDS int tid = threadIdx.x; asm volatile("" : "+v"(tid)); const int lane = tid & 63, wave = __builtin_amdgcn_readfirstlane(tid >> 6), gw = bx * NWAVES + wave, gt = bx * (NWAVES * 64) + tid; int bxp = bx; asm volatile("" : "+s"(bxp)); (void)lane; (void)wave; (void)gw; (void)gt; (void)bxp;
    unsigned char* ws = args.ws;
    gu32* ctl = (gu32*)(ws + WS_CTL);
#if MK_ONE_LAUNCH
    constexpr int lo = 0, hi = N_PHASES;
#else
    const int lo = args.ph_lo, hi = args.ph_hi;
#endif
    if (threadIdx.x < 64) MISC[threadIdx.x] = 0u;
#ifdef PROBE_EPI
    if (threadIdx.x == 0) { ((volatile LAS unsigned long long*)(lds + MISC_OFF + 1024))[0] = 0ull; ((volatile LAS unsigned long long*)(lds + MISC_OFF + 1024))[1] = 0ull; }
#endif
    if (threadIdx.x == 0) { LAS unsigned long long* pt = (LAS unsigned long long*)(lds + MISC_OFF + 512);
#pragma unroll
        for (int i = 0; i < 16; ++i) pt[i] = (unsigned long long)args.in[i];
        pt[16] = (unsigned long long)args.out; pt[17] = (unsigned long long)args.ws; }
    __syncthreads();
    if (hi - lo > 1) (void)xcd_barrier_post((unsigned*)(ctl + CW_BAR), MISC + 8);
#define BAR_NOW() do { XcdBarrier b_; b_.bar = (unsigned*)((gu32*)((unsigned char*)ldptr(17) + WS_CTL) + CW_BAR); b_.x = xb_xcc_id(); b_.st = (volatile LAS unsigned*)(lds + MISC_OFF) + 8; xcd_barrier(b_); } while (0)
#ifndef PHMASK
#define PHMASK 0xFFFF
#endif
#define PHM(b) ((PHMASK >> (b)) & 1)
#ifndef REPMASK
#define REPMASK 0
#endif
#define REP(b) for (int rep_ = 0; rep_ <= ((REPMASK >> (b)) & 1); ++rep_)
#define IN(k) (lo <= (k) && (k) < hi)
#ifdef PROBE_PH
    unsigned long long tprev = __builtin_amdgcn_s_memrealtime(), psum = 0ull;
#define SEAM(k) do { if ((k) + 1 < hi) BAR_NOW(); { const unsigned long long now_ = __builtin_amdgcn_s_memrealtime(); const int ty_ = (k) == 0 ? 0 : ((k) - 1) % PH_PER + 1;     if (ty_ == PROBE_PH) psum += now_ - tprev; tprev = now_; } } while (0)
#else
#define SEAM(k) do { if ((k) + 1 < hi) BAR_NOW(); } while (0)
#endif

    auto ldptr = [&](int i) -> unsigned long long { unsigned ao_ = (unsigned)(MISC_OFF + 512 + 8 * i); asm volatile("" : "+v"(ao_));
        const unsigned long long v = *(const volatile LAS unsigned long long*)(lds + ao_);
        return ((unsigned long long)(unsigned)__builtin_amdgcn_readfirstlane((int)(v >> 32)) << 32) | (unsigned)__builtin_amdgcn_readfirstlane((int)(unsigned)v); };
#define INP(i) ((const float*)ldptr(i))
#define PH_BASE unsigned char* wq = (unsigned char*)ldptr(17);
#define WSP(T, off) ((T*)(wq + (off)))
#define RS_FILL(S_, statp, pmvar, qsp) int pmvar = -1; { pg8::Unit u0_; (void)(S_).next(0, u0_); { pmvar = u0_.pm; int t_ = threadIdx.x; asm volatile("" : "+v"(t_)); if (t_ < 256) { const pg8::f32x4 sv_ = *(const GAS pg8::f32x4*)((statp) + (size_t)(u0_.pm * 256 + t_) * 4); ((LAS float*)(lds + RING_BYTES + 8192))[t_] = __builtin_amdgcn_rsqf(((sv_[0] + sv_[1]) + (sv_[2] + sv_[3])) * (1.0f / 1024.0f) + EPS) * ((qsp) ? ((const GAS float*)(qsp))[u0_.pm * 256 + t_] : 1.0f); } } } __syncthreads();
#define RS_FILLQ(S_, statp, qsp) { pg8::Unit u0_; (void)(S_).next(0, u0_); { int t_ = threadIdx.x; asm volatile("" : "+v"(t_)); const int r_ = u0_.pm * 256 + (t_ & 255); const pg8::f32x4 sv_ = *(const GAS pg8::f32x4*)((statp) + (size_t)r_ * 4); ((LAS float*)(lds + RING_BYTES + 8192))[t_] = __builtin_amdgcn_rsqf(((sv_[0] + sv_[1]) + (sv_[2] + sv_[3])) * (1.0f / 1024.0f) + EPS) * (((qsp) && t_ >= 256) ? ((const GAS float*)(qsp))[r_] : 1.0f); } } __syncthreads();
#define RS_FILL2(S_, statp, pmvar, qsp) int pmvar = -1; { pg8::Unit u0_; (void)(S_).next(0, u0_); { pmvar = u0_.pm; int t_ = threadIdx.x; asm volatile("" : "+v"(t_)); const int pr_ = u0_.pm + 8 * (t_ >> 8); if (pr_ < M / 256) { const pg8::f32x4 sv_ = *(const GAS pg8::f32x4*)((statp) + (size_t)(pr_ * 256 + (t_ & 255)) * 4); ((LAS float*)(lds + RING_BYTES + 8192))[t_] = __builtin_amdgcn_rsqf(((sv_[0] + sv_[1]) + (sv_[2] + sv_[3])) * (1.0f / 1024.0f) + EPS) * ((qsp) ? ((const GAS float*)(qsp))[pr_ * 256 + (t_ & 255)] : 1.0f); } } } __syncthreads();

#define SEL_IN8 ColSel{88, 24, 96, 3, 12}
#define SEL_INB ColSel{96, 0, 24, 1 << 20, 0}
#define WAMAX_P(L_, mi) ((unsigned*)(WSP(unsigned, WS_CTL) + CW_WAMAX + (L_) * 512 + (mi) * 256))
#define CONVERT_A(L_, gwv, ngwv) { LAS float* scr = (LAS float*)(lds + wave * 16384); bf16* wl = WSP(bf16, WS_W) + (size_t)(L_) * W_LAYER; \
        if (PG_I8_P1) p0_amax(INP(2) + (size_t)(L_) * D * DIN, D, DIN, (gwv), (ngwv), lane, 2, INP(1) + (L_) * D, WAMAX_P(L_, 0), SEL_IN8); \
        if (PG_I8_UP) p0_amax(INP(11) + (size_t)(L_) * D * NUP, D, NUP, (gwv), (ngwv), lane, 1, INP(10) + (L_) * D, WAMAX_P(L_, 1), ColSel{NUP / 32, NUP / 32, 0, 1 << 20, 0}); \
        p0_matrix<false>(INP(6) + (size_t)(L_) * 512 * D, 512, D, wl + W_OA, 1536, scr, (gwv), (ngwv), lane, 3, nullptr); \
        p0_matrix<false>(INP(7) + (size_t)(L_) * D * D, D, D, wl + W_OA + 512, 1536, scr, (gwv), (ngwv), lane, 3, nullptr); \
        p0_matrix<false>(INP(14) + (size_t)(L_) * DFF * D, DFF, D, wl + W_DN, DFF, scr, (gwv), (ngwv), lane, 3, nullptr); }
#define CONVERT_B(L_, gwv, ngwv) { LAS float* scr = (LAS float*)(lds + wave * 16384); bf16* wl = WSP(bf16, WS_W) + (size_t)(L_) * W_LAYER; \
        if (PG_I8_P1) { p0_matrix_sel<true>(INP(2) + (size_t)(L_) * D * DIN, D, DIN, wl + W_IN8, D, scr, (gwv), (ngwv), lane, 2, INP(1) + (L_) * D, WAMAX_P(L_, 0), SEL_IN8); \
                        p0_matrix_sel<false>(INP(2) + (size_t)(L_) * D * DIN, D, DIN, wl + W_IN, D, scr, (gwv), (ngwv), lane, 2, INP(1) + (L_) * D, nullptr, SEL_INB); } \
        else p0_matrix<false>(INP(2) + (size_t)(L_) * D * DIN, D, DIN, wl + W_IN, D, scr, (gwv), (ngwv), lane, 2, INP(1) + (L_) * D); \
        if (PG_I8_UP) p0_matrix<true>(INP(11) + (size_t)(L_) * D * NUP, D, NUP, wl + W_UP, D, scr, (gwv), (ngwv), lane, 1, INP(10) + (L_) * D, WAMAX_P(L_, 1)); \
        else p0_matrix<false>(INP(11) + (size_t)(L_) * D * NUP, D, NUP, wl + W_UP, D, scr, (gwv), (ngwv), lane, 1, INP(10) + (L_) * D); \
        p0_matrix<false>(INP(8) + (size_t)(L_) * D * D, D, D, wl + W_O, D, scr, (gwv), (ngwv), lane, 3, nullptr); }
    if (PHM(0) && IN(0)) { PH_IDS PH_BASE
        CONVERT_A(0, gw, NGW)
        float* biastab = WSP(float, WS_BIAS); float* costab = WSP(float, WS_COS); float* sintab = WSP(float, WS_SIN);
        for (int t = gt; t < 1024; t += NGT) { const int head = t >> 7, dist = t & 127;
            int bucket = dist; if (dist >= 16) { bucket = 16 + (int)(log2f((float)dist * (1.0f / 16.0f)) * (16.0f / 3.0f)); bucket = bucket > 31 ? 31 : bucket; }
            ((GAS float*)biastab)[t] = ((const GAS float*)INP(4))[bucket * 8 + head]; }
        for (int t = gt; t < SEQ * 64; t += NGT) { const int pos = t >> 6, i = t & 63;
            const float fr = exp2f(-(float)i * (13.287712379549449f / 64.0f)); const float ang = (float)pos * fr;
            const double kk = rint((double)ang * 0.15915494309189535); const float rr = (float)((double)ang - kk * 6.283185307179586);
            ((GAS float*)costab)[t] = __cosf(rr); ((GAS float*)sintab)[t] = __sinf(rr); }
        xg_rows(INP(0), WSP(bf16, WS_XN), WSP(float, WS_STAT), WSP(signed char, WS_XQ), WSP(float, WS_QS), WSP(float, WS_AMX), gw, NGW, lane);
        xg_rows(INP(0) + (size_t)MH * D, WSP(bf16, WS_XN1), WSP(float, WS_STAT + 256 * 1024), WSP(signed char, WS_XQ) + (size_t)MH * D, WSP(float, WS_QS) + MH, WSP(float, WS_AMX) + (size_t)MH * 4, gw, NGW, lane);
        if (PG_I8_P1 || PG_I8_UP) BAR_NOW();
        CONVERT_B(0, gw, NGW)
        SEAM(0);
    }

    for (int l = 0; l < DEPTH; ++l) {
        const int pl = 1 + l * PH_PER;
#define WL (WSP(bf16, WS_W) + (size_t)l * W_LAYER)
#define XNP WSP(bf16, (hf ? WS_XN1 : WS_XN))
#define STAT_MIX WSP(float, WS_STAT + (size_t)hf * 256 * 1024)
#define STAT_FFN WSP(float, WS_STAT + (size_t)(2 + hf) * 256 * 1024)
#define AMX_MIX (WSP(float, WS_AMX) + (size_t)hf * MH * 4)
#define AMX_FFN (WSP(float, WS_AMX + 512 * 1024) + (size_t)hf * MH * 4)
        for (int hf = 0; hf < 2; ++hf) {
            const int pb = pl + hf * 6;
            const int einst = (l * 2 + hf) * 2;
#ifdef PROBE_XBAR
            if (IN(pb + 0)) { for (int xb_ = 0; xb_ < PROBE_XBAR; ++xb_) BAR_NOW(); }
#endif
            if (PHM(2) && IN(pb + 0)) { PH_BASE
                const float* qsh = PG_I8_P1 ? WSP(float, WS_QS) + (size_t)hf * MH : nullptr;
                if (PG_I8_P1) {
                    pg8::StaticOrder S; S.init(MH, 12 * 256, G, bx);
                    RS_FILLQ(S, STAT_MIX, qsh)
                    { pg8::Gemm g{XNP, WL + W_IN + (size_t)3 * 256 * D, MH, 12 * 256, D};
                      pg8::EpiBf16Rs<false, 0, 3, 0> E{WSP(bf16, WS_RA), DIN, WSP(float, WS_COS), WSP(float, WS_SIN), nullptr};
                      pg8::gemm_phase<pg8::EpiBf16Rs<false, 0, 3, 0>, pg8::StaticOrder, PG_ALIGN_P1, PG_SP2_P1>(lds, g, S, E); }
                    { pg8::StaticOrder S2; S2.init(MH, 11 * 256, G, bx);
                      pg8::Gemm g{(const bf16*)(WSP(signed char, WS_XQ) + (size_t)hf * MH * D), WL + W_IN8, MH, 11 * 256, D / 2};
                      pg8::EpiBf16Rs<true, 3, 12, 256> E{WSP(bf16, WS_RA), DIN, WSP(float, WS_COS), WSP(float, WS_SIN), WAMAX_P(l, 0)};
                      pg8::gemm_phase<pg8::EpiBf16Rs<true, 3, 12, 256>, pg8::StaticOrder, PG_ALIGN_P1, PG_SP2_P1>(lds, g, S2, E); }
                } else {
                    pg8::Gemm g{XNP, WL + W_IN, MH, DIN, D}; pg8::StaticOrder S; S.init(MH, DIN, G, bx);
                    RS_FILLQ(S, STAT_MIX, qsh)
                    pg8::EpiBf16Rs<false, 0, 0, 0> E{WSP(bf16, WS_RA), DIN, WSP(float, WS_COS), WSP(float, WS_SIN), nullptr};
                    pg8::gemm_phase<pg8::EpiBf16Rs<false, 0, 0, 0>, pg8::StaticOrder, PG_ALIGN_P1, PG_SP2_P1>(lds, g, S, E);
                }
                { int bxo = bx; asm volatile("" : "+s"(bxo));
                  if (l + 1 < DEPTH && bxo >= 192) { PH_IDS if (hf == 0) CONVERT_A(l + 1, (bxo - 192) * NWAVES + wave, 512) else CONVERT_B(l + 1, (bxo - 192) * NWAVES + wave, 512) } }
                SEAM(pb + 0);
            }
            if (PHM(3) && IN(pb + 1)) { PH_IDS PH_BASE
                mix_phase(lds, WSP(bf16, WS_RA), WSP(bf16, WS_AOA), WSP(bf16, WS_KV), WSP(float, WS_BIAS), INP(3) + l * 8, bxp, wave, lane);
                SEAM(pb + 1);
            }
            if (PHM(4) && IN(pb + 2)) { PH_IDS PH_BASE scan_phase(WSP(bf16, WS_KV), gt, NGT); SEAM(pb + 2); }
            if (PHM(5) && IN(pb + 3)) { PH_IDS PH_BASE
                ret_phase(lds, WSP(bf16, WS_RA), WSP(bf16, WS_KV), WSP(bf16, WS_AOA), INP(5) + l * 1024, bxp, G, wave, lane);
                SEAM(pb + 3);
            }
            if (PHM(6) && IN(pb + 4)) { PH_BASE
                pg8::Gemm g{WSP(bf16, WS_AOA), WL + W_OA, MH, D, 1536}; pg8::StaticOrder S; S.init(MH, D, G, bx);
                pg8::EpiGate2 E{WSP(bf16, WS_MG), D, WSP(bf16, WS_RA) + C_GA, WSP(bf16, WS_RA) + C_GT, DIN};
                pg8::gemm_phase<pg8::EpiGate2, pg8::StaticOrder, true, true>(lds, g, S, E);
                SEAM(pb + 4);
            }
            if (PHM(7) && IN(pb + 5)) { PH_BASE
                pg8::Gemm g{WSP(bf16, WS_MG), WL + W_O, MH, D, D}; pg8::StaticOrder S; S.init(MH, D, G, bx);
                pg8::PanelRms st{WSP(unsigned, WS_XSLOT), (unsigned*)(WSP(unsigned, WS_CTL) + CW_SEAM + (size_t)einst * 4096), WSP(unsigned, WS_CTL), EPS, 0x700u, AMX_MIX, WSP(float, WS_QS) + (size_t)hf * MH};
                pg8::EpiRmsRes<PG_I8_UP> E{XNP, nullptr, D, INP(9) + l * D, STAT_FFN, WSP(signed char, WS_XQ) + (size_t)hf * MH * D, AMX_FFN, st};
                pg8::gemm_phase<pg8::EpiRmsRes<PG_I8_UP>, pg8::StaticOrder, false, true>(lds, g, S, E);
                if (hf == 1) SEAM(pb + 5);
            }
        }
        if (PHM(9) && IN(pl + 12)) { PH_BASE
            pg8::Gemm g{PG_I8_UP ? (const bf16*)WSP(signed char, WS_XQ) : WSP(bf16, WS_XN), WL + W_UP, M, NUP, PG_I8_UP ? D / 2 : D}; pg8::StaticOrder S; S.init(M, NUP, G, bx);
            const float* qsf = PG_I8_UP ? WSP(float, WS_QS) : nullptr;
            RS_FILL2(S, WSP(float, WS_STAT + 2 * 256 * 1024), pmc, qsf)
#ifdef STAGGER_UP
            {
                const unsigned long long t0_ = __builtin_amdgcn_s_memrealtime(); const unsigned long long dl_ = (unsigned long long)(((bx >> 3) & 3) * STAGGER_UP);
                while (__builtin_amdgcn_s_memrealtime() - t0_ < dl_) __builtin_amdgcn_s_sleep(4);
            }
#endif
            pg8::EpiConv E{WSP(bf16, WS_G), WSP(bf16, WS_H), INP(12) + (size_t)l * 3 * DFF, INP(13) + (size_t)l * DFF, DFF, WSP(float, WS_STAT + 2 * 256 * 1024), EPS, pmc, qsf, WAMAX_P(l, 1)};
            pg8::gemm_phase<pg8::EpiConv, pg8::StaticOrder, PG_ALIGN_UP, true>(lds, g, S, E);
            SEAM(pl + 12);
        }
        for (int hf = 0; hf < 2; ++hf) {
            const int einst = (l * 2 + hf) * 2;
            if (PHM(11) && IN(pl + 13 + hf)) { PH_BASE
                bf16* Gh = WSP(bf16, WS_G) + (size_t)hf * MH * DFF; bf16* Hh = WSP(bf16, WS_H) + (size_t)hf * (MH / 64) * 6 * DFF;
                pg8::Gemm g{Gh, WL + W_DN, MH, D, DFF}; pg8::StaticOrder S; S.init(MH, D, G, bx);
                { pg8::Unit u0; int tf_ = threadIdx.x; asm volatile("" : "+v"(tf_)); (void)S.next(0, u0); conv_fixup(Hh, Gh, INP(12) + (size_t)l * 3 * DFF, INP(13) + (size_t)l * DFF, u0.pm, tf_); }
                asm volatile("s_waitcnt vmcnt(0)" ::: "memory"); __syncthreads();
                pg8::PanelRms st{WSP(unsigned, WS_XSLOT + 512 * 1024), (unsigned*)(WSP(unsigned, WS_CTL) + CW_SEAM + (size_t)(einst + 1) * 4096), WSP(unsigned, WS_CTL), EPS, 0x780u, AMX_FFN, WSP(float, WS_QS) + (size_t)hf * MH};
                pg8::EpiRmsRes<PG_I8_P1> E{XNP, (l + 1 < DEPTH) ? nullptr : (float*)ldptr(16) + (size_t)hf * MH * D, D, INP(15) + l * D, STAT_MIX, WSP(signed char, WS_XQ) + (size_t)hf * MH * D, AMX_MIX, st};
                pg8::gemm_phase<pg8::EpiRmsRes<PG_I8_P1>, pg8::StaticOrder, false, true>(lds, g, S, E);
                if (hf == 1) SEAM(pl + 13 + hf);
            }
        }
    }
#ifdef PROBE_EPI
    if (bx == 0 && threadIdx.x == 0) { const unsigned long long ps_ = ((volatile LAS unsigned long long*)(lds + MISC_OFF + 1024))[PROBE_EPI_MODE]; const unsigned long long t0_ = __builtin_amdgcn_s_memrealtime(); while (__builtin_amdgcn_s_memrealtime() - t0_ < (unsigned long long)PROBE_AMP * ps_) __builtin_amdgcn_s_sleep(8); }
#endif
#ifdef PROBE_PH
    if (bx == 0) { const unsigned long long t0_ = __builtin_amdgcn_s_memrealtime(); while (__builtin_amdgcn_s_memrealtime() - t0_ < (unsigned long long)PROBE_AMP * psum) __builtin_amdgcn_s_sleep(8); }
#endif
#undef IN
#undef SEAM
}

extern "C" void kernel_launch(void* const* d_in, const int* in_sizes, int n_in, void* d_out, int out_size, void* d_ws, size_t ws_size, hipStream_t stream) {
    static int grid = 0;
    if (grid == 0) {
        if (n_in != 16 || in_sizes[0] != M * D || out_size != M * D || ws_size < WS_END) { fprintf(stderr, "kernel_launch: unexpected shapes / workspace (n_in %d, ws %zu < %zu)\n", n_in, ws_size, (size_t)WS_END); grid = -1; return; }
        int dev = 0, cus = 0, per_cu = 0;
        if (hipGetDevice(&dev) != hipSuccess || hipDeviceGetAttribute(&cus, hipDeviceAttributeMultiprocessorCount, dev) != hipSuccess) { grid = -1; return; }
        if (hipFuncSetAttribute((const void*)skel_fwd, hipFuncAttributeMaxDynamicSharedMemorySize, LDS_BYTES) != hipSuccess) { fprintf(stderr, "kernel_launch: hipFuncSetAttribute failed\n"); grid = -1; return; }
        if (hipOccupancyMaxActiveBlocksPerMultiprocessor(&per_cu, (const void*)skel_fwd, NWAVES * 64, LDS_BYTES) != hipSuccess || per_cu < 1) fprintf(stderr, "kernel_launch: occupancy query reports %d\n", per_cu);
        (void)hipGetLastError();
        grid = cus;
        if (grid != 256) { fprintf(stderr, "kernel_launch: this kernel needs exactly 256 CUs (one 256x256 unit per workgroup in the fused-norm GEMM phases), got %d\n", grid); grid = -1; return; }
    }
    if (grid < 0) return;
    (void)hipMemsetAsync((char*)d_ws + WS_CTL, 0, CTL_ZERO_BYTES, stream);
    Args a{};
    for (int i = 0; i < 16; ++i) a.in[i] = (const float*)d_in[i];
    a.out = (float*)d_out; a.ws = (unsigned char*)d_ws;
#if MK_ONE_LAUNCH
    a.ph_lo = 0; a.ph_hi = N_PHASES;
    hipLaunchKernelGGL(skel_fwd, dim3(grid), dim3(NWAVES * 64), LDS_BYTES, stream, a);
#else
    for (int p = 0; p < N_PHASES; ++p) { a.ph_lo = p; a.ph_hi = p + 1; hipLaunchKernelGGL(skel_fwd, dim3(grid), dim3(NWAVES * 64), LDS_BYTES, stream, a); }
#endif
}
```

```cpp
#include <hip/hip_runtime.h>
#include <cstdio>
#include <cstdint>
#include <cmath>
#define MK_ONE_LAUNCH 1
#define PG_ALIGN_P1 true
#define PG_ALIGN_UP true
#define PG_NST 16
#define PG_SP2_P1 true
#define PG_I8_P1 true
#define PG_I8_UP true
__device__ __forceinline__ float gsel4(int h, float a, float b, float c, float d) { return h == 0 ? a : (h == 1 ? b : (h == 2 ? c : d)); }
#define GAMMA_OF(h) gsel4((h), 0.96875f, 0.984375f, 0.9921875f, 0.99609375f)
#define LOG2_GAMMA_OF(h) gsel4((h), -0.04580368961312479f, -0.02272007650008353f, -0.011315313227834146f, -0.005646563141142063f)
#define GAMMA127_OF(h) gsel4((h), 0.01773731465374751f, 0.13532968927456346f, 0.3693230522678801f, 0.6083133121044885f)
#define GAMMA128_OF(h) gsel4((h), 0.017183023570817902f, 0.1332151628796484f, 0.3664377159220373f, 0.6059370882290803f)
namespace pg8 {
#define PG8_LAS __attribute__((address_space(3)))
typedef unsigned short bf16_t;
typedef short bf16x8 __attribute__((ext_vector_type(8)));
typedef float f32x4 __attribute__((ext_vector_type(4)));
typedef unsigned u32x4 __attribute__((ext_vector_type(4)));
typedef int i32x4 __attribute__((ext_vector_type(4)));
typedef unsigned u32x2 __attribute__((ext_vector_type(2)));
constexpr int BM = 256, BK = 64, HALF = 128, HTB = HALF * BK * 2  , STAGE_BYTES = 8 * HTB, NXCD = 8, WGM = 8;

__host__ __device__ __forceinline__ int lds_byte(int r, int c) { const int st = (r >> 4) * 2 + (c >> 5), rr = r & 15, cc = c & 31, ob = rr * 64 + cc * 2; return st * 1024 + (ob ^ (((ob >> 9) & 1) << 5)); }
__host__ __device__ __forceinline__ void stage_rc(int b, int& R, int& C) { const int st = b / 1024, sb = b % 1024, swz = sb ^ (((sb >> 9) & 1) << 5); R = (st >> 1) * 16 + swz / 64; C = (st & 1) * 32 + (swz % 64) / 2; }
__host__ __device__ __forceinline__ int perm32(int rho) { const int n = rho >> 4, i = rho & 15; return 8 * (i >> 2) + 4 * n + (i & 3); }

struct Unit { int pm, pn; };
struct Gemm { const bf16_t* A; const bf16_t* Bt; int M, N, K; };

struct StaticOrder {
    int nM, nN, nwg, G, c;
    __host__ __device__ __forceinline__ void init(int M, int N, int G_, int c_) { nM = M / BM; nN = N / BM; nwg = nM * nN; G = G_; c = c_; }
    __host__ __device__ __forceinline__ bool next(int i, Unit& u) const {
        const long L = (long)i * G + c; if (L >= nwg) return false;
        int wgid = (int)L; { const int q = nwg / NXCD, r = nwg % NXCD, xcd = wgid % NXCD, off = wgid / NXCD; wgid = (xcd < r ? xcd * (q + 1) : r * (q + 1) + (xcd - r) * q) + off; }
        const int nig = WGM * nN, gid = wgid / nig, fm = gid * WGM, gsz = (nM - fm) < WGM ? (nM - fm) : WGM;
        u.pm = fm + ((wgid % nig) % gsz); u.pn = (wgid % nig) / gsz; return true;
    }
    __device__ __forceinline__ void a_ready(const Unit&) const {}
    __device__ __forceinline__ void done(const Unit&) const {}
};

__device__ __forceinline__ unsigned cvt_pk_bf16(float lo, float hi) { unsigned r; asm volatile("v_cvt_pk_bf16_f32 %0, %1, %2" : "=v"(r) : "v"(lo), "v"(hi)); return r; }
typedef float f32x2 __attribute__((ext_vector_type(2)));
__device__ __forceinline__ f32x2 gelu_pk(f32x2 v) {
    const f32x2 av = __builtin_elementwise_abs(v), d = av * 0.2316418882f + 1.0f;
    f32x2 t; t.x = __builtin_amdgcn_rcpf(d.x); t.y = __builtin_amdgcn_rcpf(d.y);
    f32x2 q = t * 0.5307027145f + (-0.7265760135f); q = q * t + 0.7107068705f; q = q * t + (-0.142248368f); q = q * t + 0.127414796f; q = q * t;
    const f32x2 s = (v * v) * (-0.72134752044f);
    f32x2 e; e.x = __builtin_amdgcn_exp2f(s.x); e.y = __builtin_amdgcn_exp2f(s.y);
    const f32x2 m = v * (q * e), r = v - m;
    f32x2 o; o.x = v.x < 0.f ? m.x : r.x; o.y = v.y < 0.f ? m.y : r.y; return o;
}

template <int ACT  > struct EpiBf16 {
    static constexpr bool PERM = true, AFTER_DRAIN = false, HAS_MID = false, I8 = false; static constexpr int MID_T = -1, NST = 0, PID = 0; static_assert(ACT == 0 || ACT == 1, "EpiBf16: ACT is 0 (none) or 1 (gelu_pk)");
    bf16_t* O; int ldc; const float* bias; int split_cols; size_t split_stride; float scale0;
    __device__ __forceinline__ void operator()(const f32x4 (&acc)[2][2][4][2], const Unit& u, int wr, int wc, int fr, int fq) const {
        const int row0 = u.pm * BM + wr * 64 + fr; int colt = u.pn * BM; bf16_t* base = O;
        float sc = 1.f; if (split_cols) { const int t = colt / split_cols; base += (size_t)t * split_stride; colt -= t * split_cols; if (t == 0) sc = scale0; }
        const int col0 = colt + wc * 32 + 8 * fq, bcol0 = u.pn * BM + wc * 32 + 8 * fq;
        f32x4 bv[2][2];
#pragma unroll
        for (int bj = 0; bj < 2; ++bj)
#pragma unroll
            for (int n = 0; n < 2; ++n) bv[bj][n] = bias ? *(const f32x4*)(bias + bcol0 + bj * HALF + 4 * n) : (f32x4){0.f, 0.f, 0.f, 0.f};
#pragma unroll
        for (int ai = 0; ai < 2; ++ai)
#pragma unroll
            for (int m = 0; m < 4; ++m) { bf16_t* rowp = base + (size_t)(row0 + ai * HALF + m * 16) * ldc + col0;
#pragma unroll
                for (int bj = 0; bj < 2; ++bj) { f32x4 v0 = acc[ai][bj][m][0] + bv[bj][0], v1 = acc[ai][bj][m][1] + bv[bj][1];
                    if (ACT == 1) { f32x2 a = gelu_pk((f32x2){v0[0], v0[1]}), b = gelu_pk((f32x2){v0[2], v0[3]}), c = gelu_pk((f32x2){v1[0], v1[1]}), d = gelu_pk((f32x2){v1[2], v1[3]});
                        v0 = (f32x4){a.x, a.y, b.x, b.y}; v1 = (f32x4){c.x, c.y, d.x, d.y}; }
                    v0 = v0 * sc; v1 = v1 * sc; u32x4 w; w.x = cvt_pk_bf16(v0[0], v0[1]); w.y = cvt_pk_bf16(v0[2], v0[3]); w.z = cvt_pk_bf16(v1[0], v1[1]); w.w = cvt_pk_bf16(v1[2], v1[3]);
                    *(u32x4*)(rowp + bj * HALF) = w; } }
    }
};

template <class Epi, class Sched, bool ALIGN_EPI = false, bool SP2 = false>
__device__ __forceinline__ void gemm_phase(PG8_LAS unsigned char* lds, const Gemm g, const Sched& S, const Epi& E) {
    int tid_o = threadIdx.x; asm volatile("" : "+v"(tid_o));
    const int tid = tid_o, wid = __builtin_amdgcn_readfirstlane(tid >> 6), lane = tid & 63, wr = wid >> 2, wc = wid & 3, fr = lane & 15, fq = lane >> 4;
    const int K = g.K, nt = K / BK;
    unsigned voffA[2], voffB[2];
#pragma unroll
    for (int i = 0; i < 2; ++i) { int R, C; stage_rc(tid * 16 + i * 8192, R, C); const int Rb = Epi::PERM ? ((R & ~31) + perm32(R & 31)) : R;
        voffA[i] = (unsigned)(R * K + C) * 2u; voffB[i] = (unsigned)(Rb * K + C) * 2u; }
    const size_t kstep = (size_t)(BK * 2);
    const size_t hstep = (size_t)HALF * K * 2;
    const size_t tstep = 2 * hstep;
    const unsigned ldsw = (unsigned)wid * 1024u;
    const int aoff = lds_byte(wr * 64 + fr, fq * 8), boff = lds_byte(wc * 32 + fr, fq * 8);
#define PG8_SA(b, h) (((b) * 2 + (h)) * HTB)
#define PG8_SB(b, h) ((4 + (b) * 2 + (h)) * HTB)
#define PG8_STAGE(bufoff, gbase, voff) do { _Pragma("unroll") for (int _i = 0; _i < 2; ++_i) \
        __builtin_amdgcn_global_load_lds((const unsigned*)((const char*)(gbase) + (voff)[_i]), (PG8_LAS unsigned*)(lds + (bufoff) + ldsw + _i * 8192), 16, 0, 0); } while (0)
#define PG8_LDA(dst, b, h) do { _Pragma("unroll") for (int m = 0; m < 4; ++m) _Pragma("unroll") for (int k = 0; k < 2; ++k) dst[m][k] = *(const PG8_LAS bf16x8*)(lds + PG8_SA(b, h) + aoff + m * 2048 + k * 1024); } while (0)
#define PG8_LDB(dst, b, h) do { _Pragma("unroll") for (int n = 0; n < 2; ++n) _Pragma("unroll") for (int k = 0; k < 2; ++k) dst[n][k] = *(const PG8_LAS bf16x8*)(lds + PG8_SB(b, h) + boff + n * 2048 + k * 1024); } while (0)
#define PG8_MMA(ai, bj, At, Bt) do { __builtin_amdgcn_s_setprio(1); _Pragma("unroll") for (int m = 0; m < 4; ++m) _Pragma("unroll") for (int n = 0; n < 2; ++n) _Pragma("unroll") for (int k = 0; k < 2; ++k) \
        { if constexpr (Epi::I8) acc[ai][bj][m][n] = __builtin_bit_cast(f32x4, __builtin_amdgcn_mfma_i32_16x16x64_i8(__builtin_bit_cast(i32x4, Bt[n][k]), __builtin_bit_cast(i32x4, At[m][k]), __builtin_bit_cast(i32x4, acc[ai][bj][m][n]), 0, 0, 0)); \
          else acc[ai][bj][m][n] = __builtin_amdgcn_mfma_f32_16x16x32_bf16(Bt[n][k], At[m][k], acc[ai][bj][m][n], 0, 0, 0); } __builtin_amdgcn_s_setprio(0); } while (0)
#define PG8_WAIT_V(n) asm volatile("s_waitcnt vmcnt(" #n ")" ::: "memory")
#define PG8_WAIT_L(n) asm volatile("s_waitcnt lgkmcnt(" #n ")" ::: "memory")
#define PG8_BAR __builtin_amdgcn_s_barrier()
#define PG8_SCHED __builtin_amdgcn_sched_barrier(0)
    Unit cur, nxt; int ui = 0;
    if (!S.next(0, cur)) return;
#ifdef PROBE_EPI
    unsigned long long pe_prev = __builtin_amdgcn_s_memrealtime();
#endif
    f32x4 acc[2][2][4][2];
#pragma unroll
    for (int a = 0; a < 2; ++a)
#pragma unroll
        for (int b = 0; b < 2; ++b)
#pragma unroll
            for (int m = 0; m < 4; ++m)
#pragma unroll
                for (int n = 0; n < 2; ++n) acc[a][b][m][n] = (f32x4){0.f, 0.f, 0.f, 0.f};
    bf16x8 At[4][2], B0[2][2], B1[2][2];
    const char* cA = (const char*)g.A + (size_t)cur.pm * tstep; const char* cB = (const char*)g.Bt + (size_t)cur.pn * tstep;
    S.a_ready(cur);
    if constexpr (SP2) {
        PG8_STAGE(PG8_SB(0, 0), cB, voffB); PG8_STAGE(PG8_SB(0, 1), cB + hstep, voffB); PG8_STAGE(PG8_SA(0, 0), cA, voffA); PG8_STAGE(PG8_SA(0, 1), cA + hstep, voffA);
        if (wr == 1) PG8_BAR;
        PG8_WAIT_V(2); PG8_BAR;
        PG8_STAGE(PG8_SB(1, 0), cB + kstep, voffB); PG8_STAGE(PG8_SA(1, 0), cA + kstep, voffA); PG8_STAGE(PG8_SB(1, 1), cB + hstep + kstep, voffB);
        PG8_WAIT_V(6); PG8_BAR;
    } else {
        PG8_STAGE(PG8_SB(0, 0), cB, voffB); PG8_STAGE(PG8_SA(0, 0), cA, voffA); PG8_STAGE(PG8_SB(0, 1), cB + hstep, voffB); PG8_STAGE(PG8_SA(0, 1), cA + hstep, voffA);
        if (wr == 1) PG8_BAR;
        PG8_WAIT_V(4); PG8_BAR;
        PG8_STAGE(PG8_SB(1, 0), cB + kstep, voffB); PG8_STAGE(PG8_SA(1, 0), cA + kstep, voffA); PG8_STAGE(PG8_SB(1, 1), cB + hstep + kstep, voffB);
        PG8_WAIT_V(6); PG8_BAR;
    }
#ifndef PG8_EARLY
#define PG8_EARLY PG8_STAGE(PG8_SA(1, 1), nA + kstep + hstep, voffA);
#endif
    int fresh = 0;
    for (;;) {
        const bool has_next = S.next(ui + 1, nxt);
        const char* nA = has_next ? (const char*)g.A + (size_t)nxt.pm * tstep : cA; const char* nB = has_next ? (const char*)g.Bt + (size_t)nxt.pn * tstep : cB;
        for (int t = 0; t < nt; t += 2) {
            const bool last = (t == nt - 2);
            const char* a1 = cA + (size_t)(t + 1) * kstep;
            const char* a2 = last ? nA : cA + (size_t)(t + 2) * kstep; const char* b2 = last ? nB : cB + (size_t)(t + 2) * kstep;
            const char* a3 = a2 + kstep; const char* b3 = b2 + kstep;
            if (last && has_next) S.a_ready(nxt);
            if constexpr (SP2) {
            int fresh_now = 0;
            if constexpr (Epi::NST != 0) { int tt = t; asm volatile("" : "+s"(tt)); fresh_now = (tt == 0) ? fresh : 0; }
#define PG8_WAIT_VF() do { static_assert(Epi::NST == 0 || Epi::NST == 14 || Epi::NST == 16, "NST"); \
        if constexpr (Epi::NST == 16) asm volatile("s_waitcnt vmcnt(26)\n\ts_cmp_lg_u32 %0, 0\n\ts_cbranch_scc1 .Lpg8f%=\n\ts_waitcnt vmcnt(8)\n.Lpg8f%=:" :: "s"(fresh_now) : "memory", "scc"); \
        else if constexpr (Epi::NST == 14) asm volatile("s_waitcnt vmcnt(24)\n\ts_cmp_lg_u32 %0, 0\n\ts_cbranch_scc1 .Lpg8g%=\n\ts_waitcnt vmcnt(8)\n.Lpg8g%=:" :: "s"(fresh_now) : "memory", "scc"); \
        else PG8_WAIT_V(8); } while (0)
            PG8_LDB(B0, 0, 0); PG8_LDB(B1, 0, 1); PG8_SCHED; PG8_LDA(At, 0, 0); PG8_STAGE(PG8_SA(1, 1), a1 + hstep, voffA);
            PG8_WAIT_VF(); PG8_WAIT_L(0); PG8_BAR; PG8_MMA(0, 0, At, B0); PG8_MMA(0, 1, At, B1); PG8_BAR; PG8_SCHED;
            PG8_LDA(At, 0, 1); PG8_STAGE(PG8_SB(0, 0), b2, voffB); PG8_STAGE(PG8_SB(0, 1), b2 + hstep, voffB); PG8_STAGE(PG8_SA(0, 0), a2, voffA);
            PG8_WAIT_VF(); PG8_WAIT_L(0); PG8_BAR; PG8_MMA(1, 0, At, B0); PG8_MMA(1, 1, At, B1); PG8_BAR; PG8_SCHED;
            PG8_LDB(B0, 1, 0); PG8_LDB(B1, 1, 1); PG8_SCHED; PG8_LDA(At, 1, 0); PG8_STAGE(PG8_SA(0, 1), a2 + hstep, voffA);
            PG8_WAIT_VF(); PG8_WAIT_L(0); PG8_BAR; PG8_MMA(0, 0, At, B0); PG8_MMA(0, 1, At, B1); PG8_BAR; PG8_SCHED;
            PG8_LDA(At, 1, 1); PG8_STAGE(PG8_SB(1, 0), b3, voffB); PG8_STAGE(PG8_SB(1, 1), b3 + hstep, voffB); PG8_STAGE(PG8_SA(1, 0), a3, voffA);
            PG8_WAIT_V(8); PG8_WAIT_L(0); PG8_BAR; PG8_MMA(1, 0, At, B0); PG8_MMA(1, 1, At, B1); PG8_BAR; PG8_SCHED;
#undef PG8_WAIT_VF
            } else {
            PG8_LDB(B0, 0, 0); PG8_SCHED; PG8_LDA(At, 0, 0); PG8_STAGE(PG8_SA(1, 1), a1 + hstep, voffA);
            PG8_WAIT_L(8); PG8_BAR; PG8_WAIT_L(0); PG8_MMA(0, 0, At, B0); PG8_BAR; PG8_SCHED;
            PG8_LDB(B1, 0, 1); PG8_STAGE(PG8_SB(0, 0), b2, voffB);
            PG8_BAR; PG8_WAIT_L(0); PG8_MMA(0, 1, At, B1); PG8_BAR;
            PG8_LDA(At, 0, 1); PG8_STAGE(PG8_SA(0, 0), a2, voffA);
            PG8_BAR; PG8_WAIT_L(0); PG8_MMA(1, 0, At, B0); PG8_BAR; PG8_SCHED;
            PG8_STAGE(PG8_SB(0, 1), b2 + hstep, voffB);
            PG8_WAIT_V(6); PG8_BAR; PG8_MMA(1, 1, At, B1); PG8_BAR;
            PG8_LDB(B0, 1, 0); PG8_SCHED; PG8_LDA(At, 1, 0); PG8_STAGE(PG8_SA(0, 1), a2 + hstep, voffA);
            PG8_WAIT_L(8); PG8_BAR; PG8_WAIT_L(0); PG8_MMA(0, 0, At, B0); PG8_BAR; PG8_SCHED;
            PG8_LDB(B1, 1, 1); PG8_STAGE(PG8_SB(1, 0), b3, voffB);
            PG8_BAR; PG8_WAIT_L(0); PG8_MMA(0, 1, At, B1); PG8_BAR;
            PG8_LDA(At, 1, 1); PG8_STAGE(PG8_SA(1, 0), a3, voffA);
            PG8_BAR; PG8_WAIT_L(0); PG8_MMA(1, 0, At, B0); PG8_BAR; PG8_SCHED;
            PG8_STAGE(PG8_SB(1, 1), b3 + hstep, voffB);
            PG8_WAIT_V(6); PG8_BAR; PG8_MMA(1, 1, At, B1); PG8_BAR;
            }
            if constexpr (Epi::HAS_MID) { if (t == Epi::MID_T) E.mid(acc, cur, wr, wc, fr, fq); }
        }
#ifdef PROBE_EPI
        const unsigned long long pe_t0 = __builtin_amdgcn_s_memrealtime();
#endif
        if constexpr (ALIGN_EPI) { if (wr == 0) PG8_BAR; }
        if constexpr (SP2 && ALIGN_EPI && Epi::NST != 0) { PG8_EARLY fresh = 1; }
        if constexpr (Epi::I8) {
#pragma unroll
            for (int a = 0; a < 2; ++a)
#pragma unroll
                for (int b = 0; b < 2; ++b)
#pragma unroll
                    for (int m = 0; m < 4; ++m)
#pragma unroll
                        for (int n = 0; n < 2; ++n) acc[a][b][m][n] = __builtin_convertvector(__builtin_bit_cast(i32x4, acc[a][b][m][n]), f32x4);
        }
        if constexpr (!Epi::AFTER_DRAIN) { E(acc, cur, wr, wc, fr, fq); S.done(cur); }
#ifdef PROBE_EPI
        if constexpr (Epi::PID == PROBE_EPI) { const unsigned long long now_ = __builtin_amdgcn_s_memrealtime();
            if (tid == 0) { volatile PG8_LAS unsigned long long* pa_ = (volatile PG8_LAS unsigned long long*)(lds + 143360 + 1024); pa_[0] += now_ - pe_t0; pa_[1] += now_ - pe_prev; }
            pe_prev = now_; }
#endif
        if (!has_next) break;
#pragma unroll
        for (int a = 0; a < 2; ++a)
#pragma unroll
            for (int b = 0; b < 2; ++b)
#pragma unroll
                for (int m = 0; m < 4; ++m)
#pragma unroll
                    for (int n = 0; n < 2; ++n) acc[a][b][m][n] = (f32x4){0.f, 0.f, 0.f, 0.f};
        cur = nxt; cA = nA; cB = nB; ++ui;
        if constexpr (ALIGN_EPI) { if (wr == 1) PG8_BAR; }
    }
    PG8_WAIT_V(0);
    if constexpr (!ALIGN_EPI) { if (wr == 0) PG8_BAR; }
    PG8_BAR;
    if constexpr (Epi::AFTER_DRAIN) { E.fused(acc, cur, wr, wc, fr, fq, lds, wid, lane); S.done(cur); }
#undef PG8_SA
#undef PG8_SB
#undef PG8_STAGE
#undef PG8_LDA
#undef PG8_LDB
#undef PG8_MMA
#undef PG8_WAIT_V
#undef PG8_WAIT_L
#undef PG8_BAR
#undef PG8_SCHED
}
}
namespace pg8 {
#define PG8_GAS __attribute__((address_space(1)))
#define ST16(p, v) (*(PG8_GAS u32x4*)(p) = (v))
constexpr int RSL_OFF = 131072 + 8192;
__device__ __forceinline__ const PG8_LAS float* rs_lds() { extern __shared__ __attribute__((aligned(16))) unsigned char lds_dyn_[]; return (const PG8_LAS float*)((PG8_LAS unsigned char*)lds_dyn_ + RSL_OFF); }
__device__ __forceinline__ void pair_swap(const u32x4 w0, const u32x4 w1, int odd, u32x4& dA, u32x4& dB) {
    const u32x4 snd = odd ? w0 : w1; u32x4 rcv;
    rcv.x = (unsigned)__builtin_amdgcn_update_dpp(0, (int)snd.x, 0xB1, 0xf, 0xf, false); rcv.y = (unsigned)__builtin_amdgcn_update_dpp(0, (int)snd.y, 0xB1, 0xf, 0xf, false);
    rcv.z = (unsigned)__builtin_amdgcn_update_dpp(0, (int)snd.z, 0xB1, 0xf, 0xf, false); rcv.w = (unsigned)__builtin_amdgcn_update_dpp(0, (int)snd.w, 0xB1, 0xf, 0xf, false);
    dA = odd ? rcv : w0; dB = odd ? w1 : rcv;
}
__device__ __forceinline__ float bfbits2f(unsigned b16) { return __uint_as_float(b16 << 16); }
__device__ __forceinline__ float sigmoidf_(float x) { return __builtin_amdgcn_rcpf(1.0f + __builtin_amdgcn_exp2f(x * -1.4426950408889634f)); }
struct EpiGateA {
    static constexpr bool PERM = true, AFTER_DRAIN = false, HAS_MID = false, I8 = false; static constexpr int MID_T = -1, NST = 0, PID = 0;
    bf16_t* O; int ldc; const bf16_t* gate; int ldg;
    __device__ __forceinline__ void operator()(const f32x4 (&acc)[2][2][4][2], const Unit& u, int wr, int wc, int fr, int fq) const {
        const int row0 = u.pm * BM + wr * 64 + fr, col0 = u.pn * BM + wc * 32 + 8 * fq;
#pragma unroll
        for (int ai = 0; ai < 2; ++ai)
#pragma unroll
            for (int m = 0; m < 4; ++m) { const size_t r = (size_t)(row0 + ai * HALF + m * 16);
#pragma unroll
                for (int bj = 0; bj < 2; ++bj) { const int c = col0 + bj * HALF;
                    const u32x4 gv = *(const PG8_GAS u32x4*)(gate + r * ldg + c);
                    const f32x4 v0 = acc[ai][bj][m][0], v1 = acc[ai][bj][m][1];
                    float o[8];
                    o[0] = v0[0] * sigmoidf_(bfbits2f(gv.x & 0xffffu)); o[1] = v0[1] * sigmoidf_(bfbits2f(gv.x >> 16));
                    o[2] = v0[2] * sigmoidf_(bfbits2f(gv.y & 0xffffu)); o[3] = v0[3] * sigmoidf_(bfbits2f(gv.y >> 16));
                    o[4] = v1[0] * sigmoidf_(bfbits2f(gv.z & 0xffffu)); o[5] = v1[1] * sigmoidf_(bfbits2f(gv.z >> 16));
                    o[6] = v1[2] * sigmoidf_(bfbits2f(gv.w & 0xffffu)); o[7] = v1[3] * sigmoidf_(bfbits2f(gv.w >> 16));
                    u32x4 w; w.x = cvt_pk_bf16(o[0], o[1]); w.y = cvt_pk_bf16(o[2], o[3]); w.z = cvt_pk_bf16(o[4], o[5]); w.w = cvt_pk_bf16(o[6], o[7]);
                    *(PG8_GAS u32x4*)(O + r * ldc + c) = w; }
                if (m == 3) asm volatile("" ::: "memory"); }
    }
};
struct EpiGateR {
    static constexpr bool PERM = true, AFTER_DRAIN = false, HAS_MID = false, I8 = false; static constexpr int MID_T = -1, NST = 0, PID = 0;
    bf16_t* O; int ldc; const bf16_t* gate; int ldg;
    __device__ __forceinline__ void operator()(const f32x4 (&acc)[2][2][4][2], const Unit& u, int wr, int wc, int fr, int fq) const {
        const int row0 = u.pm * BM + wr * 64 + fr, col0 = u.pn * BM + wc * 32 + 8 * fq;
#pragma unroll
        for (int ai = 0; ai < 2; ++ai)
#pragma unroll
            for (int m = 0; m < 4; ++m) { const size_t r = (size_t)(row0 + ai * HALF + m * 16);
#pragma unroll
                for (int bj = 0; bj < 2; ++bj) { const int c = col0 + bj * HALF;
                    const u32x4 gv = *(const PG8_GAS u32x4*)(gate + r * ldg + c);
                    const u32x4 tv = *(const PG8_GAS u32x4*)(O + r * ldc + c);
                    const f32x4 v0 = acc[ai][bj][m][0], v1 = acc[ai][bj][m][1];
                    float o[8];
                    o[0] = bfbits2f(tv.x & 0xffffu) + v0[0] * sigmoidf_(bfbits2f(gv.x & 0xffffu)); o[1] = bfbits2f(tv.x >> 16) + v0[1] * sigmoidf_(bfbits2f(gv.x >> 16));
                    o[2] = bfbits2f(tv.y & 0xffffu) + v0[2] * sigmoidf_(bfbits2f(gv.y & 0xffffu)); o[3] = bfbits2f(tv.y >> 16) + v0[3] * sigmoidf_(bfbits2f(gv.y >> 16));
                    o[4] = bfbits2f(tv.z & 0xffffu) + v1[0] * sigmoidf_(bfbits2f(gv.z & 0xffffu)); o[5] = bfbits2f(tv.z >> 16) + v1[1] * sigmoidf_(bfbits2f(gv.z >> 16));
                    o[6] = bfbits2f(tv.w & 0xffffu) + v1[2] * sigmoidf_(bfbits2f(gv.w & 0xffffu)); o[7] = bfbits2f(tv.w >> 16) + v1[3] * sigmoidf_(bfbits2f(gv.w >> 16));
                    u32x4 w; w.x = cvt_pk_bf16(o[0], o[1]); w.y = cvt_pk_bf16(o[2], o[3]); w.z = cvt_pk_bf16(o[4], o[5]); w.w = cvt_pk_bf16(o[6], o[7]);
                    *(PG8_GAS u32x4*)(O + r * ldc + c) = w; }
                if (m == 3) asm volatile("" ::: "memory"); }
    }
};
struct EpiF32 {
    static constexpr bool PERM = true, AFTER_DRAIN = false, HAS_MID = false, I8 = false; static constexpr int MID_T = -1, NST = 0, PID = 0;
    float* O; int ldc;
    __device__ __forceinline__ void operator()(const f32x4 (&acc)[2][2][4][2], const Unit& u, int wr, int wc, int fr, int fq) const {
        const int row0 = u.pm * BM + wr * 64 + fr, col0 = u.pn * BM + wc * 32 + 8 * fq;
#pragma unroll
        for (int ai = 0; ai < 2; ++ai)
#pragma unroll
            for (int m = 0; m < 4; ++m) { float* rowp = O + (size_t)(row0 + ai * HALF + m * 16) * ldc + col0;
#pragma unroll
                for (int bj = 0; bj < 2; ++bj) { *(PG8_GAS f32x4*)(rowp + bj * HALF) = acc[ai][bj][m][0]; *(PG8_GAS f32x4*)(rowp + bj * HALF + 4) = acc[ai][bj][m][1]; } }
    }
};

__device__ __forceinline__ float dpp_f(float v, int ctrl_sel) {
    const int iv = __builtin_bit_cast(int, v); int r;
    switch (ctrl_sel) { case 0: r = __builtin_amdgcn_update_dpp(0, iv, 0x111, 0xf, 0xf, true); break;
                        case 1: r = __builtin_amdgcn_update_dpp(0, iv, 0x112, 0xf, 0xf, true); break;
                        case 2: r = __builtin_amdgcn_update_dpp(0, iv, 0x10F, 0xf, 0xf, true); break;
                        default: r = __builtin_amdgcn_update_dpp(0, iv, 0x10E, 0xf, 0xf, true); break; }
    return __builtin_bit_cast(float, r);
}
__device__ __forceinline__ float gelu_tanh_f(float x) { const float u2 = 1.5957691216057308f * (x + 0.044715f * x * x * x); return x * __builtin_amdgcn_rcpf(1.0f + __expf(-u2)); }
struct EpiConv {
    static constexpr bool PERM = true, AFTER_DRAIN = false, HAS_MID = false, I8 = PG_I8_UP; static constexpr int MID_T = -1, NST = PG_NST ? 14 : 0  , PID = 1;
    bf16_t* G; bf16_t* H; const float* cw; const float* cb; int dff; const float* stat; float eps; int pmc;
    const float* qs; const unsigned* wsc;
    __device__ __forceinline__ void operator()(const f32x4 (&acc)[2][2][4][2], const Unit& u, int wr, int wc, int fr, int fq) const {
        const int colb = u.pn * HALF + wc * 32 + 8 * fq;
        float ts0 = 1.0f, ts1 = 1.0f;
        if constexpr (I8) { ts0 = __uint_as_float(((const PG8_GAS unsigned*)wsc)[u.pn * 8 + wc]) * (1.0f / 127.0f); ts1 = __uint_as_float(((const PG8_GAS unsigned*)wsc)[u.pn * 8 + 4 + wc]) * (1.0f / 127.0f); }
        f32x2 w02[4], w12[4], w22[4], wb2[4];
#pragma unroll
        for (int h = 0; h < 2; ++h) { const f32x4 a = *(const PG8_GAS f32x4*)(cw + colb + 4 * h), b = *(const PG8_GAS f32x4*)(cw + dff + colb + 4 * h), c = *(const PG8_GAS f32x4*)(cw + 2 * dff + colb + 4 * h), d = *(const PG8_GAS f32x4*)(cb + colb + 4 * h);
            w02[2 * h] = (f32x2){a[0], a[1]}; w02[2 * h + 1] = (f32x2){a[2], a[3]}; w12[2 * h] = (f32x2){b[0], b[1]}; w12[2 * h + 1] = (f32x2){b[2], b[3]};
            w22[2 * h] = (f32x2){c[0], c[1]}; w22[2 * h + 1] = (f32x2){c[2], c[3]}; wb2[2 * h] = (f32x2){d[0], d[1]}; wb2[2 * h + 1] = (f32x2){d[2], d[3]}; }
#pragma unroll
        for (int ai = 0; ai < 2; ++ai) {
            const int row64 = u.pm * BM + ai * HALF + wr * 64, grp = row64 >> 6;
            float rsc[4];
            {
                const int tb_ = (u.pm == pmc) ? 0 : 256;
#pragma unroll
                for (int m = 0; m < 4; ++m) rsc[m] = rs_lds()[tb_ + ((row64 + m * 16 + fr) & 255)];
            }
            float rsv[4];
#pragma unroll
            for (int m = 0; m < 4; ++m) { rsv[m] = rsc[m] * ts1; rsc[m] *= ts0; }
            if (fr >= 14) { const f32x4 v0 = acc[ai][0][3][0] * rsc[3], v1 = acc[ai][0][3][1] * rsc[3]; u32x4 w; w.x = cvt_pk_bf16(v0[0], v0[1]); w.y = cvt_pk_bf16(v0[2], v0[3]); w.z = cvt_pk_bf16(v1[0], v1[1]); w.w = cvt_pk_bf16(v1[2], v1[3]);
                *(PG8_GAS u32x4*)(H + (size_t)(grp * 6 + (fr - 14)) * dff + colb) = w; }
            if (fr < 2) { const f32x4 v0 = acc[ai][0][0][0] * rsc[0], v1 = acc[ai][0][0][1] * rsc[0], x0 = acc[ai][1][0][0] * rsv[0], x1 = acc[ai][1][0][1] * rsv[0]; u32x4 w, x;
                w.x = cvt_pk_bf16(v0[0], v0[1]); w.y = cvt_pk_bf16(v0[2], v0[3]); w.z = cvt_pk_bf16(v1[0], v1[1]); w.w = cvt_pk_bf16(v1[2], v1[3]);
                x.x = cvt_pk_bf16(x0[0], x0[1]); x.y = cvt_pk_bf16(x0[2], x0[3]); x.z = cvt_pk_bf16(x1[0], x1[1]); x.w = cvt_pk_bf16(x1[2], x1[3]);
                *(PG8_GAS u32x4*)(H + (size_t)(grp * 6 + 2 + fr) * dff + colb) = w; *(PG8_GAS u32x4*)(H + (size_t)(grp * 6 + 4 + fr) * dff + colb) = x; }
            f32x2 ap[4];
#pragma unroll
            for (int pr = 0; pr < 4; ++pr) ap[pr] = (f32x2){0.f, 0.f};
#pragma unroll
            for (int m = 0; m < 4; ++m) {
                f32x2 o2[4];
#pragma unroll
                for (int pr = 0; pr < 4; ++pr) { const int n = pr >> 1, i = (pr & 1) * 2;
                    const f32x2 a2 = (f32x2){acc[ai][0][m][n][i], acc[ai][0][m][n][i + 1]} * rsc[m];
                    const f32x2 v2 = (f32x2){acc[ai][1][m][n][i], acc[ai][1][m][n][i + 1]} * rsv[m];
                    f32x2 p1 = (f32x2){dpp_f(a2.x, 0), dpp_f(a2.y, 0)}, p2 = (f32x2){dpp_f(a2.x, 1), dpp_f(a2.y, 1)};
                    if (m > 0) { p1 += (f32x2){dpp_f(ap[pr].x, 2), dpp_f(ap[pr].y, 2)}; p2 += (f32x2){dpp_f(ap[pr].x, 3), dpp_f(ap[pr].y, 3)}; }
                    ap[pr] = a2;
                    const f32x2 ac = wb2[pr] + w02[pr] * p2 + w12[pr] * p1 + w22[pr] * a2;
                    const f32x2 u2 = (ac + (ac * ac) * ac * 0.044715f) * (-1.5957691216057308f * 1.4426950408889634f);
                    f32x2 e; e.x = __builtin_amdgcn_exp2f(u2.x); e.y = __builtin_amdgcn_exp2f(u2.y);
                    const f32x2 d = e + 1.0f; f32x2 r; r.x = __builtin_amdgcn_rcpf(d.x); r.y = __builtin_amdgcn_rcpf(d.y);
                    o2[pr] = (ac * r) * v2; }
                u32x4 w; w.x = cvt_pk_bf16(o2[0].x, o2[0].y); w.y = cvt_pk_bf16(o2[1].x, o2[1].y); w.z = cvt_pk_bf16(o2[2].x, o2[2].y); w.w = cvt_pk_bf16(o2[3].x, o2[3].y);
                *(PG8_GAS u32x4*)(G + (size_t)(row64 + m * 16 + fr) * dff + colb) = w;
            }
        }
    }
};

struct PanelRms {
    unsigned* xbuf;
    unsigned* cnt;
    unsigned* tmo;
    float eps; unsigned code;
    const float* amx_in;
    float* qs_out;
    template <bool quant> __device__ __forceinline__ bool run(const f32x4 (&v)[2][2][4][2], const f32x4 (&gv)[2][2], const Unit& u, int wr, int wc, int fr, int fq, PG8_LAS unsigned char* lds, int wid, int lane, u32x4 (&pre)[2][4][2], const bf16_t* xb, int ldc, int col0) const {
        PG8_LAS float* P = (PG8_LAS float*)lds;
        PG8_LAS float* PX = (PG8_LAS float*)(lds + 4096);
        PG8_LAS float* S = (PG8_LAS float*)(lds + 8192);
        PG8_LAS float* S2 = (PG8_LAS float*)(lds + 9216);
        PG8_LAS unsigned* flag = (PG8_LAS unsigned*)(lds + 8192 + 2048);
        const int row = wid * 32 + (lane & 31);
        f32x4 ao = (f32x4){0.f, 0.f, 0.f, 0.f};
        if (quant && lane < 32) ao = *(const PG8_GAS f32x4*)(amx_in + (size_t)(u.pm * BM + row) * 4);
#pragma unroll
        for (int ai = 0; ai < 2; ++ai)
#pragma unroll
            for (int m = 0; m < 4; ++m) {
                float s = 0.f, mx = 0.f;
#pragma unroll
                for (int bj = 0; bj < 2; ++bj)
#pragma unroll
                    for (int n = 0; n < 2; ++n) { const f32x4 x = v[ai][bj][m][n]; s += (x[0] * x[0] + x[1] * x[1]) + (x[2] * x[2] + x[3] * x[3]);
                        if (quant) { const f32x4 y = x * gv[bj][n]; mx = fmaxf(mx, fmaxf(fmaxf(fabsf(y[0]), fabsf(y[1])), fmaxf(fabsf(y[2]), fabsf(y[3])))); } }
                s += __shfl_xor(s, 16); s += __shfl_xor(s, 32);
                if (quant) { mx = fmaxf(mx, __shfl_xor(mx, 16)); mx = fmaxf(mx, __shfl_xor(mx, 32)); }
                if (fq == 0) { P[(ai * HALF + wr * 64 + m * 16 + fr) * 4 + wc] = s; if (quant) PX[(ai * HALF + wr * 64 + m * 16 + fr) * 4 + wc] = mx; }
            }
        asm volatile("s_waitcnt lgkmcnt(0)" ::: "memory"); __builtin_amdgcn_s_barrier(); asm volatile("" ::: "memory");
        if (lane < 32) {
            const float t = (P[row * 4 + 0] + P[row * 4 + 1]) + (P[row * 4 + 2] + P[row * 4 + 3]);
            const float tm = quant ? fmaxf(fmaxf(PX[row * 4 + 0], PX[row * 4 + 1]), fmaxf(PX[row * 4 + 2], PX[row * 4 + 3])) : 0.f;
            __hip_atomic_store((PG8_GAS unsigned long long*)(xbuf + ((size_t)(u.pm * BM + row) * 4 + u.pn) * 2), ((unsigned long long)__float_as_uint(tm) << 32) | (unsigned long long)__float_as_uint(t), __ATOMIC_RELAXED, __HIP_MEMORY_SCOPE_AGENT);
        }
        asm volatile("" ::: "memory");
#pragma unroll
        for (int ai = 0; ai < 2; ++ai)
#pragma unroll
            for (int m = 0; m < 4; ++m) { const size_t off = (size_t)(u.pm * BM + ai * HALF + wr * 64 + m * 16 + fr) * ldc + col0;
#pragma unroll
                for (int bj = 0; bj < 2; ++bj) pre[ai][m][bj] = *(const PG8_GAS u32x4*)(xb + off + bj * 32); }
        asm volatile("s_waitcnt vmcnt(14)" ::: "memory");
        if (lane == 0) __hip_atomic_fetch_add((PG8_GAS unsigned*)cnt + 64 * u.pm, 1u, __ATOMIC_RELAXED, __HIP_MEMORY_SCOPE_AGENT);
        if (wid == 0) {
            bool dead = false; const unsigned want = 8u * 4u;
            for (unsigned spins = 0;; ++spins) {
                if ((unsigned)__builtin_amdgcn_readfirstlane(__hip_atomic_load((const PG8_GAS unsigned*)cnt + 64 * u.pm, __ATOMIC_RELAXED, __HIP_MEMORY_SCOPE_AGENT)) >= want) break;
                if (spins > (1u << 20)) {
                    if (lane == 0) { unsigned expect = 0u; __hip_atomic_compare_exchange_strong(tmo + 1, &expect, code | (unsigned)(u.pm & 0xff), __ATOMIC_RELAXED, __ATOMIC_RELAXED, __HIP_MEMORY_SCOPE_AGENT);
                                     __hip_atomic_store(tmo, 1u, __ATOMIC_RELAXED, __HIP_MEMORY_SCOPE_AGENT); }
                    dead = true; break; }
                __builtin_amdgcn_s_sleep(2);
            }
            __builtin_amdgcn_fence(__ATOMIC_ACQUIRE, "agent");
            if (lane == 0) flag[0] = dead ? 1u : 0u;
        }
        asm volatile("s_waitcnt vmcnt(0) lgkmcnt(0)" ::: "memory"); __builtin_amdgcn_s_barrier(); asm volatile("" ::: "memory");
        const bool bad = flag[0] != 0u;
        if (lane < 32) {
            const PG8_GAS unsigned long long* slot = (const PG8_GAS unsigned long long*)(xbuf + (size_t)(u.pm * BM + row) * 8); float q = 0.f; f32x4 bm;
#pragma unroll
            for (int t = 0; t < 4; ++t) { const unsigned long long w = __hip_atomic_load(slot + t, __ATOMIC_RELAXED, __HIP_MEMORY_SCOPE_AGENT); q += __uint_as_float((unsigned)w); bm[t] = __uint_as_float((unsigned)(w >> 32)); }
            const float rinv = __builtin_amdgcn_rsqf(q * (1.0f / 1024.0f) + eps);
            S[row] = rinv;
            if (quant) { const f32x4 bt = ao + bm * rinv;
                const float B = fmaxf(fmaxf(bt[0], bt[1]), fmaxf(bt[2], bt[3])) * 1.004f + 1e-20f;
                S2[row] = 127.0f * __builtin_amdgcn_rcpf(B); if (u.pn == 0) ((PG8_GAS float*)qs_out)[u.pm * BM + row] = B * (1.0f / 127.0f); }
        }
        asm volatile("s_waitcnt lgkmcnt(0)" ::: "memory"); __builtin_amdgcn_s_barrier(); asm volatile("" ::: "memory");
        return bad;
    }
};
__device__ __forceinline__ unsigned pack_i8x4(const f32x4 q) {
    return __builtin_amdgcn_perm(__float_as_uint(q[1]), __float_as_uint(q[0]), 0x0c0c0400u) | __builtin_amdgcn_perm(__float_as_uint(q[3]), __float_as_uint(q[2]), 0x04000c0cu);
}
__device__ __forceinline__ float amax4(const f32x4 a) { return fmaxf(fmaxf(fabsf(a[0]), fabsf(a[1])), fmaxf(fabsf(a[2]), fabsf(a[3]))); }
template <bool QUANT  > struct EpiRmsRes {
    static constexpr bool PERM = true, AFTER_DRAIN = true, HAS_MID = false, I8 = false; static constexpr int MID_T = -1, NST = 0, PID = 0;
    bf16_t* xb; float* outf; int ldc; const float* g1; float* stat; signed char* xq; float* amx; PanelRms st;
    __device__ __forceinline__ void fused(f32x4 (&acc)[2][2][4][2], const Unit& u, int wr, int wc, int fr, int fq, PG8_LAS unsigned char* lds, int wid, int lane) const {
        const PG8_LAS float* S = (const PG8_LAS float*)(lds + 8192);
        const PG8_LAS float* S2 = (const PG8_LAS float*)(lds + 9216);
        PG8_LAS float* P = (PG8_LAS float*)lds;
        PG8_LAS float* PX = (PG8_LAS float*)(lds + 4096);
        const int col0 = u.pn * BM + wc * 64 + 8 * fq, odd = fr & 1;
        u32x4 pre[2][4][2];
        f32x4 gv[2][2];
#pragma unroll
        for (int bj = 0; bj < 2; ++bj)
#pragma unroll
            for (int n = 0; n < 2; ++n) gv[bj][n] = *(const PG8_GAS f32x4*)(g1 + col0 + bj * 32 + 4 * n);
        (void)st.template run<QUANT>(acc, gv, u, wr, wc, fr, fq, lds, wid, lane, pre, xb, ldc, col0);
#pragma unroll
        for (int ai = 0; ai < 2; ++ai)
#pragma unroll
            for (int m = 0; m < 4; ++m) { const int r = ai * HALF + wr * 64 + m * 16 + fr; const float sr = S[r]; const size_t off = (size_t)(u.pm * BM + r) * ldc + col0;
                const float s2r = QUANT ? S2[r] : 0.f;
                float ps = 0.f, pmx = 0.f; u32x4 w[2];
#pragma unroll
                for (int bj = 0; bj < 2; ++bj) { const u32x4 pb = pre[ai][m][bj];
                    const f32x4 b0 = (f32x4){bfbits2f(pb.x & 0xffffu), bfbits2f(pb.x >> 16), bfbits2f(pb.y & 0xffffu), bfbits2f(pb.y >> 16)};
                    const f32x4 b1 = (f32x4){bfbits2f(pb.z & 0xffffu), bfbits2f(pb.z >> 16), bfbits2f(pb.w & 0xffffu), bfbits2f(pb.w >> 16)};
                    const f32x4 o0 = b0 + acc[ai][bj][m][0] * sr * gv[bj][0], o1 = b1 + acc[ai][bj][m][1] * sr * gv[bj][1];
                    if (outf) { *(PG8_GAS f32x4*)(outf + off + bj * 32) = o0; *(PG8_GAS f32x4*)(outf + off + bj * 32 + 4) = o1; }
                    else { w[bj].x = cvt_pk_bf16(o0[0], o0[1]); w[bj].y = cvt_pk_bf16(o0[2], o0[3]); w[bj].z = cvt_pk_bf16(o1[0], o1[1]); w[bj].w = cvt_pk_bf16(o1[2], o1[3]);
                        ps += ((o0[0] * o0[0] + o0[1] * o0[1]) + (o0[2] * o0[2] + o0[3] * o0[3])) + ((o1[0] * o1[0] + o1[1] * o1[1]) + (o1[2] * o1[2] + o1[3] * o1[3]));
                        pmx = fmaxf(pmx, fmaxf(amax4(o0), amax4(o1)));
                        if constexpr (QUANT) { u32x2 qw; qw.x = pack_i8x4(o0 * s2r + 12582912.0f); qw.y = pack_i8x4(o1 * s2r + 12582912.0f);
                            *(PG8_GAS u32x2*)(xq + off + bj * 32) = qw; } } }
                if (!outf) { u32x4 dA, dB; pair_swap(w[0], w[1], odd, dA, dB);
                    bf16_t* pA = xb + (size_t)(u.pm * BM + r - odd) * ldc + col0 + 32 * odd; *(PG8_GAS u32x4*)pA = dA; *(PG8_GAS u32x4*)(pA + ldc) = dB; }
                if (!outf) { ps += __shfl_xor(ps, 16); ps += __shfl_xor(ps, 32); pmx = fmaxf(pmx, __shfl_xor(pmx, 16)); pmx = fmaxf(pmx, __shfl_xor(pmx, 32)); if (fq == 0) { P[r * 4 + wc] = ps; PX[r * 4 + wc] = pmx; } } }
        if (!outf) {
            asm volatile("s_waitcnt lgkmcnt(0)" ::: "memory"); __builtin_amdgcn_s_barrier(); asm volatile("" ::: "memory");
            const int row = wid * 32 + (lane & 31);
            if (lane < 32) { ((PG8_GAS float*)stat)[(size_t)(u.pm * BM + row) * 4 + u.pn] = (P[row * 4 + 0] + P[row * 4 + 1]) + (P[row * 4 + 2] + P[row * 4 + 3]);
                ((PG8_GAS float*)amx)[(size_t)(u.pm * BM + row) * 4 + u.pn] = fmaxf(fmaxf(PX[row * 4 + 0], PX[row * 4 + 1]), fmaxf(PX[row * 4 + 2], PX[row * 4 + 3])); }
        }
    }
};
template <bool I8E, int THR, int OFF_HI, int TB> struct EpiBf16Rs {
    static constexpr bool PERM = true, AFTER_DRAIN = false, HAS_MID = false, I8 = I8E; static constexpr int MID_T = -1, NST = PG_NST, PID = I8E ? 2 : 3;
    bf16_t* O; int ldc; const float* costab; const float* sintab; const unsigned* wsc;
    __device__ __forceinline__ void operator()(const f32x4 (&acc)[2][2][4][2], const Unit& u, int wr, int wc, int fr, int fq) const {
        const int pn = u.pn + (u.pn >= THR ? OFF_HI : 0);
        const int row0 = u.pm * BM + wr * 64 + fr, col0 = pn * BM + wc * 32 + 8 * fq;
        float ts[2] = {1.0f, 1.0f};
        if constexpr (I8) { ts[0] = __uint_as_float(((const PG8_GAS unsigned*)wsc)[u.pn * 8 + wc]) * (1.0f / 127.0f); ts[1] = __uint_as_float(((const PG8_GAS unsigned*)wsc)[u.pn * 8 + 4 + wc]) * (1.0f / 127.0f); }
        const bool rot = !I8E && (pn >= 3) && (pn <= 6);
        float sc[2][4];
        {
#pragma unroll
            for (int ai = 0; ai < 2; ++ai)
#pragma unroll
                for (int m = 0; m < 4; ++m) sc[ai][m] = rs_lds()[TB + ((row0 + ai * HALF + m * 16) & 255)];
        }
        if (!rot) {
            const int odd = fr & 1; const int colL = pn * BM + wc * 64 + 32 * odd + 8 * fq;
#pragma unroll
            for (int ai = 0; ai < 2; ++ai)
#pragma unroll
                for (int m = 0; m < 4; ++m) { const int rr = row0 + ai * HALF + m * 16;
                    u32x4 w[2];
#pragma unroll
                    for (int bj = 0; bj < 2; ++bj) { const float sb = sc[ai][m] * ts[bj]; const f32x4 v0 = acc[ai][bj][m][0] * sb, v1 = acc[ai][bj][m][1] * sb;
                        w[bj].x = cvt_pk_bf16(v0[0], v0[1]); w[bj].y = cvt_pk_bf16(v0[2], v0[3]); w[bj].z = cvt_pk_bf16(v1[0], v1[1]); w[bj].w = cvt_pk_bf16(v1[2], v1[3]); }
                    const u32x4 snd = odd ? w[0] : w[1];
                    u32x4 rcv;
                    rcv.x = (unsigned)__builtin_amdgcn_update_dpp(0, (int)snd.x, 0xB1, 0xf, 0xf, false); rcv.y = (unsigned)__builtin_amdgcn_update_dpp(0, (int)snd.y, 0xB1, 0xf, 0xf, false);
                    rcv.z = (unsigned)__builtin_amdgcn_update_dpp(0, (int)snd.z, 0xB1, 0xf, 0xf, false); rcv.w = (unsigned)__builtin_amdgcn_update_dpp(0, (int)snd.w, 0xB1, 0xf, 0xf, false);
                    const u32x4 dA = odd ? rcv : w[0], dB = odd ? w[1] : rcv;
                    bf16_t* pA = O + (size_t)(rr - odd) * ldc + colL; bf16_t* pB = O + (size_t)(rr - odd + 1) * ldc + colL;
                    ST16(pA, dA); ST16(pB, dB); }
        } else {
            const bool isk = pn >= 5; const int hb = 2 * ((pn - 3) & 1);
            float lgs[2];
#pragma unroll
            for (int bj = 0; bj < 2; ++bj) { const float lg2 = LOG2_GAMMA_OF(hb + bj); lgs[bj] = isk ? -lg2 : lg2; }
            const float kmul = isk ? 0.08838834764831845f : 1.0f;
#pragma unroll
            for (int ai = 0; ai < 2; ++ai)
#pragma unroll
                for (int m = 0; m < 4; ++m) { const int ri = row0 + ai * HALF + m * 16; bf16_t* rowp = O + (size_t)ri * ldc + col0;
                    const int toff = (ri & 4095) * 64 + 4 * (4 * wc + fq); const f32x4 cs = *(const PG8_GAS f32x4*)(costab + toff), sn = *(const PG8_GAS f32x4*)(sintab + toff);
                    const float cpos = (float)(ri & 127);
#pragma unroll
                    for (int bj = 0; bj < 2; ++bj) { const float scl = sc[ai][m] * (kmul * ts[bj]) * __builtin_amdgcn_exp2f(lgs[bj] * cpos);
                        const f32x4 x1 = acc[ai][bj][m][0], x2 = acc[ai][bj][m][1];
                        const f32x4 v0 = (x1 * cs - x2 * sn) * scl, v1 = (x1 * sn + x2 * cs) * scl;
                        u32x4 w; w.x = cvt_pk_bf16(v0[0], v0[1]); w.y = cvt_pk_bf16(v0[2], v0[3]); w.z = cvt_pk_bf16(v1[0], v1[1]); w.w = cvt_pk_bf16(v1[2], v1[3]);
                        ST16(rowp + bj * HALF, w); } }
        }
    }
};
struct EpiNull {
    static constexpr bool PERM = true, AFTER_DRAIN = false, HAS_MID = false, I8 = false; static constexpr int MID_T = -1, NST = 0, PID = 0;
    float* sink;
    __device__ __forceinline__ void operator()(const f32x4 (&acc)[2][2][4][2], const Unit& u, int wr, int wc, int fr, int fq) const {
        f32x4 t = acc[0][0][0][0];
#pragma unroll
        for (int ai = 0; ai < 2; ++ai)
#pragma unroll
            for (int bj = 0; bj < 2; ++bj)
#pragma unroll
                for (int m = 0; m < 4; ++m)
#pragma unroll
                    for (int n = 0; n < 2; ++n) t += acc[ai][bj][m][n];
        if (t[0] + t[1] + t[2] + t[3] == 123456.789f) sink[0] = t[0];
    }
};

struct EpiGate2 {
    static constexpr bool PERM = true, AFTER_DRAIN = false, HAS_MID = true, I8 = false; static constexpr int MID_T = 6, NST = 0, PID = 0;
    bf16_t* O; int ldc; const bf16_t* ga; const bf16_t* gr; int ldg;
    static __device__ __forceinline__ f32x2 expneg2(unsigned w) { const f32x2 x = (f32x2){bfbits2f(w & 0xffffu), __uint_as_float(w & 0xffff0000u)} * -1.4426950408889634f; f32x2 e; e.x = __builtin_amdgcn_exp2f(x.x); e.y = __builtin_amdgcn_exp2f(x.y); return e; }
    static __device__ __forceinline__ f32x2 rcp2(f32x2 d) { f32x2 r; r.x = __builtin_amdgcn_rcpf(d.x); r.y = __builtin_amdgcn_rcpf(d.y); return r; }
    __device__ __forceinline__ void mid(f32x4 (&acc)[2][2][4][2], const Unit& u, int wr, int wc, int fr, int fq) const {
        int fro = fr; asm volatile("" : "+v"(fro));
        const int row0 = u.pm * BM + wr * 64 + fro, col0 = u.pn * BM + wc * 64 + 8 * fq;
#pragma unroll
        for (int ai = 0; ai < 2; ++ai)
#pragma unroll
            for (int m = 0; m < 4; ++m) { const size_t r = (size_t)(row0 + ai * HALF + m * 16);
#pragma unroll
                for (int bj = 0; bj < 2; ++bj) { const int c = col0 + bj * 32;
                    const u32x4 a = *(const PG8_GAS u32x4*)(ga + r * ldg + c), g = *(const PG8_GAS u32x4*)(gr + r * ldg + c);
                    const unsigned aw[4] = {a.x, a.y, a.z, a.w}, gw_[4] = {g.x, g.y, g.z, g.w};
                    f32x2 rho[4];
#pragma unroll
                    for (int k = 0; k < 4; ++k) rho[k] = (expneg2(gw_[k]) + 1.0f) * rcp2(expneg2(aw[k]) + 1.0f);
                    acc[ai][bj][m][0] = acc[ai][bj][m][0] * (f32x4){rho[0].x, rho[0].y, rho[1].x, rho[1].y};
                    acc[ai][bj][m][1] = acc[ai][bj][m][1] * (f32x4){rho[2].x, rho[2].y, rho[3].x, rho[3].y}; }
                if (m & 1) asm volatile("" ::: "memory"); }
    }
    __device__ __forceinline__ void operator()(const f32x4 (&acc)[2][2][4][2], const Unit& u, int wr, int wc, int fr, int fq) const {
        const int row0 = u.pm * BM + wr * 64 + fr, col0 = u.pn * BM + wc * 64 + 8 * fq, odd = fr & 1;
#pragma unroll
        for (int ai = 0; ai < 2; ++ai)
#pragma unroll
            for (int m = 0; m < 4; ++m) { const size_t r = (size_t)(row0 + ai * HALF + m * 16);
                u32x4 w[2];
#pragma unroll
                for (int bj = 0; bj < 2; ++bj) { const int c = col0 + bj * 32;
                    const u32x4 gv = *(const PG8_GAS u32x4*)(gr + r * ldg + c);
                    const f32x4 v0 = acc[ai][bj][m][0], v1 = acc[ai][bj][m][1];
                    const f32x2 s0 = rcp2(expneg2(gv.x) + 1.0f), s1 = rcp2(expneg2(gv.y) + 1.0f), s2 = rcp2(expneg2(gv.z) + 1.0f), s3 = rcp2(expneg2(gv.w) + 1.0f);
                    const f32x2 o0 = (f32x2){v0[0], v0[1]} * s0, o1 = (f32x2){v0[2], v0[3]} * s1, o2 = (f32x2){v1[0], v1[1]} * s2, o3 = (f32x2){v1[2], v1[3]} * s3;
                    w[bj].x = cvt_pk_bf16(o0.x, o0.y); w[bj].y = cvt_pk_bf16(o1.x, o1.y); w[bj].z = cvt_pk_bf16(o2.x, o2.y); w[bj].w = cvt_pk_bf16(o3.x, o3.y); }
                u32x4 dA, dB; pair_swap(w[0], w[1], odd, dA, dB);
                bf16_t* pA = O + (r - odd) * ldc + col0 + 32 * odd;
                *(PG8_GAS u32x4*)pA = dA; *(PG8_GAS u32x4*)(pA + ldc) = dB;
                if (m == 3) asm volatile("" ::: "memory"); }
    }
};
}

constexpr int NWAVES = 8;
constexpr int D = 1024, BATCH = 8, SEQ = 4096, DEPTH = 4;
constexpr int M = BATCH * SEQ, MH = M / 2;
constexpr int DIN = 5888, DFF = 2816, NUP = 2 * DFF;
constexpr int C_QA = 0, C_KA = 512, C_VA = 640, C_QR = 768, C_KR = 1280, C_VR = 1792, C_GR = 2816, C_GA = 3840, C_GT = 4864;
constexpr float EPS = 1e-6f;
#ifndef MK_ONE_LAUNCH
#define MK_ONE_LAUNCH 0
#endif
constexpr int PH_PER = 15;
constexpr int N_PHASES = 1 + DEPTH * PH_PER;

constexpr size_t MiB = 1u << 20;
constexpr size_t WS_CTL = 0, CTL_ZERO_BYTES = 1 * MiB;
constexpr size_t WS_BIAS = 1 * MiB;
constexpr size_t WS_AMX = 5 * MiB;
constexpr size_t WS_COS = 2 * MiB, WS_SIN = 3 * MiB;
constexpr size_t WS_STAT = 4 * MiB;
constexpr size_t WS_W = 6 * MiB;
constexpr size_t W_IN = 0, W_OA = W_IN + (size_t)DIN * D, W_OR = W_OA + (size_t)D * 512, W_O = W_OR + (size_t)D * D, W_UP = W_O + (size_t)D * D, W_DN = W_UP + (size_t)NUP * D, W_LAYER = W_DN + (size_t)D * DFF;
static_assert(W_LAYER * 2 == 33 * MiB, "weights per layer");
constexpr size_t W_IN8 = W_UP + (size_t)NUP * D / 2;
constexpr size_t WS_RA = WS_W + 4 * 33 * MiB;
constexpr size_t WS_RB = WS_RA + 184 * MiB;
constexpr size_t WS_XN = WS_RB;
constexpr size_t WS_XN1 = WS_XN + 32 * MiB;
constexpr size_t WS_AOA = WS_XN1 + 32 * MiB;
constexpr size_t WS_AOR = WS_AOA + 16 * MiB;
constexpr size_t WS_KV = WS_AOA + 48 * MiB;
constexpr size_t WS_MG = WS_KV;
constexpr size_t WS_G = WS_RA;
constexpr size_t WS_H = WS_AOA;
constexpr size_t WS_XQ = WS_KV + 32 * MiB;
constexpr size_t WS_XSLOT = WS_XQ + 32 * MiB;
constexpr size_t WS_QS = WS_XSLOT + 1 * MiB;
constexpr size_t WS_END = WS_QS + 1 * MiB;
static_assert((size_t)MH * DIN * 2 == 184 * MiB && (size_t)M * DFF * 2 <= 184 * MiB && (size_t)(M / 64) * 6 * DFF * 2 <= 48 * MiB && WS_END <= 512 * MiB, "ws map");
constexpr int CW_WAMAX = 131072;
constexpr int CW_BAR = 4096, CW_SEAM = 16384;

constexpr int RING_BYTES = 131072;
constexpr int LDS_BYTES = 147456;
constexpr int MISC_OFF = 143360;

#define GAS __attribute__((address_space(1)))
#define LAS __attribute__((address_space(3)))
typedef unsigned short bf16;
typedef unsigned v4u __attribute__((ext_vector_type(4)));
typedef float f32x4 __attribute__((ext_vector_type(4)));
typedef short bf16x8 __attribute__((ext_vector_type(8)));
typedef GAS unsigned gu32;
typedef GAS unsigned long long gu64;
#define RLX_AGENT __ATOMIC_RELAXED, __HIP_MEMORY_SCOPE_AGENT
#define LDS_WAIT() asm volatile("s_waitcnt lgkmcnt(0)" ::: "memory")
#define VM_WAIT() asm volatile("s_waitcnt vmcnt(0)" ::: "memory")
__device__ __forceinline__ unsigned long long rt() { return __builtin_amdgcn_s_memrealtime(); }
__device__ __forceinline__ unsigned f2bf(float f) { unsigned u = __builtin_bit_cast(unsigned, f); return (u + 0x7fffu + ((u >> 16) & 1u)) >> 16; }
typedef float pk2_f32x2_t __attribute__((ext_vector_type(2))); typedef __bf16 pk2_bf16x2_t __attribute__((ext_vector_type(2)));
__device__ __forceinline__ unsigned pk2(float lo, float hi) { const pk2_f32x2_t v = {lo, hi}; return __builtin_bit_cast(unsigned, __builtin_convertvector(v, pk2_bf16x2_t)); }

#define XB_TMO      128
#define XB_XCNT(j)  (256  + 64 * (j))
#define XB_XSUB(j)  (1280 + 64 * (j))
#define XB_XGEN(j)  (2304 + 64 * (j))
#define XB_TOP      3328
#define XB_TOPGEN   3392
#define XCD_BAR_WORDS 3456
#define XB_SPIN_CAP (1u << 18)

__device__ __forceinline__ unsigned xb_ld(unsigned* p)              { return __hip_atomic_load(p, __ATOMIC_RELAXED, __HIP_MEMORY_SCOPE_AGENT); }
__device__ __forceinline__ unsigned xb_add(unsigned* p, unsigned v) { return __hip_atomic_fetch_add(p, v, __ATOMIC_RELAXED, __HIP_MEMORY_SCOPE_AGENT); }
__device__ __forceinline__ unsigned xb_xcc_id() { return (unsigned)__builtin_amdgcn_s_getreg((3 << 11) | 20) & 0xFu; }
#define XB_SPIN(cond, bar) do { unsigned _sp = 0; while (cond) { __builtin_amdgcn_s_sleep(1); \
    if ((++_sp & 255u) == 0u) { if (xb_ld(&(bar)[XB_TMO])) break; if (_sp > XB_SPIN_CAP) { atomicAdd(&(bar)[XB_TMO], 1u); break; } } } } while (0)

struct XcdBarrier {
    unsigned* bar; unsigned x;
    volatile LAS unsigned* st;
};

__device__ __forceinline__ XcdBarrier xcd_barrier_post(unsigned* bar, volatile LAS unsigned* st) {
    XcdBarrier b; b.bar = bar; b.x = xb_xcc_id(); b.st = st;
    if (threadIdx.x == 0) (void)xb_add(&bar[XB_XCNT(b.x)], 1u);
    return b;
}
__device__ __forceinline__ void xcd_barrier_complete(unsigned* bar, unsigned x, unsigned& nloc, unsigned& nx) {
    const unsigned G = gridDim.x * gridDim.y * gridDim.z;
    unsigned sum, cnt, mine, sp = 0u;
    for (;;) {
        sum = 0u; cnt = 0u; mine = 0u;
#pragma unroll
        for (unsigned j = 0; j < 16; ++j) { const unsigned c = xb_ld(&bar[XB_XCNT(j)]); sum += c; cnt += (c > 0u) ? 1u : 0u; mine = (j == x) ? c : mine; }
        if (sum == G) break;
        __builtin_amdgcn_s_sleep(1);
        if ((++sp & 255u) == 0u) { if (xb_ld(&bar[XB_TMO])) break; if (sp > XB_SPIN_CAP) { atomicAdd(&bar[XB_TMO], 1u); break; } }
    }
    nloc = mine > 0u ? mine : 1u; nx = cnt > 0u ? cnt : 1u;
}

__device__ __forceinline__ void xcd_barrier(const XcdBarrier& b) {
    asm volatile("s_waitcnt vmcnt(0)" ::: "memory");
    __syncthreads();
    int tid0_ = threadIdx.x; asm volatile("" : "+v"(tid0_));
    if (tid0_ == 0) {
        unsigned* bar = b.bar;
        __builtin_amdgcn_s_waitcnt(0);
        unsigned nloc = b.st[0], nx = b.st[1];
        if (nloc == 0u) { xcd_barrier_complete(bar, b.x, nloc, nx); b.st[0] = nloc; b.st[1] = nx; }
        const unsigned old = xb_add(&bar[XB_XSUB(b.x)], 1u);
        const unsigned gen = old / nloc;
        if (old + 1u == (gen + 1u) * nloc) {
            __builtin_amdgcn_fence(__ATOMIC_RELEASE, "agent");
            asm volatile("s_waitcnt vmcnt(0)" ::: "memory");
            const unsigned og = xb_add(&bar[XB_TOP], 1u);
            const unsigned tg = og / nx;
            if (og + 1u == (tg + 1u) * nx) xb_add(&bar[XB_TOPGEN], 1u);
            else XB_SPIN(xb_ld(&bar[XB_TOPGEN]) == tg, bar);
            __builtin_amdgcn_fence(__ATOMIC_ACQUIRE, "agent");
            xb_add(&bar[XB_XGEN(b.x)], 1u);
            asm volatile("s_waitcnt vmcnt(0)" ::: "memory");
        } else {
            XB_SPIN(xb_ld(&bar[XB_XGEN(b.x)]) == gen, bar);
            __builtin_amdgcn_fence(__ATOMIC_ACQUIRE, "agent");
            asm volatile("s_waitcnt vmcnt(0)" ::: "memory");
        }
    }
    __syncthreads();
}
typedef unsigned u32x2 __attribute__((ext_vector_type(2)));
typedef unsigned short u16;
#define MFMA16(a, b, c) __builtin_amdgcn_mfma_f32_16x16x32_bf16((a), (b), (c), 0, 0, 0)
__device__ __forceinline__ float bf2f(unsigned b) { return __uint_as_float(b << 16); }
__device__ __forceinline__ float wave_sum(float v) {
#pragma unroll
    for (int o = 1; o < 64; o <<= 1) v += __shfl_xor(v, o);
    return v;
}
__device__ __forceinline__ float sigm(float x) { return __builtin_amdgcn_rcpf(1.0f + __builtin_amdgcn_exp2f(x * -1.4426950408889634f)); }
__device__ __forceinline__ float tanh_fast(float x) { const float e = __expf(-2.0f * fabsf(x)); const float t = (1.0f - e) / (1.0f + e); return x < 0.f ? -t : t; }
__device__ __forceinline__ float gelu_tanh(float x) { const float u = 0.7978845608028654f * (x + 0.044715f * x * x * x); return 0.5f * x * (1.0f + tanh_fast(u)); }

struct ColSel { int cnt, split, gap, rt_split, rt_gap; };
__device__ __forceinline__ int p0_row(int ro, int N, int rmode) {
    if (rmode == 1) { const int hv = ro >= (N >> 1), nn = hv ? ro - (N >> 1) : ro; ro = 256 * (nn >> 7) + 128 * hv + (nn & 127); }
    else if (rmode == 2 && ro >= C_QR && ro < C_VR) { const int jj = ro & 127; ro = (ro & ~127) + ((jj & 63) >> 2) * 8 + ((jj >> 6) << 2) + (jj & 3); }
    else if (rmode == 2 || rmode == 3) { const int x = ro & 255; ro = (ro & ~255) + 128 * ((x >> 5) & 1) + 32 * (x >> 6) + (x & 31); }
    return ro;
}
__device__ __forceinline__ int p0_rowc(int col, int N, int rmode, const ColSel cs) { int ro = p0_row(col, N, rmode); if ((ro >> 8) >= cs.rt_split) ro -= 256 * cs.rt_gap; return ro; }
__device__ __forceinline__ void p0_load_item(const float* W, int N, int item, int lane, const ColSel cs, f32x4 (&wv)[8]) {
    const int kb = item / cs.cnt, j = item % cs.cnt, nb = j + (j >= cs.split ? cs.gap : 0), k0 = 64 * kb;
    const float* base = W + (size_t)(k0 + (lane >> 3)) * N + 32 * nb + 4 * (lane & 7);
#pragma unroll
    for (int i = 0; i < 8; ++i) wv[i] = *(const GAS f32x4*)(base + (size_t)(8 * i) * N);
}
__device__ __forceinline__ unsigned p0_pack8(const float (&q)[4]) {
    return __builtin_amdgcn_perm(__float_as_uint(q[1]), __float_as_uint(q[0]), 0x0c0c0400u) | __builtin_amdgcn_perm(__float_as_uint(q[3]), __float_as_uint(q[2]), 0x04000c0cu);
}
template <bool Q8>
__device__ __forceinline__ void p0_store_item(const f32x4 (&wv)[8], int K, int N, bf16* WT, int ldw, LAS float* scr, int item, int lane, int rmode, const float* gk, const unsigned* wamax, const ColSel cs) {
    const int kb = item / cs.cnt, j_ = item % cs.cnt, nb = j_ + (j_ >= cs.split ? cs.gap : 0), k0 = 64 * kb;
    float qsc = 1.0f;
    if (Q8) { const int blk = p0_rowc(32 * nb, N, rmode, cs) >> 5; qsc = 127.0f * __builtin_amdgcn_rcpf(fmaxf(__uint_as_float(((const GAS unsigned*)wamax)[blk]), 1e-20f)); }
#pragma unroll
    for (int i = 0; i < 8; ++i) { const int kk = 8 * i + (lane >> 3); const float gs = (gk ? ((const GAS float*)gk)[k0 + kk] : 1.0f) * qsc; LAS float* d = scr + kk * 33 + 4 * (lane & 7);
        d[0] = wv[i].x * gs; d[1] = wv[i].y * gs; d[2] = wv[i].z * gs; d[3] = wv[i].w * gs; }
    LDS_WAIT(); asm volatile("" ::: "memory");
    const int c = lane & 7;
#pragma unroll
    for (int j = 0; j < 4; ++j) { const int n = (lane >> 3) + 8 * j; const LAS float* s = scr + (8 * c) * 33 + n;
        const int ro = p0_rowc(32 * nb + n, N, rmode, cs);
        if (Q8) { const float qa[4] = {s[0 * 33] + 12582912.0f, s[1 * 33] + 12582912.0f, s[2 * 33] + 12582912.0f, s[3 * 33] + 12582912.0f}, qb[4] = {s[4 * 33] + 12582912.0f, s[5 * 33] + 12582912.0f, s[6 * 33] + 12582912.0f, s[7 * 33] + 12582912.0f};
            u32x2 o; o.x = p0_pack8(qa); o.y = p0_pack8(qb);
            *(GAS u32x2*)((signed char*)WT + (size_t)ro * ldw + k0 + 8 * c) = o; }
        else { v4u o; o.x = pk2(s[0 * 33], s[1 * 33]); o.y = pk2(s[2 * 33], s[3 * 33]); o.z = pk2(s[4 * 33], s[5 * 33]); o.w = pk2(s[6 * 33], s[7 * 33]);
            *(GAS v4u*)(WT + (size_t)ro * ldw + k0 + 8 * c) = o; } }
    LDS_WAIT(); asm volatile("" ::: "memory");
}
template <bool Q8>
__device__ __forceinline__ void p0_matrix_sel(const float* W, int K, int N, bf16* WT, int ldw, LAS float* scr, int gw, int NGW, int lane, int rmode, const float* gk, const unsigned* wamax, const ColSel cs) {
    const int nitems = (K / 64) * cs.cnt;
    f32x4 wa[8], wb[8];
    int it = gw;
    if (it < nitems) p0_load_item(W, N, it, lane, cs, wa);
    while (it < nitems) {
        const int it1 = it + NGW, it2 = it1 + NGW;
        if (it1 < nitems) p0_load_item(W, N, it1, lane, cs, wb);
        p0_store_item<Q8>(wa, K, N, WT, ldw, scr, it, lane, rmode, gk, wamax, cs);
        if (it1 >= nitems) break;
        if (it2 < nitems) p0_load_item(W, N, it2, lane, cs, wa);
        p0_store_item<Q8>(wb, K, N, WT, ldw, scr, it1, lane, rmode, gk, wamax, cs);
        it = it2;
    }
}
template <bool Q8>
__device__ __forceinline__ void p0_matrix(const float* W, int K, int N, bf16* WT, int ldw, LAS float* scr, int gw, int NGW, int lane, int rmode, const float* gk, const unsigned* wamax = nullptr) {
    p0_matrix_sel<Q8>(W, K, N, WT, ldw, scr, gw, NGW, lane, rmode, gk, wamax, ColSel{N / 32, N / 32, 0, 1 << 20, 0});
}
__device__ __forceinline__ void p0_amax_item(const f32x4 (&wv)[8], int N, int item, int lane, int rmode, const float* gk, unsigned* wamax, const ColSel cs) {
    const int kb = item / cs.cnt, j = item % cs.cnt, nb = j + (j >= cs.split ? cs.gap : 0), k0 = 64 * kb;
    float mx = 0.f;
#pragma unroll
    for (int i = 0; i < 8; ++i) { const float gs = fabsf(((const GAS float*)gk)[k0 + 8 * i + (lane >> 3)]); mx = fmaxf(mx, gs * fmaxf(fmaxf(fabsf(wv[i].x), fabsf(wv[i].y)), fmaxf(fabsf(wv[i].z), fabsf(wv[i].w)))); }
#pragma unroll
    for (int o = 1; o < 64; o <<= 1) mx = fmaxf(mx, __shfl_xor(mx, o));
    if (lane == 0) __hip_atomic_fetch_max((GAS unsigned*)wamax + (p0_rowc(32 * nb, N, rmode, cs) >> 5), __float_as_uint(mx), __ATOMIC_RELAXED, __HIP_MEMORY_SCOPE_AGENT);
}
__device__ __forceinline__ void p0_amax(const float* W, int K, int N, int gw, int NGW, int lane, int rmode, const float* gk, unsigned* wamax, const ColSel cs) {
    const int nitems = (K / 64) * cs.cnt;
    f32x4 wa[8], wb[8];
    int it = gw;
    if (it < nitems) p0_load_item(W, N, it, lane, cs, wa);
    while (it < nitems) {
        const int it1 = it + NGW, it2 = it1 + NGW;
        if (it1 < nitems) p0_load_item(W, N, it1, lane, cs, wb);
        p0_amax_item(wa, N, it, lane, rmode, gk, wamax, cs);
        if (it1 >= nitems) break;
        if (it2 < nitems) p0_load_item(W, N, it2, lane, cs, wa);
        p0_amax_item(wb, N, it1, lane, rmode, gk, wamax, cs);
        it = it2;
    }
}

__device__ __forceinline__ void rms_rows(const float* x, const float* g, bf16* xn, int gw, int NGW, int lane) {
    f32x4 gg[4];
#pragma unroll
    for (int j = 0; j < 4; ++j) gg[j] = *((const f32x4*)g + lane + 64 * j);
    for (int m = gw; m < MH; m += NGW) {
        const GAS f32x4* xr = (const GAS f32x4*)(x + (size_t)m * D) + lane;
        f32x4 v[4]; float s = 0.f;
#pragma unroll
        for (int j = 0; j < 4; ++j) { v[j] = xr[64 * j]; s += (v[j].x * v[j].x + v[j].y * v[j].y) + (v[j].z * v[j].z + v[j].w * v[j].w); }
        const float r = __builtin_amdgcn_rsqf(wave_sum(s) * (1.f / D) + EPS);
        GAS u32x2* o = (GAS u32x2*)(xn + (size_t)m * D) + lane;
#pragma unroll
        for (int j = 0; j < 4; ++j) { u32x2 w; w.x = pk2(v[j].x * r * gg[j].x, v[j].y * r * gg[j].y); w.y = pk2(v[j].z * r * gg[j].z, v[j].w * r * gg[j].w); o[64 * j] = w; }
    }
}
__device__ __forceinline__ void xg_rows(const float* x, bf16* xg, float* stat, signed char* xq, float* qs, float* amx, int gw, int NGW, int lane) {
    for (int m0 = gw * 4; m0 < MH; m0 += NGW * 4) {
        f32x4 v[4][4];
#pragma unroll
        for (int r = 0; r < 4; ++r) { const GAS f32x4* xr = (const GAS f32x4*)(x + (size_t)(m0 + r) * D) + lane;
#pragma unroll
            for (int j = 0; j < 4; ++j) v[r][j] = xr[64 * j]; }
#pragma unroll
        for (int r = 0; r < 4; ++r) { float s = 0.f, mx = 0.f;
#pragma unroll
            for (int j = 0; j < 4; ++j) { s += (v[r][j].x * v[r][j].x + v[r][j].y * v[r][j].y) + (v[r][j].z * v[r][j].z + v[r][j].w * v[r][j].w);
                mx = fmaxf(mx, fmaxf(fmaxf(fabsf(v[r][j].x), fabsf(v[r][j].y)), fmaxf(fabsf(v[r][j].z), fabsf(v[r][j].w)))); }
            s = wave_sum(s);
#pragma unroll
            for (int o = 1; o < 64; o <<= 1) mx = fmaxf(mx, __shfl_xor(mx, o));
            const float B = fmaxf(mx, 1e-20f), s2 = 127.0f * __builtin_amdgcn_rcpf(B);
            GAS u32x2* o = (GAS u32x2*)(xg + (size_t)(m0 + r) * D) + lane;
            GAS unsigned* oq = (GAS unsigned*)(xq + (size_t)(m0 + r) * D) + lane;
#pragma unroll
            for (int j = 0; j < 4; ++j) { u32x2 w; w.x = pk2(v[r][j].x, v[r][j].y); w.y = pk2(v[r][j].z, v[r][j].w); o[64 * j] = w;
                if (PG_I8_P1) { const float qa[4] = {v[r][j].x * s2 + 12582912.0f, v[r][j].y * s2 + 12582912.0f, v[r][j].z * s2 + 12582912.0f, v[r][j].w * s2 + 12582912.0f}; oq[64 * j] = p0_pack8(qa); } }
            if (lane == 0) { *(GAS f32x4*)(stat + (size_t)(m0 + r) * 4) = (f32x4){s, 0.f, 0.f, 0.f}; *(GAS f32x4*)(amx + (size_t)(m0 + r) * 4) = (f32x4){mx, mx, mx, mx}; ((GAS float*)qs)[m0 + r] = B * (1.0f / 127.0f); } }
    }
}
__device__ __forceinline__ void resid_rows(const bf16* z, const float* xsrc, float* xdst, const float* gpost, const float* gnext, bf16* xn, int gw, int NGW, int lane) {
    for (int m = gw; m < MH; m += NGW) {
        const GAS u32x2* zr = (const GAS u32x2*)(z + (size_t)m * D) + lane;
        const GAS f32x4* xr = (const GAS f32x4*)(xsrc + (size_t)m * D) + lane;
        f32x4 v[4], xv[4]; float s = 0.f;
#pragma unroll
        for (int j = 0; j < 4; ++j) { const u32x2 zb = zr[64 * j]; v[j] = (f32x4){bf2f(zb.x & 0xffffu), bf2f(zb.x >> 16), bf2f(zb.y & 0xffffu), bf2f(zb.y >> 16)}; xv[j] = xr[64 * j]; s += (v[j].x * v[j].x + v[j].y * v[j].y) + (v[j].z * v[j].z + v[j].w * v[j].w); }
        const float r = __builtin_amdgcn_rsqf(wave_sum(s) * (1.f / D) + EPS);
        float s2 = 0.f;
        GAS f32x4* xo = (GAS f32x4*)(xdst + (size_t)m * D) + lane;
#pragma unroll
        for (int j = 0; j < 4; ++j) { const f32x4 gp = *((const f32x4*)gpost + lane + 64 * j); v[j] = xv[j] + v[j] * r * gp; xo[64 * j] = v[j];
            s2 += (v[j].x * v[j].x + v[j].y * v[j].y) + (v[j].z * v[j].z + v[j].w * v[j].w); }
        if (gnext) {
            const float r2 = __builtin_amdgcn_rsqf(wave_sum(s2) * (1.f / D) + EPS);
            GAS u32x2* o = (GAS u32x2*)(xn + (size_t)m * D) + lane;
#pragma unroll
            for (int j = 0; j < 4; ++j) { const f32x4 gn = *((const f32x4*)gnext + lane + 64 * j); u32x2 w; w.x = pk2(v[j].x * r2 * gn.x, v[j].y * r2 * gn.y); w.y = pk2(v[j].z * r2 * gn.z, v[j].w * r2 * gn.w); o[64 * j] = w; }
        }
    }
}
__device__ __forceinline__ void conv_phase(const bf16* U, bf16* G, const float* cw, const float* cb, int gt, int NGT) {
    constexpr int CG = DFF / 8, NIT = (MH / 32) * CG;
    for (int it = gt; it < NIT; it += NGT) {
        const int cg = it % CG, rg = it / CG, c0 = cg * 8, t0 = rg * 32;
        float w0[8], w1[8], w2[8], bb[8];
#pragma unroll
        for (int e = 0; e < 8; ++e) { w0[e] = cw[c0 + e]; w1[e] = cw[DFF + c0 + e]; w2[e] = cw[2 * DFF + c0 + e]; bb[e] = cb[c0 + e]; }
        float a2[8], a1[8];
        if ((t0 & (SEQ - 1)) == 0) {
#pragma unroll
            for (int e = 0; e < 8; ++e) { a2[e] = 0.f; a1[e] = 0.f; }
        } else {
            const v4u p2 = *(const GAS v4u*)(U + (size_t)(t0 - 2) * NUP + c0), p1 = *(const GAS v4u*)(U + (size_t)(t0 - 1) * NUP + c0);
            a2[0] = bf2f(p2.x & 0xffffu); a2[1] = bf2f(p2.x >> 16); a2[2] = bf2f(p2.y & 0xffffu); a2[3] = bf2f(p2.y >> 16); a2[4] = bf2f(p2.z & 0xffffu); a2[5] = bf2f(p2.z >> 16); a2[6] = bf2f(p2.w & 0xffffu); a2[7] = bf2f(p2.w >> 16);
            a1[0] = bf2f(p1.x & 0xffffu); a1[1] = bf2f(p1.x >> 16); a1[2] = bf2f(p1.y & 0xffffu); a1[3] = bf2f(p1.y >> 16); a1[4] = bf2f(p1.z & 0xffffu); a1[5] = bf2f(p1.z >> 16); a1[6] = bf2f(p1.w & 0xffffu); a1[7] = bf2f(p1.w >> 16);
        }
#pragma unroll 4
        for (int t = 0; t < 32; ++t) {
            const v4u pa = *(const GAS v4u*)(U + (size_t)(t0 + t) * NUP + c0), pv = *(const GAS v4u*)(U + (size_t)(t0 + t) * NUP + DFF + c0);
            float a0[8], vv[8], o[8];
            a0[0] = bf2f(pa.x & 0xffffu); a0[1] = bf2f(pa.x >> 16); a0[2] = bf2f(pa.y & 0xffffu); a0[3] = bf2f(pa.y >> 16); a0[4] = bf2f(pa.z & 0xffffu); a0[5] = bf2f(pa.z >> 16); a0[6] = bf2f(pa.w & 0xffffu); a0[7] = bf2f(pa.w >> 16);
            vv[0] = bf2f(pv.x & 0xffffu); vv[1] = bf2f(pv.x >> 16); vv[2] = bf2f(pv.y & 0xffffu); vv[3] = bf2f(pv.y >> 16); vv[4] = bf2f(pv.z & 0xffffu); vv[5] = bf2f(pv.z >> 16); vv[6] = bf2f(pv.w & 0xffffu); vv[7] = bf2f(pv.w >> 16);
#pragma unroll
            for (int e = 0; e < 8; ++e) { const float ac = bb[e] + w0[e] * a2[e] + w1[e] * a1[e] + w2[e] * a0[e]; o[e] = gelu_tanh(ac) * vv[e]; a2[e] = a1[e]; a1[e] = a0[e]; }
            v4u w; w.x = pk2(o[0], o[1]); w.y = pk2(o[2], o[3]); w.z = pk2(o[4], o[5]); w.w = pk2(o[6], o[7]);
            *(GAS v4u*)(G + (size_t)(t0 + t) * DFF + c0) = w;
        }
    }
}
__device__ __forceinline__ void ld8(const bf16* p, float (&o)[8]) { const v4u v = *(const GAS v4u*)p; o[0] = bf2f(v.x & 0xffffu); o[1] = bf2f(v.x >> 16); o[2] = bf2f(v.y & 0xffffu); o[3] = bf2f(v.y >> 16); o[4] = bf2f(v.z & 0xffffu); o[5] = bf2f(v.z >> 16); o[6] = bf2f(v.w & 0xffffu); o[7] = bf2f(v.w >> 16); }
__device__ __forceinline__ void up8(const v4u v, float (&o)[8]) { o[0] = bf2f(v.x & 0xffffu); o[1] = bf2f(v.x >> 16); o[2] = bf2f(v.y & 0xffffu); o[3] = bf2f(v.y >> 16); o[4] = bf2f(v.z & 0xffffu); o[5] = bf2f(v.z >> 16); o[6] = bf2f(v.w & 0xffffu); o[7] = bf2f(v.w >> 16); }
__device__ __forceinline__ void conv_fixup(const bf16* H, bf16* G, const float* cw, const float* cb, int pm, int tid) {
    if (tid >= DFF / 8) return;
    asm volatile("" : "+s"(pm));
    const int c0 = 8 * tid;
    v4u ld[4][6];
#pragma unroll
    for (int g = 0; g < 4; ++g) { const int grp = 4 * pm + g; const bool seq0 = ((grp * 64) & (SEQ - 1)) == 0; const int gp = seq0 ? grp : grp - 1;
        ld[g][0] = *(const GAS v4u*)(H + (size_t)(gp * 6 + 0) * DFF + c0);  ld[g][1] = *(const GAS v4u*)(H + (size_t)(gp * 6 + 1) * DFF + c0);
        ld[g][2] = *(const GAS v4u*)(H + (size_t)(grp * 6 + 2) * DFF + c0); ld[g][3] = *(const GAS v4u*)(H + (size_t)(grp * 6 + 3) * DFF + c0);
        ld[g][4] = *(const GAS v4u*)(H + (size_t)(grp * 6 + 4) * DFF + c0); ld[g][5] = *(const GAS v4u*)(H + (size_t)(grp * 6 + 5) * DFF + c0); }
    float w0[8], w1[8], w2[8], bb[8];
#pragma unroll
    for (int h = 0; h < 2; ++h) { const f32x4 a = *(const GAS f32x4*)(cw + c0 + 4 * h), b = *(const GAS f32x4*)(cw + DFF + c0 + 4 * h), c = *(const GAS f32x4*)(cw + 2 * DFF + c0 + 4 * h), d = *(const GAS f32x4*)(cb + c0 + 4 * h);
#pragma unroll
        for (int i = 0; i < 4; ++i) { w0[4 * h + i] = a[i]; w1[4 * h + i] = b[i]; w2[4 * h + i] = c[i]; bb[4 * h + i] = d[i]; } }
#pragma unroll
    for (int g = 0; g < 4; ++g) { const int grp = 4 * pm + g; const float pz = (((grp * 64) & (SEQ - 1)) == 0) ? 0.f : 1.f;
        float p62[8], p63[8], a0[8], a1[8], v0[8], v1[8], o0[8], o1[8];
        up8(ld[g][0], p62); up8(ld[g][1], p63); up8(ld[g][2], a0); up8(ld[g][3], a1); up8(ld[g][4], v0); up8(ld[g][5], v1);
#pragma unroll
        for (int e = 0; e < 8; ++e) { const float q62 = p62[e] * pz, q63 = p63[e] * pz;
            o0[e] = pg8::gelu_tanh_f(bb[e] + w0[e] * q62 + w1[e] * q63 + w2[e] * a0[e]) * v0[e];
            o1[e] = pg8::gelu_tanh_f(bb[e] + w0[e] * q63 + w1[e] * a0[e] + w2[e] * a1[e]) * v1[e]; }
        v4u x; x.x = pk2(o0[0], o0[1]); x.y = pk2(o0[2], o0[3]); x.z = pk2(o0[4], o0[5]); x.w = pk2(o0[6], o0[7]); *(GAS v4u*)(G + (size_t)(grp * 64) * DFF + c0) = x;
        v4u y; y.x = pk2(o1[0], o1[1]); y.y = pk2(o1[2], o1[3]); y.z = pk2(o1[4], o1[5]); y.w = pk2(o1[6], o1[7]); *(GAS v4u*)(G + (size_t)(grp * 64 + 1) * DFF + c0) = y; }
}
__device__ __forceinline__ void scan_phase(bf16* KV, int gt, int NGT) {
    constexpr int NIT = 16 * (256 * 128 / 4);
    for (int it = gt; it < NIT; it += NGT) {
        const int p = it / 8192, idx = it % 8192, h = p & 3;
        const float gc = GAMMA128_OF(h);
        GAS u32x2* base = (GAS u32x2*)(KV + (size_t)p * 32 * 32768) + idx;
        u32x2 ld[32];
#pragma unroll
        for (int n = 0; n < 32; ++n) ld[n] = base[(size_t)n * 8192];
        float s0 = 0.f, s1 = 0.f, s2 = 0.f, s3 = 0.f;
#pragma unroll
        for (int n = 0; n < 32; ++n) {
            u32x2 w; w.x = pk2(s0, s1); w.y = pk2(s2, s3); base[(size_t)n * 8192] = w;
            s0 = gc * s0 + bf2f(ld[n].x & 0xffffu); s1 = gc * s1 + bf2f(ld[n].x >> 16); s2 = gc * s2 + bf2f(ld[n].y & 0xffffu); s3 = gc * s3 + bf2f(ld[n].y >> 16);
        }
    }
}

__device__ __forceinline__ void attn_unit(LAS unsigned char* lds, const bf16* proj, bf16* aoa, const float* biastab, const float* sinks_l, int unit, int tid, int wave, int lane) {
    constexpr int KST = 144, VST = 136, K_OFF = 0, V_OFF = 256 * KST, B_OFF = V_OFF + 256 * VST;
    const int kh = unit & 1, n = (unit >> 1) & 31, bb = unit >> 6;
    const int rb = bb * SEQ + 128 * n;
#pragma unroll
    for (int it = tid; it < 2048; it += 512) {
        const int j = it >> 3, ch = it & 7;
        v4u kv = (v4u){0u, 0u, 0u, 0u}, vv = (v4u){0u, 0u, 0u, 0u};
        if (n > 0 || j >= 128) { const bf16* src = proj + (size_t)(rb - 128 + j) * DIN; kv = *(const GAS v4u*)(src + C_KA + kh * 64 + ch * 8); vv = *(const GAS v4u*)(src + C_VA + kh * 64 + ch * 8); }
        *(LAS v4u*)(lds + K_OFF + j * KST + ch * 16) = kv;
        *(LAS u32x2*)(lds + V_OFF + j * VST + ch * 16) = (u32x2){vv.x, vv.y};
        *(LAS u32x2*)(lds + V_OFF + j * VST + ch * 16 + 8) = (u32x2){vv.z, vv.w};
    }
    { LAS float* bl = (LAS float*)(lds + B_OFF); bl[tid] = biastab[(kh * 4 + (tid >> 7)) * 128 + (tid & 127)]; }
    __syncthreads();
    const int g = wave >> 1, qh = wave & 1, head = kh * 4 + g;
    const float sink = sinks_l[head];
    const int c = lane & 15, q = lane >> 4;
    const LAS float* bl = (const LAS float*)(lds + B_OFF) + g * 128;
    for (int qs = 0; qs < 4; ++qs) {
        const int i0 = 64 * qh + 16 * qs, i = i0 + c;
        const bf16* qsrc = proj + (size_t)(rb + i) * DIN + C_QA + head * 64 + 8 * q;
        const bf16x8 qf0 = *(const GAS bf16x8*)(qsrc), qf1 = *(const GAS bf16x8*)(qsrc + 32);
        f32x4 s[9];
#pragma unroll
        for (int kt = 0; kt < 9; ++kt) {
            const LAS unsigned char* kp = lds + K_OFF + (i0 + 16 * kt + c) * KST + 16 * q;
            const bf16x8 k0 = *(const LAS bf16x8*)kp, k1 = *(const LAS bf16x8*)(kp + 64);
            f32x4 a = (f32x4){0.f, 0.f, 0.f, 0.f};
            a = MFMA16(k0, qf0, a); a = MFMA16(k1, qf1, a); s[kt] = a;
        }
        float mx = -3.0e38f;
#pragma unroll
        for (int kt = 0; kt < 9; ++kt)
#pragma unroll
            for (int r = 0; r < 4; ++r) {
                const int j = i0 + 16 * kt + 4 * q + r, dist = 128 + i - j;
                const bool ok = (dist >= 0) && (dist < 128) && (n > 0 || j >= 128);
                const float v = ok ? s[kt][r] * 0.125f + bl[dist & 127] : -1.0e30f;
                s[kt][r] = v; mx = fmaxf(mx, v);
            }
        mx = fmaxf(mx, __shfl_xor(mx, 16)); mx = fmaxf(mx, __shfl_xor(mx, 32)); mx = fmaxf(mx, sink);
        float sum = 0.f;
#pragma unroll
        for (int kt = 0; kt < 9; ++kt)
#pragma unroll
            for (int r = 0; r < 4; ++r) { const float p = __expf(s[kt][r] - mx); s[kt][r] = p; sum += p; }
        sum += __shfl_xor(sum, 16); sum += __shfl_xor(sum, 32);
        const float inv = __builtin_amdgcn_rcpf(sum + __expf(sink - mx));
        f32x4 o[4];
#pragma unroll
        for (int dt = 0; dt < 4; ++dt) o[dt] = (f32x4){0.f, 0.f, 0.f, 0.f};
#pragma unroll
        for (int p = 0; p < 5; ++p) {
            const f32x4 ta = s[2 * p], tb = (2 * p + 1 < 9) ? s[2 * p + 1 < 9 ? 2 * p + 1 : 8] : (f32x4){0.f, 0.f, 0.f, 0.f};
            v4u pw; pw.x = pk2(ta[0], ta[1]); pw.y = pk2(ta[2], ta[3]); pw.z = pk2(tb[0], tb[1]); pw.w = pk2(tb[2], tb[3]);
            const bf16x8 pb = __builtin_bit_cast(bf16x8, pw);
#pragma unroll
            for (int dt = 0; dt < 4; ++dt) {
                bf16x8 va;
#pragma unroll
                for (int j = 0; j < 8; ++j) { int key = i0 + 32 * p + (j < 4 ? 4 * q + j : 16 + 4 * q + (j - 4)); key = key > 255 ? 255 : key;
                    va[j] = (short)*(const LAS u16*)(lds + V_OFF + key * VST + (16 * dt + c) * 2); }
                o[dt] = MFMA16(va, pb, o[dt]);
            }
        }
        bf16* orow = aoa + (size_t)(rb + i) * 1536 + head * 64 + 4 * q;
#pragma unroll
        for (int dt = 0; dt < 4; ++dt) { u32x2 w; w.x = pk2(o[dt][0] * inv, o[dt][1] * inv); w.y = pk2(o[dt][2] * inv, o[dt][3] * inv); *(GAS u32x2*)(orow + 16 * dt) = w; }
    }
    __syncthreads();
}

__device__ __forceinline__ void stage_copy(LAS unsigned char* img, const bf16* src, int s, int i8) {
    const v4u x1 = *(const GAS v4u*)(src), x2 = *(const GAS v4u*)(src + 64);
    *(LAS v4u*)(img + s * 272 + i8 * 16) = x1; *(LAS v4u*)(img + s * 272 + 128 + i8 * 16) = x2;
}
__device__ __forceinline__ void stage_v(LAS unsigned char* img, const bf16* proj, int rb, int h, int tid) {
#pragma unroll
    for (int it = tid; it < 4096; it += 512) { const int s = it >> 5, ch = it & 31;
        const v4u v = *(const GAS v4u*)(proj + (size_t)(rb + s) * DIN + C_VR + h * 256 + 8 * ch);
        *(LAS u32x2*)(img + s * 520 + ch * 16) = (u32x2){v.x, v.y}; *(LAS u32x2*)(img + s * 520 + ch * 16 + 8) = (u32x2){v.z, v.w}; }
}
__device__ __forceinline__ void kv_unit(LAS unsigned char* lds, const bf16* proj, bf16* kvbuf, int unit, int tid, int wave, int lane) {
    constexpr int KZ_OFF = 0, V_OFF = 128 * 272;
    const int n = unit & 31, h = (unit >> 5) & 3, bb = unit >> 7;
    const int rb = bb * SEQ + 128 * n;
    const float lg = __logf(1.0f - exp2f(-5.0f - (float)h)), g127 = __expf(127.0f * lg);
#pragma unroll
    for (int it = tid; it < 1024; it += 512) { const int s = it >> 3, i8 = it & 7; stage_copy(lds + KZ_OFF, proj + (size_t)(rb + s) * DIN + C_KR + h * 128 + 8 * i8, s, i8); }
    stage_v(lds + V_OFF, proj, rb, h, tid);
    __syncthreads();
    const int c = lane & 15, q = lane >> 4;
    f32x4 acc[2][8];
#pragma unroll
    for (int ei = 0; ei < 2; ++ei)
#pragma unroll
        for (int dt = 0; dt < 8; ++dt) acc[ei][dt] = (f32x4){0.f, 0.f, 0.f, 0.f};
#pragma unroll
    for (int ks = 0; ks < 4; ++ks) {
        bf16x8 bfr[2];
#pragma unroll
        for (int ei = 0; ei < 2; ++ei)
#pragma unroll
            for (int j = 0; j < 8; ++j) bfr[ei][j] = (short)*(const LAS u16*)(lds + V_OFF + (32 * ks + 8 * q + j) * 520 + (16 * (2 * wave + ei) + c) * 2);
#pragma unroll
        for (int dt = 0; dt < 8; ++dt) {
            bf16x8 af;
#pragma unroll
            for (int j = 0; j < 8; ++j) af[j] = (short)*(const LAS u16*)(lds + KZ_OFF + (32 * ks + 8 * q + j) * 272 + (16 * dt + c) * 2);
#pragma unroll
            for (int ei = 0; ei < 2; ++ei) acc[ei][dt] = MFMA16(af, bfr[ei], acc[ei][dt]);
        }
    }
#pragma unroll
    for (int ei = 0; ei < 2; ++ei) { const int e = 16 * (2 * wave + ei) + c; bf16* dst = kvbuf + ((size_t)unit * 256 + e) * 128 + 4 * q;
#pragma unroll
        for (int dt = 0; dt < 8; ++dt) { u32x2 w; w.x = pk2(acc[ei][dt][0] * g127, acc[ei][dt][1] * g127); w.y = pk2(acc[ei][dt][2] * g127, acc[ei][dt][3] * g127); *(GAS u32x2*)(dst + 16 * dt) = w; } }
    __syncthreads();
}
__device__ __forceinline__ void ret_unit(LAS unsigned char* lds, const bf16* proj, const bf16* kvbuf, bf16* aor, const float* rnorm_l, int unit, int tid, int wave, int lane) {
    constexpr int Q_OFF = 0, K_OFF = 128 * 272, V_OFF = 2 * 128 * 272;
    const int n = unit & 31, h = (unit >> 5) & 3, bb = unit >> 7;
    const int rb = bb * SEQ + 128 * n;
    const float lg = __logf(1.0f - exp2f(-5.0f - (float)h));
#pragma unroll
    for (int it = tid; it < 2048; it += 512) { const int which = it >> 10, s = (it >> 3) & 127, i8 = it & 7;
        stage_copy(lds + (which ? K_OFF : Q_OFF), proj + (size_t)(rb + s) * DIN + (which ? C_KR : C_QR) + h * 128 + 8 * i8, s, i8); }
    stage_v(lds + V_OFF, proj, rb, h, tid);
    __syncthreads();
    const int c = lane & 15, q = lane >> 4, cl = 16 * wave + c;
    bf16x8 qf[4];
#pragma unroll
    for (int ks = 0; ks < 4; ++ks) qf[ks] = *(const LAS bf16x8*)(lds + Q_OFF + cl * 272 + (32 * ks + 8 * q) * 2);
    f32x4 sT[8];
#pragma unroll
    for (int st = 0; st < 8; ++st) {
        f32x4 a = (f32x4){0.f, 0.f, 0.f, 0.f};
        if (st <= wave) {
#pragma unroll
            for (int ks = 0; ks < 4; ++ks) { const bf16x8 kf = *(const LAS bf16x8*)(lds + K_OFF + (16 * st + c) * 272 + (32 * ks + 8 * q) * 2); a = MFMA16(kf, qf[ks], a); }
#pragma unroll
            for (int r = 0; r < 4; ++r) { const int s = 16 * st + 4 * q + r; a[r] = (cl >= s) ? a[r] : 0.f; }
        }
        sT[st] = a;
    }
    f32x4 o[16];
    const bf16* stp = kvbuf + (size_t)unit * 256 * 128 + (size_t)c * 128 + 8 * q;
#pragma unroll
    for (int et = 0; et < 16; ++et) {
        f32x4 a = (f32x4){0.f, 0.f, 0.f, 0.f};
#pragma unroll
        for (int ks = 0; ks < 4; ++ks) { const bf16x8 sf = *(const GAS bf16x8*)(stp + (size_t)et * 16 * 128 + 32 * ks); a = MFMA16(sf, qf[ks], a); }
        o[et] = a;
    }
    const float xi = __expf(lg);
#pragma unroll
    for (int et = 0; et < 16; ++et) o[et] = o[et] * xi;
#pragma unroll
    for (int p = 0; p < 4; ++p) {
        if (2 * p <= wave) {
            const f32x4 ta = sT[2 * p], tb = sT[2 * p + 1];
            v4u pw; pw.x = pk2(ta[0], ta[1]); pw.y = pk2(ta[2], ta[3]); pw.z = pk2(tb[0], tb[1]); pw.w = pk2(tb[2], tb[3]);
            const bf16x8 pb = __builtin_bit_cast(bf16x8, pw);
#pragma unroll
            for (int et = 0; et < 16; ++et) {
                bf16x8 va;
#pragma unroll
                for (int j = 0; j < 8; ++j) { const int s = 32 * p + (j < 4 ? 4 * q + j : 16 + 4 * q + (j - 4)); va[j] = (short)*(const LAS u16*)(lds + V_OFF + s * 520 + (16 * et + c) * 2); }
                o[et] = MFMA16(va, pb, o[et]);
            }
        }
    }
    float sm = 0.f;
#pragma unroll
    for (int et = 0; et < 16; ++et) sm += (o[et][0] + o[et][1]) + (o[et][2] + o[et][3]);
    sm += __shfl_xor(sm, 16); sm += __shfl_xor(sm, 32);
    const float mu = sm * (1.0f / 256.0f);
    float vs = 0.f;
#pragma unroll
    for (int et = 0; et < 16; ++et) { const f32x4 d = o[et] - mu; vs += (d[0] * d[0] + d[1] * d[1]) + (d[2] * d[2] + d[3] * d[3]); }
    vs += __shfl_xor(vs, 16); vs += __shfl_xor(vs, 32);
    const float rs = __builtin_amdgcn_rsqf(vs * (1.0f / 256.0f) + EPS);
    const size_t tok = (size_t)(rb + cl);
    const bf16* grow = proj + tok * DIN + C_GR + h * 256 + 4 * q;
    bf16* orow = aor + tok * 1536 + 512 + h * 256 + 4 * q;
    const float* gn = rnorm_l + h * 256 + 4 * q;
#pragma unroll
    for (int et = 0; et < 16; ++et) {
        const u32x2 gv = *(const GAS u32x2*)(grow + 16 * et); const f32x4 gg = *(const GAS f32x4*)(gn + 16 * et);
        const float g0 = bf2f(gv.x & 0xffffu), g1 = bf2f(gv.x >> 16), g2 = bf2f(gv.y & 0xffffu), g3 = bf2f(gv.y >> 16);
        const float y0 = (o[et][0] - mu) * rs * gg.x * g0 * sigm(g0), y1 = (o[et][1] - mu) * rs * gg.y * g1 * sigm(g1), y2 = (o[et][2] - mu) * rs * gg.z * g2 * sigm(g2), y3 = (o[et][3] - mu) * rs * gg.w * g3 * sigm(g3);
        u32x2 w; w.x = pk2(y0, y1); w.y = pk2(y2, y3); *(GAS u32x2*)(orow + 16 * et) = w;
    }
    __syncthreads();
}

__device__ __forceinline__ void ret_dma(LAS unsigned char* buf, int type, const bf16* proj, const bf16* kvbuf, int unit, int wave, int lane) {
    const int n = unit & 31, h = (unit >> 5) & 3, bb = unit >> 7, rb = bb * SEQ + 128 * n;
    asm volatile("" : "+v"(lane));
#pragma unroll
    for (int i = 0; i < 4; ++i) {
        const int ins = wave * 4 + i, P = ins * 64 + lane;
        const char* src;
        if (type < 2) { const int r = P >> 4, ch = (P & 15) ^ (r & 15); src = (const char*)(proj + (size_t)(rb + r) * DIN + (type == 0 ? C_QR : C_KR) + h * 128) + ch * 16; }
        else if (type < 4) { const int r = (P >> 4) + 128 * (type - 2), ch = (P & 15) ^ (r & 15); src = (const char*)(kvbuf + ((size_t)unit * 256 + r) * 128) + ch * 16; }
        else { const int r = (P >> 5) + 64 * (type & 1), cp = P & 31, ch = (((cp >> 1) ^ (r & 7)) << 1) | (cp & 1); src = (const char*)(proj + (size_t)(rb + r) * DIN + (type < 6 ? C_VR : C_GR) + h * 256) + ch * 16; }
        __builtin_amdgcn_global_load_lds((const unsigned*)src, (LAS unsigned*)(buf + ins * 1024), 16, 0, 0);
    }
}
typedef short v4i16_t __attribute__((ext_vector_type(4)));
__device__ __forceinline__ bf16x8 tr_pair(const LAS unsigned char* p0, const LAS unsigned char* p1) {
    const v4i16_t lo = __builtin_amdgcn_ds_read_tr16_b64_v4i16((LAS v4i16_t*)p0), hi = __builtin_amdgcn_ds_read_tr16_b64_v4i16((LAS v4i16_t*)p1);
    return (bf16x8){lo[0], lo[1], lo[2], lo[3], hi[0], hi[1], hi[2], hi[3]};
}
__device__ __forceinline__ void ret_phase(LAS unsigned char* lds, const bf16* proj, const bf16* kvbuf, bf16* ao, const float* rnorm_l, int bx, int G, int wave, int lane) {
    const int nu = (512 - bx + G - 1) / G, nsteps = 8 * nu;
    { LAS float* gl = (LAS float*)(lds + RING_BYTES); const int t = wave * 64 + lane; gl[t] = ((const GAS float*)rnorm_l)[t]; gl[t + 512] = ((const GAS float*)rnorm_l)[t + 512]; }
    if (nsteps <= 0) return;
    const int c = lane & 15, q = lane >> 4, cl = 16 * wave + c;
    f32x4 sT[8], o[16]; bf16x8 qf[4];
#pragma unroll
    for (int i = 0; i < 8; ++i) sT[i] = (f32x4){0.f, 0.f, 0.f, 0.f};
#pragma unroll
    for (int i = 0; i < 16; ++i) o[i] = (f32x4){0.f, 0.f, 0.f, 0.f};
#pragma unroll
    for (int i = 0; i < 4; ++i) qf[i] = (bf16x8){0, 0, 0, 0, 0, 0, 0, 0};
    float mu = 0.f, rs = 0.f; int last_store = -100;
#pragma unroll
    for (int k0 = 0; k0 < 3; ++k0) if (k0 < nsteps) ret_dma(lds + k0 * 32768, k0 & 7, proj, kvbuf, bx + (k0 >> 3) * G, wave, lane);
    for (int k = 0; k < nsteps; ++k) {
        const int unit = bx + (k >> 3) * G, type = k & 7;
        const LAS unsigned char* buf = lds + (k & 3) * 32768;
        if (k + 3 < nsteps) ret_dma(lds + ((k + 3) & 3) * 32768, (k + 3) & 7, proj, kvbuf, bx + ((k + 3) >> 3) * G, wave, lane);
        const int later = nsteps - 1 - k;
        if (later >= 3) { if ((unsigned)(k - last_store - 1) < 3u) asm volatile("s_waitcnt vmcnt(28)" ::: "memory"); else asm volatile("s_waitcnt vmcnt(12)" ::: "memory"); }
        else if (later == 2) asm volatile("s_waitcnt vmcnt(8)" ::: "memory");
        else if (later == 1) asm volatile("s_waitcnt vmcnt(4)" ::: "memory"); else asm volatile("s_waitcnt vmcnt(0)" ::: "memory");
        __builtin_amdgcn_s_barrier(); asm volatile("" ::: "memory");
        const int h = (unit >> 5) & 3;
        int co = c; asm volatile("" : "+v"(co));
        const int xq = (q ^ co) << 4;
        const LAS unsigned char* lb = buf + co * 256;
        if (type == 0) {
#pragma unroll
            for (int ks = 0; ks < 4; ++ks) qf[ks] = *(const LAS bf16x8*)(lb + wave * 4096 + (xq ^ (ks << 6)));
        } else if (type == 1) {
#pragma unroll
            for (int st = 0; st < 8; ++st) {
                f32x4 a = (f32x4){0.f, 0.f, 0.f, 0.f};
                if (st <= wave) {
#pragma unroll
                    for (int ks = 0; ks < 4; ++ks) { const bf16x8 kf = *(const LAS bf16x8*)(lb + st * 4096 + (xq ^ (ks << 6))); a = MFMA16(kf, qf[ks], a); }
#pragma unroll
                    for (int rr = 0; rr < 4; ++rr) { const int s = 16 * st + 4 * q + rr; a[rr] = (cl >= s) ? a[rr] : 0.f; }
                }
                sT[st] = a;
            }
        } else if (type < 4) {
            const float gam = GAMMA_OF(h);
#pragma unroll
            for (int e8 = 0; e8 < 8; ++e8) {
                f32x4 a = (f32x4){0.f, 0.f, 0.f, 0.f};
#pragma unroll
                for (int ks = 0; ks < 4; ++ks) { const bf16x8 sf = *(const LAS bf16x8*)(lb + e8 * 4096 + (xq ^ (ks << 6))); a = MFMA16(sf, qf[ks], a); }
                o[e8] = a * gam;
            }
            if (type == 2) {
#pragma unroll
                for (int e8 = 0; e8 < 8; ++e8) o[8 + e8] = o[e8];
            }
        } else if (type < 6) {
            const int x0 = (4 * q + (co >> 2)) & 7;
            const LAS unsigned char* vb = buf + (4 * q + (co >> 2)) * 512 + (co & 3) * 8;
            const int pbase = (type & 1) * 2;
#pragma unroll
            for (int pp = 0; pp < 2; ++pp) {
                if (2 * (pbase + pp) <= wave) {
                    const f32x4 ta = sT[2 * pp], tb = sT[2 * pp + 1];
                    v4u pw; pw.x = pk2(ta[0], ta[1]); pw.y = pk2(ta[2], ta[3]); pw.z = pk2(tb[0], tb[1]); pw.w = pk2(tb[2], tb[3]);
                    const bf16x8 pb = __builtin_bit_cast(bf16x8, pw);
#pragma unroll
                    for (int r = 0; r < 16; ++r) { const int et = r ^ 8, po = (((et & 7) ^ x0) << 5) + ((et & 8) << 5);
                        const bf16x8 va = tr_pair(vb + pp * 32 * 512 + po, vb + pp * 32 * 512 + 16 * 512 + po); o[r] = MFMA16(va, pb, o[r]); }
                }
            }
            if (type == 4) {
#pragma unroll
                for (int i = 0; i < 4; ++i) sT[i] = sT[4 + i];
            } else {
                float sm = 0.f;
#pragma unroll
                for (int r = 0; r < 16; ++r) sm += (o[r][0] + o[r][1]) + (o[r][2] + o[r][3]);
                sm += __shfl_xor(sm, 16); sm += __shfl_xor(sm, 32);
                mu = sm * (1.0f / 256.0f);
                float vs = 0.f;
#pragma unroll
                for (int r = 0; r < 16; ++r) { const f32x4 d = o[r] - mu; vs += (d[0] * d[0] + d[1] * d[1]) + (d[2] * d[2] + d[3] * d[3]); }
                vs += __shfl_xor(vs, 16); vs += __shfl_xor(vs, 32);
                rs = __builtin_amdgcn_rsqf(vs * (1.0f / 256.0f) + EPS);
            }
        } else if ((type == 6) == (wave < 4)) {
            const int n = unit & 31, bb = unit >> 7; const size_t tok = (size_t)(bb * SEQ + 128 * n + cl);
            bf16* orow = ao + tok * 1536 + 512 + h * 256 + 4 * q;
            const LAS unsigned char* gb = buf + (cl & 63) * 512 + 8 * q;
            const LAS float* gl = (const LAS float*)(lds + RING_BYTES) + h * 256 + 4 * q;
            const int xr = cl & 7; const float murs = mu * rs;
#pragma unroll
            for (int r = 0; r < 16; ++r) { const int et = r ^ 8;
                const u32x2 gv = *(const LAS u32x2*)(gb + ((((et & 7) ^ xr) | (et & 8)) << 5)); const f32x4 gg = *(const LAS f32x4*)(gl + 16 * et);
                typedef float f2_t __attribute__((ext_vector_type(2)));
                const f2_t ga = (f2_t){bf2f(gv.x & 0xffffu), __uint_as_float(gv.x & 0xffff0000u)}, gb_ = (f2_t){bf2f(gv.y & 0xffffu), __uint_as_float(gv.y & 0xffff0000u)};
                const f2_t xa = ga * -1.4426950408889634f, xb = gb_ * -1.4426950408889634f;
                f2_t ea, eb; ea.x = __builtin_amdgcn_exp2f(xa.x); ea.y = __builtin_amdgcn_exp2f(xa.y); eb.x = __builtin_amdgcn_exp2f(xb.x); eb.y = __builtin_amdgcn_exp2f(xb.y);
                const f2_t da = ea + 1.0f, db = eb + 1.0f; f2_t sa, sb; sa.x = __builtin_amdgcn_rcpf(da.x); sa.y = __builtin_amdgcn_rcpf(da.y); sb.x = __builtin_amdgcn_rcpf(db.x); sb.y = __builtin_amdgcn_rcpf(db.y);
                const f2_t ta = ((f2_t){o[r][0], o[r][1]} * rs - murs) * (f2_t){gg.x, gg.y} * ga * sa, tb = ((f2_t){o[r][2], o[r][3]} * rs - murs) * (f2_t){gg.z, gg.w} * gb_ * sb;
                const float y0 = ta.x, y1 = ta.y, y2 = tb.x, y3 = tb.y;
                u32x2 w; w.x = pk2(y0, y1); w.y = pk2(y2, y3); *(GAS u32x2*)(orow + 16 * et) = w;
            }
            last_store = k;
        }
        asm volatile("s_waitcnt lgkmcnt(0)" ::: "memory"); __builtin_amdgcn_s_barrier(); asm volatile("" ::: "memory");
    }
}

__device__ __forceinline__ void mix_dma(LAS unsigned char* buf, int k, const bf16* proj, int bx, int wave, int lane) {
    asm volatile("" : "+v"(lane));
    if (k == 0) {
        const int kh = bx & 1, n = (bx >> 1) & 31, bb = bx >> 6, rb = bb * SEQ + 128 * n;
#pragma unroll
        for (int i = 0; i < 8; ++i) {
            const int ins = wave * 8 + i, P = (ins * 64 + lane) & 2047, r = P >> 3, cp = P & 7, isv = ins >> 5;
            const int ch = isv ? ((((cp >> 1) ^ ((r >> 1) & 3)) << 1) | (cp & 1)) : (cp ^ (r & 7));
            const int grow = (n == 0 && r < 128) ? rb + r : rb - 128 + r;
            const char* src = (const char*)(proj + (size_t)grow * DIN + (isv ? C_VA : C_KA) + kh * 64) + ch * 16;
            __builtin_amdgcn_global_load_lds((const unsigned*)src, (LAS unsigned*)(buf + ins * 1024), 16, 0, 0);
        }
    } else {
        const int unit = bx + 256 * ((k - 1) >> 1), half = (k - 1) & 1;
        const int n = unit & 31, h = (unit >> 5) & 3, bb = unit >> 7, rb = bb * SEQ + 128 * n + 64 * half;
#pragma unroll
        for (int i = 0; i < 6; ++i) {
            const int ins = wave * 6 + i; const char* src;
            if (ins < 16) { const int P = ins * 64 + lane, r = P >> 4, cp = P & 15, ch = (((cp >> 1) ^ (r & 7)) << 1) | (cp & 1); src = (const char*)(proj + (size_t)(rb + r) * DIN + C_KR + h * 128) + ch * 16; }
            else { const int P = (ins - 16) * 64 + lane, r = P >> 5, cp = P & 31, ch = (((cp >> 1) ^ (r & 7)) << 1) | (cp & 1); src = (const char*)(proj + (size_t)(rb + r) * DIN + C_VR + h * 256) + ch * 16; }
            __builtin_amdgcn_global_load_lds((const unsigned*)src, (LAS unsigned*)(buf + ins * 1024), 16, 0, 0);
        }
    }
}
__device__ __forceinline__ void mix_phase(LAS unsigned char* lds, const bf16* proj, bf16* ao, bf16* kvbuf, const float* biastab, const float* sinks_l, int bx, int wave, int lane) {
    { LAS float* bl = (LAS float*)(lds + RING_BYTES + 4096); const int khh = bx & 1;
      for (int t = wave * 64 + lane; t < 640; t += 512) { const int h4 = t / 160, x = t % 160 - 16; bl[t] = (x >= 0 && x < 128) ? ((const GAS float*)biastab)[(khh * 4 + h4) * 128 + (127 - x)] * 1.4426950408889634f : 0.f; } }
    const int c = lane & 15, q = lane >> 4;
    mix_dma(lds, 0, proj, bx, wave, lane);
    {
        const int kh = bx & 1, an = (bx >> 1) & 31, abb = bx >> 6, arb = abb * SEQ + 128 * an;
        const int g = wave >> 1, qh = wave & 1, head = kh * 4 + g;
        bf16x8 qf[4][2];
#pragma unroll
        for (int qs = 0; qs < 4; ++qs) { const bf16* qsrc = proj + (size_t)(arb + 64 * qh + 16 * qs + c) * DIN + C_QA + head * 64 + 8 * q;
            qf[qs][0] = *(const GAS bf16x8*)(qsrc); qf[qs][1] = *(const GAS bf16x8*)(qsrc + 32); }
        const float sink = ((const GAS float*)sinks_l)[head];
        mix_dma(lds + 65536, 1, proj, bx, wave, lane); asm volatile("s_waitcnt vmcnt(6)" ::: "memory");
        __builtin_amdgcn_s_barrier(); asm volatile("" ::: "memory");
        int co = c; asm volatile("" : "+v"(co));
        const LAS unsigned char* buf = lds;
        const int db = 128 + co - 4 * q;
        const LAS float* tb = (const LAS float*)(lds + RING_BYTES + 4096) + g * 160 + (143 - db);
        const float sink2 = sink * 1.4426950408889634f;
        const int kx0 = (q ^ (co & 7)) << 4, kx1 = kx0 ^ 64;
        const LAS unsigned char* Kb = buf + co * 128;
        const LAS unsigned char* Vb = buf + 32768 + ((co & 1) << 4);
        const int vph = (co >> 1) & 1;
#pragma unroll 1
        for (int qs = 0; qs < 4; ++qs) {
            const int i0 = 64 * qh + 16 * qs, i = i0 + c;
            const bf16x8 q0 = qs == 0 ? qf[0][0] : qs == 1 ? qf[1][0] : qs == 2 ? qf[2][0] : qf[3][0], q1 = qs == 0 ? qf[0][1] : qs == 1 ? qf[1][1] : qs == 2 ? qf[2][1] : qf[3][1];
            f32x4 s[9];
#pragma unroll
            for (int kt = 0; kt < 9; ++kt) {
                const LAS unsigned char* kp = Kb + (i0 + 16 * kt) * 128;
                f32x4 a = (f32x4){0.f, 0.f, 0.f, 0.f};
                a = MFMA16(*(const LAS bf16x8*)(kp + kx0), q0, a); a = MFMA16(*(const LAS bf16x8*)(kp + kx1), q1, a); s[kt] = a;
            }
            float mx = -3.0e38f;
#pragma unroll
            for (int kt = 0; kt < 9; ++kt)
#pragma unroll
                for (int r = 0; r < 4; ++r) { const int K = 16 * kt + r;
                    float v = s[kt][r] * (0.125f * 1.4426950408889634f) + tb[K];
                    if (kt == 0) v = (K > db - 128) ? v : -1.0e30f;
                    if (kt == 8) v = (K <= db) ? v : -1.0e30f;
                    s[kt][r] = v; }
            if (an == 0) {
#pragma unroll
                for (int kt = 0; kt < 9; ++kt)
#pragma unroll
                    for (int r = 0; r < 4; ++r) s[kt][r] = (i0 + 16 * kt + 4 * q + r >= 128) ? s[kt][r] : -1.0e30f;
            }
#pragma unroll
            for (int kt = 0; kt < 9; ++kt) mx = fmaxf(fmaxf(mx, fmaxf(s[kt][0], s[kt][1])), fmaxf(s[kt][2], s[kt][3]));
            mx = fmaxf(mx, __shfl_xor(mx, 16)); mx = fmaxf(mx, __shfl_xor(mx, 32)); mx = fmaxf(mx, sink2);
            float sum = 0.f;
#pragma unroll
            for (int kt = 0; kt < 9; ++kt)
#pragma unroll
                for (int r = 0; r < 4; ++r) { const float pe = __builtin_amdgcn_exp2f(s[kt][r] - mx); s[kt][r] = pe; sum += pe; }
            sum += __shfl_xor(sum, 16); sum += __shfl_xor(sum, 32);
            const float inv = __builtin_amdgcn_rcpf(sum + __builtin_amdgcn_exp2f(sink2 - mx));
            f32x4 o[4];
#pragma unroll
            for (int dt = 0; dt < 4; ++dt) o[dt] = (f32x4){0.f, 0.f, 0.f, 0.f};
#pragma unroll
            for (int p = 0; p < 5; ++p) {
                const f32x4 ta = s[2 * p], tb = (2 * p + 1 < 9) ? s[2 * p + 1 < 9 ? 2 * p + 1 : 8] : (f32x4){0.f, 0.f, 0.f, 0.f};
                v4u pw; pw.x = pk2(ta[0], ta[1]); pw.y = pk2(ta[2], ta[3]); pw.z = pk2(tb[0], tb[1]); pw.w = pk2(tb[2], tb[3]);
                const bf16x8 pb = __builtin_bit_cast(bf16x8, pw);
                int r0 = i0 + 32 * p + 4 * q + (co >> 2), r1 = r0 + 16; r1 = r1 > 255 ? 255 : r1;
                const LAS unsigned char* v0 = Vb + r0 * 128; const LAS unsigned char* v1 = Vb + r1 * 128;
                const int x0 = (r0 >> 1) & 3, x1 = (r1 >> 1) & 3;
#pragma unroll
                for (int dt = 0; dt < 4; ++dt) { const int pr = 2 * (dt >> 1) + vph; const bf16x8 va = tr_pair(v0 + ((pr ^ x0) << 5) + 8 * (dt & 1), v1 + ((pr ^ x1) << 5) + 8 * (dt & 1)); o[dt] = MFMA16(va, pb, o[dt]); }
            }
            bf16* orow = ao + (size_t)(arb + i) * 1536 + head * 64 + 8 * q;
#pragma unroll
            for (int j = 0; j < 2; ++j) { const f32x4 a0 = o[2 * j] * inv, a1 = o[2 * j + 1] * inv; v4u w; w.x = pk2(a0[0], a0[1]); w.y = pk2(a0[2], a0[3]); w.z = pk2(a1[0], a1[1]); w.w = pk2(a1[2], a1[3]); *(GAS v4u*)(orow + 32 * j) = w; }
        }
        asm volatile("s_waitcnt lgkmcnt(0)" ::: "memory"); __builtin_amdgcn_s_barrier(); asm volatile("" ::: "memory");
    }
    f32x4 acc[2][8];
#pragma unroll
    for (int ei = 0; ei < 2; ++ei)
#pragma unroll
        for (int dt = 0; dt < 8; ++dt) acc[ei][dt] = (f32x4){0.f, 0.f, 0.f, 0.f};
    for (int k = 1; k < 5; ++k) {
        const LAS unsigned char* buf = lds + (k & 1) * 65536;
        if (k + 1 < 5) { mix_dma(lds + ((k + 1) & 1) * 65536, k + 1, proj, bx, wave, lane);
            if (k & 1) asm volatile("s_waitcnt vmcnt(14)" ::: "memory"); else asm volatile("s_waitcnt vmcnt(6)" ::: "memory"); }
        else asm volatile("s_waitcnt vmcnt(0)" ::: "memory");
        if (k > 1) { __builtin_amdgcn_s_barrier(); asm volatile("" ::: "memory"); }
        else { __builtin_amdgcn_s_barrier(); asm volatile("" ::: "memory"); }
        int co = c; asm volatile("" : "+v"(co));
        const int unit = bx + 256 * ((k - 1) >> 1), half = (k - 1) & 1, h = (unit >> 5) & 3;
        const int rl = 4 * q + (co >> 2), x0 = rl & 7;
        const LAS unsigned char* kb = buf + rl * 256 + ((co & 1) << 4);
        const LAS unsigned char* vb = buf + 16384 + rl * 512 + (co & 3) * 8;
        const int ph = (co >> 1) & 1;
#pragma unroll
        for (int ks = 0; ks < 2; ++ks) {
            bf16x8 bfr[2];
#pragma unroll
            for (int ei = 0; ei < 2; ++ei) { const int et = 2 * wave + ei, po = (((et & 7) ^ x0) << 5) + ((et & 8) << 5); bfr[ei] = tr_pair(vb + ks * 32 * 512 + po, vb + ks * 32 * 512 + 16 * 512 + po); }
#pragma unroll
            for (int dt = 0; dt < 8; ++dt) { const int po = (((2 * (dt >> 1) + ph) ^ x0) << 5) + 8 * (dt & 1); const bf16x8 af = tr_pair(kb + ks * 32 * 256 + po, kb + ks * 32 * 256 + 16 * 256 + po);
#pragma unroll
                for (int ei = 0; ei < 2; ++ei) acc[ei][dt] = MFMA16(af, bfr[ei], acc[ei][dt]); }
        }
        if (half == 1) {
            const float g127 = GAMMA127_OF(h);
#pragma unroll
            for (int ei = 0; ei < 2; ++ei) { const int e = 16 * (2 * wave + ei) + c; bf16* dst = kvbuf + ((size_t)unit * 256 + e) * 128 + 8 * q;
#pragma unroll
                for (int j = 0; j < 4; ++j) { const f32x4 a0 = acc[ei][2 * j] * g127, a1 = acc[ei][2 * j + 1] * g127;
                    v4u w; w.x = pk2(a0[0], a0[1]); w.y = pk2(a0[2], a0[3]); w.z = pk2(a1[0], a1[1]); w.w = pk2(a1[2], a1[3]); *(GAS v4u*)(dst + 32 * j) = w;
                    acc[ei][2 * j] = (f32x4){0.f, 0.f, 0.f, 0.f}; acc[ei][2 * j + 1] = (f32x4){0.f, 0.f, 0.f, 0.f}; } }
        }
        asm volatile("s_waitcnt lgkmcnt(0)" ::: "memory"); __builtin_amdgcn_s_barrier(); asm volatile("" ::: "memory");
    }
}

struct Args { const float* in[16]; float* out; unsigned char* ws; int ph_lo, ph_hi; };
__global__ void __launch_bounds__(NWAVES * 64, 2) skel_fwd(Args args) {
    extern __shared__ __attribute__((aligned(16))) unsigned char lds_raw[];
    LAS unsigned char* lds = (LAS unsigned char*)lds_raw;
    volatile LAS unsigned* MISC = (volatile LAS unsigned*)(lds + MISC_OFF);
    const int G = 256, bx = blockIdx.x; __builtin_assume(bx >= 0 && bx < 256);
    const int NGW = G * NWAVES, NGT = G * NWAVES * 64;
#define PH_IDS int tid = threadIdx.x; asm volatile("" : "+v"(tid)); const int lane = tid & 63, wave = __builtin_amdgcn_readfirstlane(tid >> 6), gw = bx * NWAVES + wave, gt = bx * (NWAVES * 64) + tid; int bxp = bx; asm volatile("" : "+s"(bxp)); (void)lane; (void)wave; (void)gw; (void)gt; (void)bxp;
    unsigned char* ws = args.ws;
    gu32* ctl = (gu32*)(ws + WS_CTL);
#if MK_ONE_LAUNCH
    constexpr int lo = 0, hi = N_PHASES;
#else
    const int lo = args.ph_lo, hi = args.ph_hi;
#endif
    if (threadIdx.x < 64) MISC[threadIdx.x] = 0u;
#ifdef PROBE_EPI
    if (threadIdx.x == 0) { ((volatile LAS unsigned long long*)(lds + MISC_OFF + 1024))[0] = 0ull; ((volatile LAS unsigned long long*)(lds + MISC_OFF + 1024))[1] = 0ull; }
#endif
    if (threadIdx.x == 0) { LAS unsigned long long* pt = (LAS unsigned long long*)(lds + MISC_OFF + 512);
#pragma unroll
        for (int i = 0; i < 16; ++i) pt[i] = (unsigned long long)args.in[i];
        pt[16] = (unsigned long long)args.out; pt[17] = (unsigned long long)args.ws; }
    __syncthreads();
    if (hi - lo > 1) (void)xcd_barrier_post((unsigned*)(ctl + CW_BAR), MISC + 8);
#define BAR_NOW() do { XcdBarrier b_; b_.bar = (unsigned*)((gu32*)((unsigned char*)ldptr(17) + WS_CTL) + CW_BAR); b_.x = xb_xcc_id(); b_.st = (volatile LAS unsigned*)(lds + MISC_OFF) + 8; xcd_barrier(b_); } while (0)
#ifndef PHMASK
#define PHMASK 0xFFFF
#endif
#define PHM(b) ((PHMASK >> (b)) & 1)
#ifndef REPMASK
#define REPMASK 0
#endif
#define REP(b) for (int rep_ = 0; rep_ <= ((REPMASK >> (b)) & 1); ++rep_)
#define IN(k) (lo <= (k) && (k) < hi)
#ifdef PROBE_PH
    unsigned long long tprev = __builtin_amdgcn_s_memrealtime(), psum = 0ull;
#define SEAM(k) do { if ((k) + 1 < hi) BAR_NOW(); { const unsigned long long now_ = __builtin_amdgcn_s_memrealtime(); const int ty_ = (k) == 0 ? 0 : ((k) - 1) % PH_PER + 1;     if (ty_ == PROBE_PH) psum += now_ - tprev; tprev = now_; } } while (0)
#else
#define SEAM(k) do { if ((k) + 1 < hi) BAR_NOW(); } while (0)
#endif

    auto ldptr = [&](int i) -> unsigned long long { unsigned ao_ = (unsigned)(MISC_OFF + 512 + 8 * i); asm volatile("" : "+v"(ao_));
        const unsigned long long v = *(const volatile LAS unsigned long long*)(lds + ao_);
        return ((unsigned long long)(unsigned)__builtin_amdgcn_readfirstlane((int)(v >> 32)) << 32) | (unsigned)__builtin_amdgcn_readfirstlane((int)(unsigned)v); };
#define INP(i) ((const float*)ldptr(i))
#define PH_BASE unsigned char* wq = (unsigned char*)ldptr(17);
#define WSP(T, off) ((T*)(wq + (off)))
#define RS_FILL(S_, statp, pmvar, qsp) int pmvar = -1; { pg8::Unit u0_; (void)(S_).next(0, u0_); { pmvar = u0_.pm; int t_ = threadIdx.x; asm volatile("" : "+v"(t_)); if (t_ < 256) { const pg8::f32x4 sv_ = *(const GAS pg8::f32x4*)((statp) + (size_t)(u0_.pm * 256 + t_) * 4); ((LAS float*)(lds + RING_BYTES + 8192))[t_] = __builtin_amdgcn_rsqf(((sv_[0] + sv_[1]) + (sv_[2] + sv_[3])) * (1.0f / 1024.0f) + EPS) * ((qsp) ? ((const GAS float*)(qsp))[u0_.pm * 256 + t_] : 1.0f); } } } __syncthreads();
#define RS_FILLQ(S_, statp, qsp) { pg8::Unit u0_; (void)(S_).next(0, u0_); { int t_ = threadIdx.x; asm volatile("" : "+v"(t_)); const int r_ = u0_.pm * 256 + (t_ & 255); const pg8::f32x4 sv_ = *(const GAS pg8::f32x4*)((statp) + (size_t)r_ * 4); ((LAS float*)(lds + RING_BYTES + 8192))[t_] = __builtin_amdgcn_rsqf(((sv_[0] + sv_[1]) + (sv_[2] + sv_[3])) * (1.0f / 1024.0f) + EPS) * (((qsp) && t_ >= 256) ? ((const GAS float*)(qsp))[r_] : 1.0f); } } __syncthreads();
#define RS_FILL2(S_, statp, pmvar, qsp) int pmvar = -1; { pg8::Unit u0_; (void)(S_).next(0, u0_); { pmvar = u0_.pm; int t_ = threadIdx.x; asm volatile("" : "+v"(t_)); const int pr_ = u0_.pm + 8 * (t_ >> 8); if (pr_ < M / 256) { const pg8::f32x4 sv_ = *(const GAS pg8::f32x4*)((statp) + (size_t)(pr_ * 256 + (t_ & 255)) * 4); ((LAS float*)(lds + RING_BYTES + 8192))[t_] = __builtin_amdgcn_rsqf(((sv_[0] + sv_[1]) + (sv_[2] + sv_[3])) * (1.0f / 1024.0f) + EPS) * ((qsp) ? ((const GAS float*)(qsp))[pr_ * 256 + (t_ & 255)] : 1.0f); } } } __syncthreads();

#define SEL_IN8 ColSel{88, 24, 96, 3, 12}
#define SEL_INB ColSel{96, 0, 24, 1 << 20, 0}
#define WAMAX_P(L_, mi) ((unsigned*)(WSP(unsigned, WS_CTL) + CW_WAMAX + (L_) * 512 + (mi) * 256))
#define CONVERT_A(L_, gwv, ngwv) { LAS float* scr = (LAS float*)(lds + wave * 16384); bf16* wl = WSP(bf16, WS_W) + (size_t)(L_) * W_LAYER; \
        if (PG_I8_P1) p0_amax(INP(2) + (size_t)(L_) * D * DIN, D, DIN, (gwv), (ngwv), lane, 2, INP(1) + (L_) * D, WAMAX_P(L_, 0), SEL_IN8); \
        if (PG_I8_UP) p0_amax(INP(11) + (size_t)(L_) * D * NUP, D, NUP, (gwv), (ngwv), lane, 1, INP(10) + (L_) * D, WAMAX_P(L_, 1), ColSel{NUP / 32, NUP / 32, 0, 1 << 20, 0}); \
        p0_matrix<false>(INP(6) + (size_t)(L_) * 512 * D, 512, D, wl + W_OA, 1536, scr, (gwv), (ngwv), lane, 3, nullptr); \
        p0_matrix<false>(INP(7) + (size_t)(L_) * D * D, D, D, wl + W_OA + 512, 1536, scr, (gwv), (ngwv), lane, 3, nullptr); \
        p0_matrix<false>(INP(14) + (size_t)(L_) * DFF * D, DFF, D, wl + W_DN, DFF, scr, (gwv), (ngwv), lane, 3, nullptr); }
#define CONVERT_B(L_, gwv, ngwv) { LAS float* scr = (LAS float*)(lds + wave * 16384); bf16* wl = WSP(bf16, WS_W) + (size_t)(L_) * W_LAYER; \
        if (PG_I8_P1) { p0_matrix_sel<true>(INP(2) + (size_t)(L_) * D * DIN, D, DIN, wl + W_IN8, D, scr, (gwv), (ngwv), lane, 2, INP(1) + (L_) * D, WAMAX_P(L_, 0), SEL_IN8); \
                        p0_matrix_sel<false>(INP(2) + (size_t)(L_) * D * DIN, D, DIN, wl + W_IN, D, scr, (gwv), (ngwv), lane, 2, INP(1) + (L_) * D, nullptr, SEL_INB); } \
        else p0_matrix<false>(INP(2) + (size_t)(L_) * D * DIN, D, DIN, wl + W_IN, D, scr, (gwv), (ngwv), lane, 2, INP(1) + (L_) * D); \
        if (PG_I8_UP) p0_matrix<true>(INP(11) + (size_t)(L_) * D * NUP, D, NUP, wl + W_UP, D, scr, (gwv), (ngwv), lane, 1, INP(10) + (L_) * D, WAMAX_P(L_, 1)); \
        else p0_matrix<false>(INP(11) + (size_t)(L_) * D * NUP, D, NUP, wl + W_UP, D, scr, (gwv), (ngwv), lane, 1, INP(10) + (L_) * D); \
        p0_matrix<false>(INP(8) + (size_t)(L_) * D * D, D, D, wl + W_O, D, scr, (gwv), (ngwv), lane, 3, nullptr); }
    if (PHM(0) && IN(0)) { PH_IDS PH_BASE
        CONVERT_A(0, gw, NGW)
        float* biastab = WSP(float, WS_BIAS); float* costab = WSP(float, WS_COS); float* sintab = WSP(float, WS_SIN);
        for (int t = gt; t < 1024; t += NGT) { const int head = t >> 7, dist = t & 127;
            int bucket = dist; if (dist >= 16) { bucket = 16 + (int)(log2f((float)dist * (1.0f / 16.0f)) * (16.0f / 3.0f)); bucket = bucket > 31 ? 31 : bucket; }
            ((GAS float*)biastab)[t] = ((const GAS float*)INP(4))[bucket * 8 + head]; }
        for (int t = gt; t < SEQ * 64; t += NGT) { const int pos = t >> 6, i = t & 63;
            const float fr = exp2f(-(float)i * (13.287712379549449f / 64.0f)); const float ang = (float)pos * fr;
            const double kk = rint((double)ang * 0.15915494309189535); const float rr = (float)((double)ang - kk * 6.283185307179586);
            ((GAS float*)costab)[t] = __cosf(rr); ((GAS float*)sintab)[t] = __sinf(rr); }
        xg_rows(INP(0), WSP(bf16, WS_XN), WSP(float, WS_STAT), WSP(signed char, WS_XQ), WSP(float, WS_QS), WSP(float, WS_AMX), gw, NGW, lane);
        xg_rows(INP(0) + (size_t)MH * D, WSP(bf16, WS_XN1), WSP(float, WS_STAT + 256 * 1024), WSP(signed char, WS_XQ) + (size_t)MH * D, WSP(float, WS_QS) + MH, WSP(float, WS_AMX) + (size_t)MH * 4, gw, NGW, lane);
        if (PG_I8_P1 || PG_I8_UP) BAR_NOW();
        CONVERT_B(0, gw, NGW)
        SEAM(0);
    }

    for (int l = 0; l < DEPTH; ++l) {
        const int pl = 1 + l * PH_PER;
#define WL (WSP(bf16, WS_W) + (size_t)l * W_LAYER)
#define XNP WSP(bf16, (hf ? WS_XN1 : WS_XN))
#define STAT_MIX WSP(float, WS_STAT + (size_t)hf * 256 * 1024)
#define STAT_FFN WSP(float, WS_STAT + (size_t)(2 + hf) * 256 * 1024)
#define AMX_MIX (WSP(float, WS_AMX) + (size_t)hf * MH * 4)
#define AMX_FFN (WSP(float, WS_AMX + 512 * 1024) + (size_t)hf * MH * 4)
        for (int hf = 0; hf < 2; ++hf) {
            const int pb = pl + hf * 6;
            const int einst = (l * 2 + hf) * 2;
#ifdef PROBE_XBAR
            if (IN(pb + 0)) { for (int xb_ = 0; xb_ < PROBE_XBAR; ++xb_) BAR_NOW(); }
#endif
            if (PHM(2) && IN(pb + 0)) { PH_BASE
                const float* qsh = PG_I8_P1 ? WSP(float, WS_QS) + (size_t)hf * MH : nullptr;
                if (PG_I8_P1) {
                    pg8::StaticOrder S; S.init(MH, 12 * 256, G, bx);
                    RS_FILLQ(S, STAT_MIX, qsh)
                    { pg8::Gemm g{XNP, WL + W_IN + (size_t)3 * 256 * D, MH, 12 * 256, D};
                      pg8::EpiBf16Rs<false, 0, 3, 0> E{WSP(bf16, WS_RA), DIN, WSP(float, WS_COS), WSP(float, WS_SIN), nullptr};
                      pg8::gemm_phase<pg8::EpiBf16Rs<false, 0, 3, 0>, pg8::StaticOrder, PG_ALIGN_P1, PG_SP2_P1>(lds, g, S, E); }
                    { pg8::StaticOrder S2; S2.init(MH, 11 * 256, G, bx);
                      pg8::Gemm g{(const bf16*)(WSP(signed char, WS_XQ) + (size_t)hf * MH * D), WL + W_IN8, MH, 11 * 256, D / 2};
                      pg8::EpiBf16Rs<true, 3, 12, 256> E{WSP(bf16, WS_RA), DIN, WSP(float, WS_COS), WSP(float, WS_SIN), WAMAX_P(l, 0)};
                      pg8::gemm_phase<pg8::EpiBf16Rs<true, 3, 12, 256>, pg8::StaticOrder, PG_ALIGN_P1, PG_SP2_P1>(lds, g, S2, E); }
                } else {
                    pg8::Gemm g{XNP, WL + W_IN, MH, DIN, D}; pg8::StaticOrder S; S.init(MH, DIN, G, bx);
                    RS_FILLQ(S, STAT_MIX, qsh)
                    pg8::EpiBf16Rs<false, 0, 0, 0> E{WSP(bf16, WS_RA), DIN, WSP(float, WS_COS), WSP(float, WS_SIN), nullptr};
                    pg8::gemm_phase<pg8::EpiBf16Rs<false, 0, 0, 0>, pg8::StaticOrder, PG_ALIGN_P1, PG_SP2_P1>(lds, g, S, E);
                }
                { int bxo = bx; asm volatile("" : "+s"(bxo));
                  if (l + 1 < DEPTH && bxo >= 192) { PH_IDS if (hf == 0) CONVERT_A(l + 1, (bxo - 192) * NWAVES + wave, 512) else CONVERT_B(l + 1, (bxo - 192) * NWAVES + wave, 512) } }
                SEAM(pb + 0);
            }
            if (PHM(3) && IN(pb + 1)) { PH_IDS PH_BASE
                mix_phase(lds, WSP(bf16, WS_RA), WSP(bf16, WS_AOA), WSP(bf16, WS_KV), WSP(float, WS_BIAS), INP(3) + l * 8, bxp, wave, lane);
                SEAM(pb + 1);
            }
            if (PHM(4) && IN(pb + 2)) { PH_IDS PH_BASE scan_phase(WSP(bf16, WS_KV), gt, NGT); SEAM(pb + 2); }
            if (PHM(5) && IN(pb + 3)) { PH_IDS PH_BASE
                ret_phase(lds, WSP(bf16, WS_RA), WSP(bf16, WS_KV), WSP(bf16, WS_AOA), INP(5) + l * 1024, bxp, G, wave, lane);
                SEAM(pb + 3);
            }
            if (PHM(6) && IN(pb + 4)) { PH_BASE
                pg8::Gemm g{WSP(bf16, WS_AOA), WL + W_OA, MH, D, 1536}; pg8::StaticOrder S; S.init(MH, D, G, bx);
                pg8::EpiGate2 E{WSP(bf16, WS_MG), D, WSP(bf16, WS_RA) + C_GA, WSP(bf16, WS_RA) + C_GT, DIN};
                pg8::gemm_phase<pg8::EpiGate2, pg8::StaticOrder, true, true>(lds, g, S, E);
                SEAM(pb + 4);
            }
            if (PHM(7) && IN(pb + 5)) { PH_BASE
                pg8::Gemm g{WSP(bf16, WS_MG), WL + W_O, MH, D, D}; pg8::StaticOrder S; S.init(MH, D, G, bx);
                pg8::PanelRms st{WSP(unsigned, WS_XSLOT), (unsigned*)(WSP(unsigned, WS_CTL) + CW_SEAM + (size_t)einst * 4096), WSP(unsigned, WS_CTL), EPS, 0x700u, AMX_MIX, WSP(float, WS_QS) + (size_t)hf * MH};
                pg8::EpiRmsRes<PG_I8_UP> E{XNP, nullptr, D, INP(9) + l * D, STAT_FFN, WSP(signed char, WS_XQ) + (size_t)hf * MH * D, AMX_FFN, st};
                pg8::gemm_phase<pg8::EpiRmsRes<PG_I8_UP>, pg8::StaticOrder, false, true>(lds, g, S, E);
                if (hf == 1) SEAM(pb + 5);
            }
        }
        if (PHM(9) && IN(pl + 12)) { PH_BASE
            pg8::Gemm g{PG_I8_UP ? (const bf16*)WSP(signed char, WS_XQ) : WSP(bf16, WS_XN), WL + W_UP, M, NUP, PG_I8_UP ? D / 2 : D}; pg8::StaticOrder S; S.init(M, NUP, G, bx);
            const float* qsf = PG_I8_UP ? WSP(float, WS_QS) : nullptr;
            RS_FILL2(S, WSP(float, WS_STAT + 2 * 256 * 1024), pmc, qsf)
#ifdef STAGGER_UP
            {
                const unsigned long long t0_ = __builtin_amdgcn_s_memrealtime(); const unsigned long long dl_ = (unsigned long long)(((bx >> 3) & 3) * STAGGER_UP);
                while (__builtin_amdgcn_s_memrealtime() - t0_ < dl_) __builtin_amdgcn_s_sleep(4);
            }
#endif
            pg8::EpiConv E{WSP(bf16, WS_G), WSP(bf16, WS_H), INP(12) + (size_t)l * 3 * DFF, INP(13) + (size_t)l * DFF, DFF, WSP(float, WS_STAT + 2 * 256 * 1024), EPS, pmc, qsf, WAMAX_P(l, 1)};
            pg8::gemm_phase<pg8::EpiConv, pg8::StaticOrder, PG_ALIGN_UP, true>(lds, g, S, E);
            SEAM(pl + 12);
        }
        for (int hf = 0; hf < 2; ++hf) {
            const int einst = (l * 2 + hf) * 2;
            if (PHM(11) && IN(pl + 13 + hf)) { PH_BASE
                bf16* Gh = WSP(bf16, WS_G) + (size_t)hf * MH * DFF; bf16* Hh = WSP(bf16, WS_H) + (size_t)hf * (MH / 64) * 6 * DFF;
                pg8::Gemm g{Gh, WL + W_DN, MH, D, DFF}; pg8::StaticOrder S; S.init(MH, D, G, bx);
                { pg8::Unit u0; int tf_ = threadIdx.x; asm volatile("" : "+v"(tf_)); (void)S.next(0, u0); conv_fixup(Hh, Gh, INP(12) + (size_t)l * 3 * DFF, INP(13) + (size_t)l * DFF, u0.pm, tf_); }
                asm volatile("s_waitcnt vmcnt(0)" ::: "memory"); __syncthreads();
                pg8::PanelRms st{WSP(unsigned, WS_XSLOT + 512 * 1024), (unsigned*)(WSP(unsigned, WS_CTL) + CW_SEAM + (size_t)(einst + 1) * 4096), WSP(unsigned, WS_CTL), EPS, 0x780u, AMX_FFN, WSP(float, WS_QS) + (size_t)hf * MH};
                pg8::EpiRmsRes<PG_I8_P1> E{XNP, (l + 1 < DEPTH) ? nullptr : (float*)ldptr(16) + (size_t)hf * MH * D, D, INP(15) + l * D, STAT_MIX, WSP(signed char, WS_XQ) + (size_t)hf * MH * D, AMX_MIX, st};
                pg8::gemm_phase<pg8::EpiRmsRes<PG_I8_P1>, pg8::StaticOrder, false, true>(lds, g, S, E);
                if (hf == 1) SEAM(pl + 13 + hf);
            }
        }
    }
#ifdef PROBE_EPI
    if (bx == 0 && threadIdx.x == 0) { const unsigned long long ps_ = ((volatile LAS unsigned long long*)(lds + MISC_OFF + 1024))[PROBE_EPI_MODE]; const unsigned long long t0_ = __builtin_amdgcn_s_memrealtime(); while (__builtin_amdgcn_s_memrealtime() - t0_ < (unsigned long long)PROBE_AMP * ps_) __builtin_amdgcn_s_sleep(8); }
#endif
#ifdef PROBE_PH
    if (bx == 0) { const unsigned long long t0_ = __builtin_amdgcn_s_memrealtime(); while (__builtin_amdgcn_s_memrealtime() - t0_ < (unsigned long long)PROBE_AMP * psum) __builtin_amdgcn_s_sleep(8); }
#endif
#undef IN
#undef SEAM
}

extern "C" void kernel_launch(void* const* d_in, const int* in_sizes, int n_in, void* d_out, int out_size, void* d_ws, size_t ws_size, hipStream_t stream) {
    static int grid = 0;
    if (grid == 0) {
        if (n_in != 16 || in_sizes[0] != M * D || out_size != M * D || ws_size < WS_END) { fprintf(stderr, "kernel_launch: unexpected shapes / workspace (n_in %d, ws %zu < %zu)\n", n_in, ws_size, (size_t)WS_END); grid = -1; return; }
        int dev = 0, cus = 0, per_cu = 0;
        if (hipGetDevice(&dev) != hipSuccess || hipDeviceGetAttribute(&cus, hipDeviceAttributeMultiprocessorCount, dev) != hipSuccess) { grid = -1; return; }
        if (hipFuncSetAttribute((const void*)skel_fwd, hipFuncAttributeMaxDynamicSharedMemorySize, LDS_BYTES) != hipSuccess) { fprintf(stderr, "kernel_launch: hipFuncSetAttribute failed\n"); grid = -1; return; }
        if (hipOccupancyMaxActiveBlocksPerMultiprocessor(&per_cu, (const void*)skel_fwd, NWAVES * 64, LDS_BYTES) != hipSuccess || per_cu < 1) fprintf(stderr, "kernel_launch: occupancy query reports %d\n", per_cu);
        (void)hipGetLastError();
        grid = cus;
        if (grid != 256) { fprintf(stderr, "kernel_launch: this kernel needs exactly 256 CUs (one 256x256 unit per workgroup in the fused-norm GEMM phases), got %d\n", grid); grid = -1; return; }
    }
    if (grid < 0) return;
    (void)hipMemsetAsync((char*)d_ws + WS_CTL, 0, CTL_ZERO_BYTES, stream);
    Args a{};
    for (int i = 0; i < 16; ++i) a.in[i] = (const float*)d_in[i];
    a.out = (float*)d_out; a.ws = (unsigned char*)d_ws;
#if MK_ONE_LAUNCH
    a.ph_lo = 0; a.ph_hi = N_PHASES;
    hipLaunchKernelGGL(skel_fwd, dim3(grid), dim3(NWAVES * 64), LDS_BYTES, stream, a);
#else
    for (int p = 0; p < N_PHASES; ++p) { a.ph_lo = p; a.ph_hi = p + 1; hipLaunchKernelGGL(skel_fwd, dim3(grid), dim3(NWAVES * 64), LDS_BYTES, stream, a); }
#endif
}
```

```cpp
#include <hip/hip_runtime.h>
#include <cstdio>
#include <cstdint>
#include <cmath>
#define MK_ONE_LAUNCH 1
#define PG_ALIGN_P1 true
#define PG_ALIGN_UP true
#define PG_NST 16
#define PG_SP2_P1 true
#define PG_I8_P1 true
#define PG_I8_UP true
#define PG_NT_UP 1
#define PG_NT_P1 1
__device__ __forceinline__ float gsel4(int h, float a, float b, float c, float d) { return h == 0 ? a : (h == 1 ? b : (h == 2 ? c : d)); }
#define GAMMA_OF(h) gsel4((h), 0.96875f, 0.984375f, 0.9921875f, 0.99609375f)
#define LOG2_GAMMA_OF(h) gsel4((h), -0.04580368961312479f, -0.02272007650008353f, -0.011315313227834146f, -0.005646563141142063f)
#define GAMMA127_OF(h) gsel4((h), 0.01773731465374751f, 0.13532968927456346f, 0.3693230522678801f, 0.6083133121044885f)
#define GAMMA128_OF(h) gsel4((h), 0.017183023570817902f, 0.1332151628796484f, 0.3664377159220373f, 0.6059370882290803f)
namespace pg8 {
#define PG8_LAS __attribute__((address_space(3)))
typedef unsigned short bf16_t;
typedef short bf16x8 __attribute__((ext_vector_type(8)));
typedef float f32x4 __attribute__((ext_vector_type(4)));
typedef unsigned u32x4 __attribute__((ext_vector_type(4)));
typedef int i32x4 __attribute__((ext_vector_type(4)));
typedef unsigned u32x2 __attribute__((ext_vector_type(2)));
constexpr int BM = 256, BK = 64, HALF = 128, HTB = HALF * BK * 2  , STAGE_BYTES = 8 * HTB, NXCD = 8, WGM = 8;

__host__ __device__ __forceinline__ int lds_byte(int r, int c) { const int st = (r >> 4) * 2 + (c >> 5), rr = r & 15, cc = c & 31, ob = rr * 64 + cc * 2; return st * 1024 + (ob ^ (((ob >> 9) & 1) << 5)); }
__host__ __device__ __forceinline__ void stage_rc(int b, int& R, int& C) { const int st = b / 1024, sb = b % 1024, swz = sb ^ (((sb >> 9) & 1) << 5); R = (st >> 1) * 16 + swz / 64; C = (st & 1) * 32 + (swz % 64) / 2; }
__host__ __device__ __forceinline__ int perm32(int rho) { const int n = rho >> 4, i = rho & 15; return 8 * (i >> 2) + 4 * n + (i & 3); }

struct Unit { int pm, pn; };
struct Gemm { const bf16_t* A; const bf16_t* Bt; int M, N, K; };

struct StaticOrder {
    int nM, nN, nwg, G, c;
    __host__ __device__ __forceinline__ void init(int M, int N, int G_, int c_) { nM = M / BM; nN = N / BM; nwg = nM * nN; G = G_; c = c_; }
    __host__ __device__ __forceinline__ bool next(int i, Unit& u) const {
        const long L = (long)i * G + c; if (L >= nwg) return false;
        int wgid = (int)L; { const int q = nwg / NXCD, r = nwg % NXCD, xcd = wgid % NXCD, off = wgid / NXCD; wgid = (xcd < r ? xcd * (q + 1) : r * (q + 1) + (xcd - r) * q) + off; }
        const int nig = WGM * nN, gid = wgid / nig, fm = gid * WGM, gsz = (nM - fm) < WGM ? (nM - fm) : WGM;
        u.pm = fm + ((wgid % nig) % gsz); u.pn = (wgid % nig) / gsz; return true;
    }
    __device__ __forceinline__ void a_ready(const Unit&) const {}
    __device__ __forceinline__ void done(const Unit&) const {}
};

__device__ __forceinline__ unsigned cvt_pk_bf16(float lo, float hi) { unsigned r; asm volatile("v_cvt_pk_bf16_f32 %0, %1, %2" : "=v"(r) : "v"(lo), "v"(hi)); return r; }
typedef float f32x2 __attribute__((ext_vector_type(2)));
__device__ __forceinline__ f32x2 gelu_pk(f32x2 v) {
    const f32x2 av = __builtin_elementwise_abs(v), d = av * 0.2316418882f + 1.0f;
    f32x2 t; t.x = __builtin_amdgcn_rcpf(d.x); t.y = __builtin_amdgcn_rcpf(d.y);
    f32x2 q = t * 0.5307027145f + (-0.7265760135f); q = q * t + 0.7107068705f; q = q * t + (-0.142248368f); q = q * t + 0.127414796f; q = q * t;
    const f32x2 s = (v * v) * (-0.72134752044f);
    f32x2 e; e.x = __builtin_amdgcn_exp2f(s.x); e.y = __builtin_amdgcn_exp2f(s.y);
    const f32x2 m = v * (q * e), r = v - m;
    f32x2 o; o.x = v.x < 0.f ? m.x : r.x; o.y = v.y < 0.f ? m.y : r.y; return o;
}

template <int ACT  > struct EpiBf16 {
    static constexpr bool PERM = true, AFTER_DRAIN = false, HAS_MID = false, I8 = false; static constexpr int MID_T = -1, NST = 0, PID = 0; static constexpr bool HAS_PRE = false; struct PreT {}; __device__ __forceinline__ PreT pre(const Unit&, int, int) const { return PreT{}; } static_assert(ACT == 0 || ACT == 1, "EpiBf16: ACT is 0 (none) or 1 (gelu_pk)");
    bf16_t* O; int ldc; const float* bias; int split_cols; size_t split_stride; float scale0;
    __device__ __forceinline__ void operator()(const f32x4 (&acc)[2][2][4][2], const Unit& u, int wr, int wc, int fr, int fq) const {
        const int row0 = u.pm * BM + wr * 64 + fr; int colt = u.pn * BM; bf16_t* base = O;
        float sc = 1.f; if (split_cols) { const int t = colt / split_cols; base += (size_t)t * split_stride; colt -= t * split_cols; if (t == 0) sc = scale0; }
        const int col0 = colt + wc * 32 + 8 * fq, bcol0 = u.pn * BM + wc * 32 + 8 * fq;
        f32x4 bv[2][2];
#pragma unroll
        for (int bj = 0; bj < 2; ++bj)
#pragma unroll
            for (int n = 0; n < 2; ++n) bv[bj][n] = bias ? *(const f32x4*)(bias + bcol0 + bj * HALF + 4 * n) : (f32x4){0.f, 0.f, 0.f, 0.f};
#pragma unroll
        for (int ai = 0; ai < 2; ++ai)
#pragma unroll
            for (int m = 0; m < 4; ++m) { bf16_t* rowp = base + (size_t)(row0 + ai * HALF + m * 16) * ldc + col0;
#pragma unroll
                for (int bj = 0; bj < 2; ++bj) { f32x4 v0 = acc[ai][bj][m][0] + bv[bj][0], v1 = acc[ai][bj][m][1] + bv[bj][1];
                    if (ACT == 1) { f32x2 a = gelu_pk((f32x2){v0[0], v0[1]}), b = gelu_pk((f32x2){v0[2], v0[3]}), c = gelu_pk((f32x2){v1[0], v1[1]}), d = gelu_pk((f32x2){v1[2], v1[3]});
                        v0 = (f32x4){a.x, a.y, b.x, b.y}; v1 = (f32x4){c.x, c.y, d.x, d.y}; }
                    v0 = v0 * sc; v1 = v1 * sc; u32x4 w; w.x = cvt_pk_bf16(v0[0], v0[1]); w.y = cvt_pk_bf16(v0[2], v0[3]); w.z = cvt_pk_bf16(v1[0], v1[1]); w.w = cvt_pk_bf16(v1[2], v1[3]);
                    *(u32x4*)(rowp + bj * HALF) = w; } }
    }
};

template <class Epi, class Sched, bool ALIGN_EPI = false, bool SP2 = false>
__device__ __forceinline__ void gemm_phase(PG8_LAS unsigned char* lds, const Gemm g, const Sched& S, const Epi& E) {
    int tid_o = threadIdx.x; asm volatile("" : "+v"(tid_o));
    const int tid = tid_o, wid = __builtin_amdgcn_readfirstlane(tid >> 6), lane = tid & 63, wr = wid >> 2, wc = wid & 3, fr = lane & 15, fq = lane >> 4;
    const int K = g.K, nt = K / BK;
    unsigned voffA[2], voffB[2];
#pragma unroll
    for (int i = 0; i < 2; ++i) { int R, C; stage_rc(tid * 16 + i * 8192, R, C); const int Rb = Epi::PERM ? ((R & ~31) + perm32(R & 31)) : R;
        voffA[i] = (unsigned)(R * K + C) * 2u; voffB[i] = (unsigned)(Rb * K + C) * 2u; }
    const size_t kstep = (size_t)(BK * 2);
    const size_t hstep = (size_t)HALF * K * 2;
    const size_t tstep = 2 * hstep;
    const unsigned ldsw = (unsigned)wid * 1024u;
    const int aoff = lds_byte(wr * 64 + fr, fq * 8), boff = lds_byte(wc * 32 + fr, fq * 8);
#define PG8_SA(b, h) (((b) * 2 + (h)) * HTB)
#define PG8_SB(b, h) ((4 + (b) * 2 + (h)) * HTB)
#define PG8_STAGE(bufoff, gbase, voff) do { _Pragma("unroll") for (int _i = 0; _i < 2; ++_i) \
        __builtin_amdgcn_global_load_lds((const unsigned*)((const char*)(gbase) + (voff)[_i]), (PG8_LAS unsigned*)(lds + (bufoff) + ldsw + _i * 8192), 16, 0, 0); } while (0)
#define PG8_LDA(dst, b, h) do { _Pragma("unroll") for (int m = 0; m < 4; ++m) _Pragma("unroll") for (int k = 0; k < 2; ++k) dst[m][k] = *(const PG8_LAS bf16x8*)(lds + PG8_SA(b, h) + aoff + m * 2048 + k * 1024); } while (0)
#define PG8_LDB(dst, b, h) do { _Pragma("unroll") for (int n = 0; n < 2; ++n) _Pragma("unroll") for (int k = 0; k < 2; ++k) dst[n][k] = *(const PG8_LAS bf16x8*)(lds + PG8_SB(b, h) + boff + n * 2048 + k * 1024); } while (0)
#define PG8_MMA(ai, bj, At, Bt) do { __builtin_amdgcn_s_setprio(1); _Pragma("unroll") for (int m = 0; m < 4; ++m) _Pragma("unroll") for (int n = 0; n < 2; ++n) _Pragma("unroll") for (int k = 0; k < 2; ++k) \
        { if constexpr (Epi::I8) acc[ai][bj][m][n] = __builtin_bit_cast(f32x4, __builtin_amdgcn_mfma_i32_16x16x64_i8(__builtin_bit_cast(i32x4, Bt[n][k]), __builtin_bit_cast(i32x4, At[m][k]), __builtin_bit_cast(i32x4, acc[ai][bj][m][n]), 0, 0, 0)); \
          else acc[ai][bj][m][n] = __builtin_amdgcn_mfma_f32_16x16x32_bf16(Bt[n][k], At[m][k], acc[ai][bj][m][n], 0, 0, 0); } __builtin_amdgcn_s_setprio(0); } while (0)
#define PG8_WAIT_V(n) asm volatile("s_waitcnt vmcnt(" #n ")" ::: "memory")
#define PG8_WAIT_L(n) asm volatile("s_waitcnt lgkmcnt(" #n ")" ::: "memory")
#define PG8_BAR __builtin_amdgcn_s_barrier()
#define PG8_SCHED __builtin_amdgcn_sched_barrier(0)
    Unit cur, nxt; int ui = 0;
    if (!S.next(0, cur)) return;
#ifdef PROBE_EPI
    unsigned long long pe_prev = __builtin_amdgcn_s_memrealtime();
#endif
    f32x4 acc[2][2][4][2];
#pragma unroll
    for (int a = 0; a < 2; ++a)
#pragma unroll
        for (int b = 0; b < 2; ++b)
#pragma unroll
            for (int m = 0; m < 4; ++m)
#pragma unroll
                for (int n = 0; n < 2; ++n) acc[a][b][m][n] = (f32x4){0.f, 0.f, 0.f, 0.f};
    bf16x8 At[4][2], B0[2][2], B1[2][2];
    const char* cA = (const char*)g.A + (size_t)cur.pm * tstep; const char* cB = (const char*)g.Bt + (size_t)cur.pn * tstep;
    S.a_ready(cur);
    if constexpr (SP2) {
        PG8_STAGE(PG8_SB(0, 0), cB, voffB); PG8_STAGE(PG8_SB(0, 1), cB + hstep, voffB); PG8_STAGE(PG8_SA(0, 0), cA, voffA); PG8_STAGE(PG8_SA(0, 1), cA + hstep, voffA);
        if (wr == 1) PG8_BAR;
        PG8_WAIT_V(2); PG8_BAR;
        PG8_STAGE(PG8_SB(1, 0), cB + kstep, voffB); PG8_STAGE(PG8_SA(1, 0), cA + kstep, voffA); PG8_STAGE(PG8_SB(1, 1), cB + hstep + kstep, voffB);
        PG8_WAIT_V(6); PG8_BAR;
    } else {
        PG8_STAGE(PG8_SB(0, 0), cB, voffB); PG8_STAGE(PG8_SA(0, 0), cA, voffA); PG8_STAGE(PG8_SB(0, 1), cB + hstep, voffB); PG8_STAGE(PG8_SA(0, 1), cA + hstep, voffA);
        if (wr == 1) PG8_BAR;
        PG8_WAIT_V(4); PG8_BAR;
        PG8_STAGE(PG8_SB(1, 0), cB + kstep, voffB); PG8_STAGE(PG8_SA(1, 0), cA + kstep, voffA); PG8_STAGE(PG8_SB(1, 1), cB + hstep + kstep, voffB);
        PG8_WAIT_V(6); PG8_BAR;
    }
#ifndef PG8_EARLY
#define PG8_EARLY PG8_STAGE(PG8_SA(1, 1), nA + kstep + hstep, voffA);
#endif
    int fresh = 0;
    for (;;) {
        const bool has_next = S.next(ui + 1, nxt);
        const char* nA = has_next ? (const char*)g.A + (size_t)nxt.pm * tstep : cA; const char* nB = has_next ? (const char*)g.Bt + (size_t)nxt.pn * tstep : cB;
        for (int t = 0; t < nt; t += 2) {
            const bool last = (t == nt - 2);
            const char* a1 = cA + (size_t)(t + 1) * kstep;
            const char* a2 = last ? nA : cA + (size_t)(t + 2) * kstep; const char* b2 = last ? nB : cB + (size_t)(t + 2) * kstep;
            const char* a3 = a2 + kstep; const char* b3 = b2 + kstep;
            if (last && has_next) S.a_ready(nxt);
            if constexpr (SP2) {
            int fresh_now = 0;
            if constexpr (Epi::NST != 0) { int tt = t; asm volatile("" : "+s"(tt)); fresh_now = (tt == 0) ? fresh : 0; }
#define PG8_WAIT_VF() do { static_assert(Epi::NST == 0 || Epi::NST == 14 || Epi::NST == 16, "NST"); \
        if constexpr (Epi::NST == 16) asm volatile("s_waitcnt vmcnt(24)\n\ts_cmp_lg_u32 %0, 0\n\ts_cbranch_scc1 .Lpg8f%=\n\ts_waitcnt vmcnt(8)\n.Lpg8f%=:" :: "s"(fresh_now) : "memory", "scc"); \
        else if constexpr (Epi::NST == 14) asm volatile("s_waitcnt vmcnt(22)\n\ts_cmp_lg_u32 %0, 0\n\ts_cbranch_scc1 .Lpg8g%=\n\ts_waitcnt vmcnt(8)\n.Lpg8g%=:" :: "s"(fresh_now) : "memory", "scc"); \
        else PG8_WAIT_V(8); } while (0)
            PG8_LDB(B0, 0, 0); PG8_LDB(B1, 0, 1); PG8_SCHED; PG8_LDA(At, 0, 0); PG8_STAGE(PG8_SA(1, 1), a1 + hstep, voffA);
            PG8_WAIT_VF(); PG8_WAIT_L(0); PG8_BAR; PG8_MMA(0, 0, At, B0); PG8_MMA(0, 1, At, B1); PG8_BAR; PG8_SCHED;
            PG8_LDA(At, 0, 1); PG8_STAGE(PG8_SB(0, 0), b2, voffB); PG8_STAGE(PG8_SB(0, 1), b2 + hstep, voffB); PG8_STAGE(PG8_SA(0, 0), a2, voffA);
            PG8_WAIT_VF(); PG8_WAIT_L(0); PG8_BAR; PG8_MMA(1, 0, At, B0); PG8_MMA(1, 1, At, B1); PG8_BAR; PG8_SCHED;
            PG8_LDB(B0, 1, 0); PG8_LDB(B1, 1, 1); PG8_SCHED; PG8_LDA(At, 1, 0); PG8_STAGE(PG8_SA(0, 1), a2 + hstep, voffA);
            PG8_WAIT_VF(); PG8_WAIT_L(0); PG8_BAR; PG8_MMA(0, 0, At, B0); PG8_MMA(0, 1, At, B1); PG8_BAR; PG8_SCHED;
            PG8_LDA(At, 1, 1); PG8_STAGE(PG8_SB(1, 0), b3, voffB); PG8_STAGE(PG8_SB(1, 1), b3 + hstep, voffB); PG8_STAGE(PG8_SA(1, 0), a3, voffA);
            PG8_WAIT_V(8); PG8_WAIT_L(0); PG8_BAR; PG8_MMA(1, 0, At, B0); PG8_MMA(1, 1, At, B1); PG8_BAR; PG8_SCHED;
#undef PG8_WAIT_VF
            } else {
            PG8_LDB(B0, 0, 0); PG8_SCHED; PG8_LDA(At, 0, 0); PG8_STAGE(PG8_SA(1, 1), a1 + hstep, voffA);
            PG8_WAIT_L(8); PG8_BAR; PG8_WAIT_L(0); PG8_MMA(0, 0, At, B0); PG8_BAR; PG8_SCHED;
            PG8_LDB(B1, 0, 1); PG8_STAGE(PG8_SB(0, 0), b2, voffB);
            PG8_BAR; PG8_WAIT_L(0); PG8_MMA(0, 1, At, B1); PG8_BAR;
            PG8_LDA(At, 0, 1); PG8_STAGE(PG8_SA(0, 0), a2, voffA);
            PG8_BAR; PG8_WAIT_L(0); PG8_MMA(1, 0, At, B0); PG8_BAR; PG8_SCHED;
            PG8_STAGE(PG8_SB(0, 1), b2 + hstep, voffB);
            PG8_WAIT_V(6); PG8_BAR; PG8_MMA(1, 1, At, B1); PG8_BAR;
            PG8_LDB(B0, 1, 0); PG8_SCHED; PG8_LDA(At, 1, 0); PG8_STAGE(PG8_SA(0, 1), a2 + hstep, voffA);
            PG8_WAIT_L(8); PG8_BAR; PG8_WAIT_L(0); PG8_MMA(0, 0, At, B0); PG8_BAR; PG8_SCHED;
            PG8_LDB(B1, 1, 1); PG8_STAGE(PG8_SB(1, 0), b3, voffB);
            PG8_BAR; PG8_WAIT_L(0); PG8_MMA(0, 1, At, B1); PG8_BAR;
            PG8_LDA(At, 1, 1); PG8_STAGE(PG8_SA(1, 0), a3, voffA);
            PG8_BAR; PG8_WAIT_L(0); PG8_MMA(1, 0, At, B0); PG8_BAR; PG8_SCHED;
            PG8_STAGE(PG8_SB(1, 1), b3 + hstep, voffB);
            PG8_WAIT_V(6); PG8_BAR; PG8_MMA(1, 1, At, B1); PG8_BAR;
            }
            if constexpr (Epi::HAS_MID) { if (t == Epi::MID_T) E.mid(acc, cur, wr, wc, fr, fq); }
        }
#ifdef PROBE_EPI
        const unsigned long long pe_t0 = __builtin_amdgcn_s_memrealtime();
#endif
        [[maybe_unused]] const typename Epi::PreT pf_ = E.pre(cur, wc, fq);
        if constexpr (ALIGN_EPI) { if (wr == 0) PG8_BAR; }
        if constexpr (SP2 && ALIGN_EPI && Epi::NST != 0) { PG8_EARLY fresh = 1; }
        if constexpr (Epi::I8) {
#pragma unroll
            for (int a = 0; a < 2; ++a)
#pragma unroll
                for (int b = 0; b < 2; ++b)
#pragma unroll
                    for (int m = 0; m < 4; ++m)
#pragma unroll
                        for (int n = 0; n < 2; ++n) acc[a][b][m][n] = __builtin_convertvector(__builtin_bit_cast(i32x4, acc[a][b][m][n]), f32x4);
        }
        if constexpr (!Epi::AFTER_DRAIN) { if constexpr (Epi::HAS_PRE) E(acc, cur, wr, wc, fr, fq, pf_); else E(acc, cur, wr, wc, fr, fq); S.done(cur); }
#ifdef PROBE_EPI
        if constexpr (Epi::PID == PROBE_EPI) { const unsigned long long now_ = __builtin_amdgcn_s_memrealtime();
            if (tid == 0) { volatile PG8_LAS unsigned long long* pa_ = (volatile PG8_LAS unsigned long long*)(lds + 143360 + 1024); pa_[0] += now_ - pe_t0; pa_[1] += now_ - pe_prev; }
            pe_prev = now_; }
#endif
        if (!has_next) break;
#pragma unroll
        for (int a = 0; a < 2; ++a)
#pragma unroll
            for (int b = 0; b < 2; ++b)
#pragma unroll
                for (int m = 0; m < 4; ++m)
#pragma unroll
                    for (int n = 0; n < 2; ++n) acc[a][b][m][n] = (f32x4){0.f, 0.f, 0.f, 0.f};
        cur = nxt; cA = nA; cB = nB; ++ui;
        if constexpr (ALIGN_EPI) { if (wr == 1) PG8_BAR; }
    }
    PG8_WAIT_V(0);
    if constexpr (!ALIGN_EPI) { if (wr == 0) PG8_BAR; }
    PG8_BAR;
    if constexpr (Epi::AFTER_DRAIN) { E.fused(acc, cur, wr, wc, fr, fq, lds, wid, lane); S.done(cur); }
#undef PG8_SA
#undef PG8_SB
#undef PG8_STAGE
#undef PG8_LDA
#undef PG8_LDB
#undef PG8_MMA
#undef PG8_WAIT_V
#undef PG8_WAIT_L
#undef PG8_BAR
#undef PG8_SCHED
}
}
namespace pg8 {
#define PG8_GAS __attribute__((address_space(1)))
#ifdef PG_NT_P1
#define ST16(p, v) __builtin_nontemporal_store((v), (PG8_GAS u32x4*)(p))
#else
#define ST16(p, v) (*(PG8_GAS u32x4*)(p) = (v))
#endif
constexpr int RSL_OFF = 131072 + 8192;
__device__ __forceinline__ const PG8_LAS float* rs_lds() { extern __shared__ __attribute__((aligned(16))) unsigned char lds_dyn_[]; return (const PG8_LAS float*)((PG8_LAS unsigned char*)lds_dyn_ + RSL_OFF); }
__device__ __forceinline__ void pair_swap(const u32x4 w0, const u32x4 w1, int odd, u32x4& dA, u32x4& dB) {
    const u32x4 snd = odd ? w0 : w1; u32x4 rcv;
    rcv.x = (unsigned)__builtin_amdgcn_update_dpp(0, (int)snd.x, 0xB1, 0xf, 0xf, false); rcv.y = (unsigned)__builtin_amdgcn_update_dpp(0, (int)snd.y, 0xB1, 0xf, 0xf, false);
    rcv.z = (unsigned)__builtin_amdgcn_update_dpp(0, (int)snd.z, 0xB1, 0xf, 0xf, false); rcv.w = (unsigned)__builtin_amdgcn_update_dpp(0, (int)snd.w, 0xB1, 0xf, 0xf, false);
    dA = odd ? rcv : w0; dB = odd ? w1 : rcv;
}
__device__ __forceinline__ float bfbits2f(unsigned b16) { return __uint_as_float(b16 << 16); }
__device__ __forceinline__ float sigmoidf_(float x) { return __builtin_amdgcn_rcpf(1.0f + __builtin_amdgcn_exp2f(x * -1.4426950408889634f)); }
struct EpiGateA {
    static constexpr bool PERM = true, AFTER_DRAIN = false, HAS_MID = false, I8 = false; static constexpr int MID_T = -1, NST = 0, PID = 0; static constexpr bool HAS_PRE = false; struct PreT {}; __device__ __forceinline__ PreT pre(const Unit&, int, int) const { return PreT{}; }
    bf16_t* O; int ldc; const bf16_t* gate; int ldg;
    __device__ __forceinline__ void operator()(const f32x4 (&acc)[2][2][4][2], const Unit& u, int wr, int wc, int fr, int fq) const {
        const int row0 = u.pm * BM + wr * 64 + fr, col0 = u.pn * BM + wc * 32 + 8 * fq;
#pragma unroll
        for (int ai = 0; ai < 2; ++ai)
#pragma unroll
            for (int m = 0; m < 4; ++m) { const size_t r = (size_t)(row0 + ai * HALF + m * 16);
#pragma unroll
                for (int bj = 0; bj < 2; ++bj) { const int c = col0 + bj * HALF;
                    const u32x4 gv = *(const PG8_GAS u32x4*)(gate + r * ldg + c);
                    const f32x4 v0 = acc[ai][bj][m][0], v1 = acc[ai][bj][m][1];
                    float o[8];
                    o[0] = v0[0] * sigmoidf_(bfbits2f(gv.x & 0xffffu)); o[1] = v0[1] * sigmoidf_(bfbits2f(gv.x >> 16));
                    o[2] = v0[2] * sigmoidf_(bfbits2f(gv.y & 0xffffu)); o[3] = v0[3] * sigmoidf_(bfbits2f(gv.y >> 16));
                    o[4] = v1[0] * sigmoidf_(bfbits2f(gv.z & 0xffffu)); o[5] = v1[1] * sigmoidf_(bfbits2f(gv.z >> 16));
                    o[6] = v1[2] * sigmoidf_(bfbits2f(gv.w & 0xffffu)); o[7] = v1[3] * sigmoidf_(bfbits2f(gv.w >> 16));
                    u32x4 w; w.x = cvt_pk_bf16(o[0], o[1]); w.y = cvt_pk_bf16(o[2], o[3]); w.z = cvt_pk_bf16(o[4], o[5]); w.w = cvt_pk_bf16(o[6], o[7]);
                    *(PG8_GAS u32x4*)(O + r * ldc + c) = w; }
                if (m == 3) asm volatile("" ::: "memory"); }
    }
};
struct EpiGateR {
    static constexpr bool PERM = true, AFTER_DRAIN = false, HAS_MID = false, I8 = false; static constexpr int MID_T = -1, NST = 0, PID = 0; static constexpr bool HAS_PRE = false; struct PreT {}; __device__ __forceinline__ PreT pre(const Unit&, int, int) const { return PreT{}; }
    bf16_t* O; int ldc; const bf16_t* gate; int ldg;
    __device__ __forceinline__ void operator()(const f32x4 (&acc)[2][2][4][2], const Unit& u, int wr, int wc, int fr, int fq) const {
        const int row0 = u.pm * BM + wr * 64 + fr, col0 = u.pn * BM + wc * 32 + 8 * fq;
#pragma unroll
        for (int ai = 0; ai < 2; ++ai)
#pragma unroll
            for (int m = 0; m < 4; ++m) { const size_t r = (size_t)(row0 + ai * HALF + m * 16);
#pragma unroll
                for (int bj = 0; bj < 2; ++bj) { const int c = col0 + bj * HALF;
                    const u32x4 gv = *(const PG8_GAS u32x4*)(gate + r * ldg + c);
                    const u32x4 tv = *(const PG8_GAS u32x4*)(O + r * ldc + c);
                    const f32x4 v0 = acc[ai][bj][m][0], v1 = acc[ai][bj][m][1];
                    float o[8];
                    o[0] = bfbits2f(tv.x & 0xffffu) + v0[0] * sigmoidf_(bfbits2f(gv.x & 0xffffu)); o[1] = bfbits2f(tv.x >> 16) + v0[1] * sigmoidf_(bfbits2f(gv.x >> 16));
                    o[2] = bfbits2f(tv.y & 0xffffu) + v0[2] * sigmoidf_(bfbits2f(gv.y & 0xffffu)); o[3] = bfbits2f(tv.y >> 16) + v0[3] * sigmoidf_(bfbits2f(gv.y >> 16));
                    o[4] = bfbits2f(tv.z & 0xffffu) + v1[0] * sigmoidf_(bfbits2f(gv.z & 0xffffu)); o[5] = bfbits2f(tv.z >> 16) + v1[1] * sigmoidf_(bfbits2f(gv.z >> 16));
                    o[6] = bfbits2f(tv.w & 0xffffu) + v1[2] * sigmoidf_(bfbits2f(gv.w & 0xffffu)); o[7] = bfbits2f(tv.w >> 16) + v1[3] * sigmoidf_(bfbits2f(gv.w >> 16));
                    u32x4 w; w.x = cvt_pk_bf16(o[0], o[1]); w.y = cvt_pk_bf16(o[2], o[3]); w.z = cvt_pk_bf16(o[4], o[5]); w.w = cvt_pk_bf16(o[6], o[7]);
                    *(PG8_GAS u32x4*)(O + r * ldc + c) = w; }
                if (m == 3) asm volatile("" ::: "memory"); }
    }
};
struct EpiF32 {
    static constexpr bool PERM = true, AFTER_DRAIN = false, HAS_MID = false, I8 = false; static constexpr int MID_T = -1, NST = 0, PID = 0; static constexpr bool HAS_PRE = false; struct PreT {}; __device__ __forceinline__ PreT pre(const Unit&, int, int) const { return PreT{}; }
    float* O; int ldc;
    __device__ __forceinline__ void operator()(const f32x4 (&acc)[2][2][4][2], const Unit& u, int wr, int wc, int fr, int fq) const {
        const int row0 = u.pm * BM + wr * 64 + fr, col0 = u.pn * BM + wc * 32 + 8 * fq;
#pragma unroll
        for (int ai = 0; ai < 2; ++ai)
#pragma unroll
            for (int m = 0; m < 4; ++m) { float* rowp = O + (size_t)(row0 + ai * HALF + m * 16) * ldc + col0;
#pragma unroll
                for (int bj = 0; bj < 2; ++bj) { *(PG8_GAS f32x4*)(rowp + bj * HALF) = acc[ai][bj][m][0]; *(PG8_GAS f32x4*)(rowp + bj * HALF + 4) = acc[ai][bj][m][1]; } }
    }
};

__device__ __forceinline__ float dpp_f(float v, int ctrl_sel) {
    const int iv = __builtin_bit_cast(int, v); int r;
    switch (ctrl_sel) { case 0: r = __builtin_amdgcn_update_dpp(0, iv, 0x111, 0xf, 0xf, true); break;
                        case 1: r = __builtin_amdgcn_update_dpp(0, iv, 0x112, 0xf, 0xf, true); break;
                        case 2: r = __builtin_amdgcn_update_dpp(0, iv, 0x10F, 0xf, 0xf, true); break;
                        default: r = __builtin_amdgcn_update_dpp(0, iv, 0x10E, 0xf, 0xf, true); break; }
    return __builtin_bit_cast(float, r);
}
__device__ __forceinline__ float gelu_tanh_f(float x) { const float u2 = 1.5957691216057308f * (x + 0.044715f * x * x * x); return x * __builtin_amdgcn_rcpf(1.0f + __expf(-u2)); }
struct EpiConv {
    static constexpr bool PERM = true, AFTER_DRAIN = false, HAS_MID = false, I8 = PG_I8_UP; static constexpr int MID_T = -1, NST = PG_NST ? 14 : 0  , PID = 1;
    bf16_t* G; bf16_t* H; const float* cw; const float* cb; int dff; const float* stat; float eps; int pmc;
    const float* qs; const unsigned* wsc;
    struct PreT { f32x4 a[2], b[2], c[2], d[2]; float ts0, ts1; };
    static constexpr bool HAS_PRE = true;
    __device__ __forceinline__ PreT pre(const Unit& u, int wc, int fq) const {
        const int colb = u.pn * HALF + wc * 32 + 8 * fq; PreT p; p.ts0 = 1.0f; p.ts1 = 1.0f;
        if constexpr (I8) { p.ts0 = __uint_as_float(((const PG8_GAS unsigned*)wsc)[u.pn * 8 + wc]) * (1.0f / 127.0f); p.ts1 = __uint_as_float(((const PG8_GAS unsigned*)wsc)[u.pn * 8 + 4 + wc]) * (1.0f / 127.0f); }
#pragma unroll
        for (int h = 0; h < 2; ++h) { p.a[h] = *(const PG8_GAS f32x4*)(cw + colb + 4 * h); p.b[h] = *(const PG8_GAS f32x4*)(cw + dff + colb + 4 * h); p.c[h] = *(const PG8_GAS f32x4*)(cw + 2 * dff + colb + 4 * h); p.d[h] = *(const PG8_GAS f32x4*)(cb + colb + 4 * h); }
        return p;
    }
    __device__ __forceinline__ void operator()(const f32x4 (&acc)[2][2][4][2], const Unit& u, int wr, int wc, int fr, int fq, const PreT& pf) const {
        const int colb = u.pn * HALF + wc * 32 + 8 * fq;
        const float ts0 = pf.ts0, ts1 = pf.ts1;
        f32x2 w02[4], w12[4], w22[4], wb2[4];
#pragma unroll
        for (int h = 0; h < 2; ++h) { const f32x4 a = pf.a[h], b = pf.b[h], c = pf.c[h], d = pf.d[h];
            w02[2 * h] = (f32x2){a[0], a[1]}; w02[2 * h + 1] = (f32x2){a[2], a[3]}; w12[2 * h] = (f32x2){b[0], b[1]}; w12[2 * h + 1] = (f32x2){b[2], b[3]};
            w22[2 * h] = (f32x2){c[0], c[1]}; w22[2 * h + 1] = (f32x2){c[2], c[3]}; wb2[2 * h] = (f32x2){d[0], d[1]}; wb2[2 * h + 1] = (f32x2){d[2], d[3]}; }
#pragma unroll
        for (int ai = 0; ai < 2; ++ai) {
            const int row64 = u.pm * BM + ai * HALF + wr * 64, grp = row64 >> 6;
            float rsc[4];
            {
                const int tb_ = (u.pm == pmc) ? 0 : 256;
#pragma unroll
                for (int m = 0; m < 4; ++m) rsc[m] = rs_lds()[tb_ + ((row64 + m * 16 + fr) & 255)];
            }
            float rsv[4];
#pragma unroll
            for (int m = 0; m < 4; ++m) { rsv[m] = rsc[m] * ts1; rsc[m] *= ts0; }
            if (fr >= 14) { const f32x4 v0 = acc[ai][0][3][0] * rsc[3], v1 = acc[ai][0][3][1] * rsc[3]; u32x4 w; w.x = cvt_pk_bf16(v0[0], v0[1]); w.y = cvt_pk_bf16(v0[2], v0[3]); w.z = cvt_pk_bf16(v1[0], v1[1]); w.w = cvt_pk_bf16(v1[2], v1[3]);
                *(PG8_GAS u32x4*)(H + (size_t)(grp * 6 + (fr - 14)) * dff + colb) = w; }
            if (fr < 2) { const f32x4 v0 = acc[ai][0][0][0] * rsc[0], v1 = acc[ai][0][0][1] * rsc[0], x0 = acc[ai][1][0][0] * rsv[0], x1 = acc[ai][1][0][1] * rsv[0]; u32x4 w, x;
                w.x = cvt_pk_bf16(v0[0], v0[1]); w.y = cvt_pk_bf16(v0[2], v0[3]); w.z = cvt_pk_bf16(v1[0], v1[1]); w.w = cvt_pk_bf16(v1[2], v1[3]);
                x.x = cvt_pk_bf16(x0[0], x0[1]); x.y = cvt_pk_bf16(x0[2], x0[3]); x.z = cvt_pk_bf16(x1[0], x1[1]); x.w = cvt_pk_bf16(x1[2], x1[3]);
                *(PG8_GAS u32x4*)(H + (size_t)(grp * 6 + 2 + fr) * dff + colb) = w; *(PG8_GAS u32x4*)(H + (size_t)(grp * 6 + 4 + fr) * dff + colb) = x; }
            f32x2 ap[4];
#pragma unroll
            for (int pr = 0; pr < 4; ++pr) ap[pr] = (f32x2){0.f, 0.f};
#pragma unroll
            for (int m = 0; m < 4; ++m) {
                f32x2 o2[4];
#pragma unroll
                for (int pr = 0; pr < 4; ++pr) { const int n = pr >> 1, i = (pr & 1) * 2;
                    const f32x2 a2 = (f32x2){acc[ai][0][m][n][i], acc[ai][0][m][n][i + 1]} * rsc[m];
                    const f32x2 v2 = (f32x2){acc[ai][1][m][n][i], acc[ai][1][m][n][i + 1]} * rsv[m];
                    f32x2 p1 = (f32x2){dpp_f(a2.x, 0), dpp_f(a2.y, 0)}, p2 = (f32x2){dpp_f(a2.x, 1), dpp_f(a2.y, 1)};
                    if (m > 0) { p1 += (f32x2){dpp_f(ap[pr].x, 2), dpp_f(ap[pr].y, 2)}; p2 += (f32x2){dpp_f(ap[pr].x, 3), dpp_f(ap[pr].y, 3)}; }
                    ap[pr] = a2;
                    const f32x2 ac = wb2[pr] + w02[pr] * p2 + w12[pr] * p1 + w22[pr] * a2;
                    const f32x2 u2 = (ac + (ac * ac) * ac * 0.044715f) * (-1.5957691216057308f * 1.4426950408889634f);
                    f32x2 e; e.x = __builtin_amdgcn_exp2f(u2.x); e.y = __builtin_amdgcn_exp2f(u2.y);
                    const f32x2 d = e + 1.0f; f32x2 r; r.x = __builtin_amdgcn_rcpf(d.x); r.y = __builtin_amdgcn_rcpf(d.y);
                    o2[pr] = (ac * r) * v2; }
                u32x4 w; w.x = cvt_pk_bf16(o2[0].x, o2[0].y); w.y = cvt_pk_bf16(o2[1].x, o2[1].y); w.z = cvt_pk_bf16(o2[2].x, o2[2].y); w.w = cvt_pk_bf16(o2[3].x, o2[3].y);
#ifdef PG_NT_UP
                __builtin_nontemporal_store(w, (PG8_GAS u32x4*)(G + (size_t)(row64 + m * 16 + fr) * dff + colb));
#else
                *(PG8_GAS u32x4*)(G + (size_t)(row64 + m * 16 + fr) * dff + colb) = w;
#endif
            }
        }
    }
};

struct PanelRms {
    unsigned* xbuf;
    unsigned* cnt;
    unsigned* tmo;
    float eps; unsigned code;
    const float* amx_in;
    float* qs_out;
    template <bool quant> __device__ __forceinline__ bool run(const f32x4 (&v)[2][2][4][2], const f32x4 (&gv)[2][2], const Unit& u, int wr, int wc, int fr, int fq, PG8_LAS unsigned char* lds, int wid, int lane, u32x4 (&pre)[2][4][2], const bf16_t* xb, int ldc, int col0) const {
        PG8_LAS float* P = (PG8_LAS float*)lds;
        PG8_LAS float* PX = (PG8_LAS float*)(lds + 4096);
        PG8_LAS float* S = (PG8_LAS float*)(lds + 8192);
        PG8_LAS float* S2 = (PG8_LAS float*)(lds + 9216);
        PG8_LAS unsigned* flag = (PG8_LAS unsigned*)(lds + 8192 + 2048);
        const int row = wid * 32 + (lane & 31);
        f32x4 ao = (f32x4){0.f, 0.f, 0.f, 0.f};
        if (quant && lane < 32) ao = *(const PG8_GAS f32x4*)(amx_in + (size_t)(u.pm * BM + row) * 4);
#pragma unroll
        for (int ai = 0; ai < 2; ++ai)
#pragma unroll
            for (int m = 0; m < 4; ++m) {
                float s = 0.f, mx = 0.f;
#pragma unroll
                for (int bj = 0; bj < 2; ++bj)
#pragma unroll
                    for (int n = 0; n < 2; ++n) { const f32x4 x = v[ai][bj][m][n]; s += (x[0] * x[0] + x[1] * x[1]) + (x[2] * x[2] + x[3] * x[3]);
                        if (quant) { const f32x4 y = x * gv[bj][n]; mx = fmaxf(mx, fmaxf(fmaxf(fabsf(y[0]), fabsf(y[1])), fmaxf(fabsf(y[2]), fabsf(y[3])))); } }
                s += __shfl_xor(s, 16); s += __shfl_xor(s, 32);
                if (quant) { mx = fmaxf(mx, __shfl_xor(mx, 16)); mx = fmaxf(mx, __shfl_xor(mx, 32)); }
                if (fq == 0) { P[(ai * HALF + wr * 64 + m * 16 + fr) * 4 + wc] = s; if (quant) PX[(ai * HALF + wr * 64 + m * 16 + fr) * 4 + wc] = mx; }
            }
        asm volatile("s_waitcnt lgkmcnt(0)" ::: "memory"); __builtin_amdgcn_s_barrier(); asm volatile("" ::: "memory");
        if (lane < 32) {
            const float t = (P[row * 4 + 0] + P[row * 4 + 1]) + (P[row * 4 + 2] + P[row * 4 + 3]);
            const float tm = quant ? fmaxf(fmaxf(PX[row * 4 + 0], PX[row * 4 + 1]), fmaxf(PX[row * 4 + 2], PX[row * 4 + 3])) : 0.f;
            __hip_atomic_store((PG8_GAS unsigned long long*)(xbuf + ((size_t)(u.pm * BM + row) * 4 + u.pn) * 2), ((unsigned long long)__float_as_uint(tm) << 32) | (unsigned long long)__float_as_uint(t), __ATOMIC_RELAXED, __HIP_MEMORY_SCOPE_AGENT);
        }
        asm volatile("" ::: "memory");
#pragma unroll
        for (int ai = 0; ai < 2; ++ai)
#pragma unroll
            for (int m = 0; m < 4; ++m) { const size_t off = (size_t)(u.pm * BM + ai * HALF + wr * 64 + m * 16 + fr) * ldc + col0;
#pragma unroll
                for (int bj = 0; bj < 2; ++bj) pre[ai][m][bj] = *(const PG8_GAS u32x4*)(xb + off + bj * 32); }
        asm volatile("s_waitcnt vmcnt(14)" ::: "memory");
        if (lane == 0) __hip_atomic_fetch_add((PG8_GAS unsigned*)cnt + 64 * u.pm, 1u, __ATOMIC_RELAXED, __HIP_MEMORY_SCOPE_AGENT);
        if (wid == 0) {
            bool dead = false; const unsigned want = 8u * 4u;
            for (unsigned spins = 0;; ++spins) {
                if ((unsigned)__builtin_amdgcn_readfirstlane(__hip_atomic_load((const PG8_GAS unsigned*)cnt + 64 * u.pm, __ATOMIC_RELAXED, __HIP_MEMORY_SCOPE_AGENT)) >= want) break;
                if (spins > (1u << 20)) {
                    if (lane == 0) { unsigned expect = 0u; __hip_atomic_compare_exchange_strong(tmo + 1, &expect, code | (unsigned)(u.pm & 0xff), __ATOMIC_RELAXED, __ATOMIC_RELAXED, __HIP_MEMORY_SCOPE_AGENT);
                                     __hip_atomic_store(tmo, 1u, __ATOMIC_RELAXED, __HIP_MEMORY_SCOPE_AGENT); }
                    dead = true; break; }
                __builtin_amdgcn_s_sleep(2);
            }
            if (lane == 0) flag[0] = dead ? 1u : 0u;
        }
        asm volatile("s_waitcnt vmcnt(0) lgkmcnt(0)" ::: "memory"); __builtin_amdgcn_s_barrier(); asm volatile("" ::: "memory");
        const bool bad = flag[0] != 0u;
        if (lane < 32) {
            const PG8_GAS unsigned long long* slot = (const PG8_GAS unsigned long long*)(xbuf + (size_t)(u.pm * BM + row) * 8); float q = 0.f; f32x4 bm;
#pragma unroll
            for (int t = 0; t < 4; ++t) { const unsigned long long w = __hip_atomic_load(slot + t, __ATOMIC_RELAXED, __HIP_MEMORY_SCOPE_AGENT); q += __uint_as_float((unsigned)w); bm[t] = __uint_as_float((unsigned)(w >> 32)); }
            const float rinv = __builtin_amdgcn_rsqf(q * (1.0f / 1024.0f) + eps);
            S[row] = rinv;
            if (quant) { const f32x4 bt = ao + bm * rinv;
                const float B = fmaxf(fmaxf(bt[0], bt[1]), fmaxf(bt[2], bt[3])) * 1.004f + 1e-20f;
                S2[row] = 127.0f * __builtin_amdgcn_rcpf(B); if (u.pn == 0) ((PG8_GAS float*)qs_out)[u.pm * BM + row] = B * (1.0f / 127.0f); }
        }
        asm volatile("s_waitcnt lgkmcnt(0)" ::: "memory"); __builtin_amdgcn_s_barrier(); asm volatile("" ::: "memory");
        return bad;
    }
};
__device__ __forceinline__ unsigned pack_i8x4(const f32x4 q) {
    return __builtin_amdgcn_perm(__float_as_uint(q[1]), __float_as_uint(q[0]), 0x0c0c0400u) | __builtin_amdgcn_perm(__float_as_uint(q[3]), __float_as_uint(q[2]), 0x04000c0cu);
}
__device__ __forceinline__ float amax4(const f32x4 a) { return fmaxf(fmaxf(fabsf(a[0]), fabsf(a[1])), fmaxf(fabsf(a[2]), fabsf(a[3]))); }
template <bool QUANT  > struct EpiRmsRes {
    static constexpr bool PERM = true, AFTER_DRAIN = true, HAS_MID = false, I8 = false; static constexpr int MID_T = -1, NST = 0, PID = 0; static constexpr bool HAS_PRE = false; struct PreT {}; __device__ __forceinline__ PreT pre(const Unit&, int, int) const { return PreT{}; }
    bf16_t* xb; float* outf; int ldc; const float* g1; float* stat; signed char* xq; float* amx; PanelRms st;
    __device__ __forceinline__ void fused(f32x4 (&acc)[2][2][4][2], const Unit& u, int wr, int wc, int fr, int fq, PG8_LAS unsigned char* lds, int wid, int lane) const {
        const PG8_LAS float* S = (const PG8_LAS float*)(lds + 8192);
        const PG8_LAS float* S2 = (const PG8_LAS float*)(lds + 9216);
        PG8_LAS float* P = (PG8_LAS float*)lds;
        PG8_LAS float* PX = (PG8_LAS float*)(lds + 4096);
        const int col0 = u.pn * BM + wc * 64 + 8 * fq, odd = fr & 1;
        u32x4 pre[2][4][2];
        f32x4 gv[2][2];
#pragma unroll
        for (int bj = 0; bj < 2; ++bj)
#pragma unroll
            for (int n = 0; n < 2; ++n) gv[bj][n] = *(const PG8_GAS f32x4*)(g1 + col0 + bj * 32 + 4 * n);
        (void)st.template run<QUANT>(acc, gv, u, wr, wc, fr, fq, lds, wid, lane, pre, xb, ldc, col0);
#pragma unroll
        for (int ai = 0; ai < 2; ++ai)
#pragma unroll
            for (int m = 0; m < 4; ++m) { const int r = ai * HALF + wr * 64 + m * 16 + fr; const float sr = S[r]; const size_t off = (size_t)(u.pm * BM + r) * ldc + col0;
                const float s2r = QUANT ? S2[r] : 0.f;
                float ps = 0.f, pmx = 0.f; u32x4 w[2];
#pragma unroll
                for (int bj = 0; bj < 2; ++bj) { const u32x4 pb = pre[ai][m][bj];
                    const f32x4 b0 = (f32x4){bfbits2f(pb.x & 0xffffu), bfbits2f(pb.x >> 16), bfbits2f(pb.y & 0xffffu), bfbits2f(pb.y >> 16)};
                    const f32x4 b1 = (f32x4){bfbits2f(pb.z & 0xffffu), bfbits2f(pb.z >> 16), bfbits2f(pb.w & 0xffffu), bfbits2f(pb.w >> 16)};
                    const f32x4 o0 = b0 + acc[ai][bj][m][0] * sr * gv[bj][0], o1 = b1 + acc[ai][bj][m][1] * sr * gv[bj][1];
                    if (outf) { *(PG8_GAS f32x4*)(outf + off + bj * 32) = o0; *(PG8_GAS f32x4*)(outf + off + bj * 32 + 4) = o1; }
                    else { w[bj].x = cvt_pk_bf16(o0[0], o0[1]); w[bj].y = cvt_pk_bf16(o0[2], o0[3]); w[bj].z = cvt_pk_bf16(o1[0], o1[1]); w[bj].w = cvt_pk_bf16(o1[2], o1[3]);
                        ps += ((o0[0] * o0[0] + o0[1] * o0[1]) + (o0[2] * o0[2] + o0[3] * o0[3])) + ((o1[0] * o1[0] + o1[1] * o1[1]) + (o1[2] * o1[2] + o1[3] * o1[3]));
                        pmx = fmaxf(pmx, fmaxf(amax4(o0), amax4(o1)));
                        if constexpr (QUANT) { u32x2 qw; qw.x = pack_i8x4(o0 * s2r + 12582912.0f); qw.y = pack_i8x4(o1 * s2r + 12582912.0f);
                            *(PG8_GAS u32x2*)(xq + off + bj * 32) = qw; } } }
                if (!outf) { u32x4 dA, dB; pair_swap(w[0], w[1], odd, dA, dB);
                    bf16_t* pA = xb + (size_t)(u.pm * BM + r - odd) * ldc + col0 + 32 * odd; *(PG8_GAS u32x4*)pA = dA; *(PG8_GAS u32x4*)(pA + ldc) = dB; }
                if (!outf) { ps += __shfl_xor(ps, 16); ps += __shfl_xor(ps, 32); pmx = fmaxf(pmx, __shfl_xor(pmx, 16)); pmx = fmaxf(pmx, __shfl_xor(pmx, 32)); if (fq == 0) { P[r * 4 + wc] = ps; PX[r * 4 + wc] = pmx; } } }
        if (!outf) {
            asm volatile("s_waitcnt lgkmcnt(0)" ::: "memory"); __builtin_amdgcn_s_barrier(); asm volatile("" ::: "memory");
            const int row = wid * 32 + (lane & 31);
            if (lane < 32) { ((PG8_GAS float*)stat)[(size_t)(u.pm * BM + row) * 4 + u.pn] = (P[row * 4 + 0] + P[row * 4 + 1]) + (P[row * 4 + 2] + P[row * 4 + 3]);
                ((PG8_GAS float*)amx)[(size_t)(u.pm * BM + row) * 4 + u.pn] = fmaxf(fmaxf(PX[row * 4 + 0], PX[row * 4 + 1]), fmaxf(PX[row * 4 + 2], PX[row * 4 + 3])); }
        }
    }
};
template <bool I8E, int THR, int OFF_HI, int TB> struct EpiBf16Rs {
    static constexpr bool PERM = true, AFTER_DRAIN = false, HAS_MID = false, I8 = I8E; static constexpr int MID_T = -1, NST = PG_NST, PID = I8E ? 2 : 3; static constexpr bool HAS_PRE = false; struct PreT {}; __device__ __forceinline__ PreT pre(const Unit&, int, int) const { return PreT{}; }
    bf16_t* O; int ldc; const float* costab; const float* sintab; const unsigned* wsc;
    __device__ __forceinline__ void operator()(const f32x4 (&acc)[2][2][4][2], const Unit& u, int wr, int wc, int fr, int fq) const {
        const int pn = u.pn + (u.pn >= THR ? OFF_HI : 0);
        const int row0 = u.pm * BM + wr * 64 + fr, col0 = pn * BM + wc * 32 + 8 * fq;
        float ts[2] = {1.0f, 1.0f};
        if constexpr (I8) { ts[0] = __uint_as_float(((const PG8_GAS unsigned*)wsc)[u.pn * 8 + wc]) * (1.0f / 127.0f); ts[1] = __uint_as_float(((const PG8_GAS unsigned*)wsc)[u.pn * 8 + 4 + wc]) * (1.0f / 127.0f); }
        const bool rot = !I8E && (pn >= 3) && (pn <= 6);
        float sc[2][4];
        {
#pragma unroll
            for (int ai = 0; ai < 2; ++ai)
#pragma unroll
                for (int m = 0; m < 4; ++m) sc[ai][m] = rs_lds()[TB + ((row0 + ai * HALF + m * 16) & 255)];
        }
        if (!rot) {
            const int odd = fr & 1; const int colL = pn * BM + wc * 64 + 32 * odd + 8 * fq;
#pragma unroll
            for (int ai = 0; ai < 2; ++ai)
#pragma unroll
                for (int m = 0; m < 4; ++m) { const int rr = row0 + ai * HALF + m * 16;
                    u32x4 w[2];
#pragma unroll
                    for (int bj = 0; bj < 2; ++bj) { const float sb = sc[ai][m] * ts[bj]; const f32x4 v0 = acc[ai][bj][m][0] * sb, v1 = acc[ai][bj][m][1] * sb;
                        w[bj].x = cvt_pk_bf16(v0[0], v0[1]); w[bj].y = cvt_pk_bf16(v0[2], v0[3]); w[bj].z = cvt_pk_bf16(v1[0], v1[1]); w[bj].w = cvt_pk_bf16(v1[2], v1[3]); }
                    const u32x4 snd = odd ? w[0] : w[1];
                    u32x4 rcv;
                    rcv.x = (unsigned)__builtin_amdgcn_update_dpp(0, (int)snd.x, 0xB1, 0xf, 0xf, false); rcv.y = (unsigned)__builtin_amdgcn_update_dpp(0, (int)snd.y, 0xB1, 0xf, 0xf, false);
                    rcv.z = (unsigned)__builtin_amdgcn_update_dpp(0, (int)snd.z, 0xB1, 0xf, 0xf, false); rcv.w = (unsigned)__builtin_amdgcn_update_dpp(0, (int)snd.w, 0xB1, 0xf, 0xf, false);
                    const u32x4 dA = odd ? rcv : w[0], dB = odd ? w[1] : rcv;
                    bf16_t* pA = O + (size_t)(rr - odd) * ldc + colL; bf16_t* pB = O + (size_t)(rr - odd + 1) * ldc + colL;
                    ST16(pA, dA); ST16(pB, dB); }
        } else {
            const bool isk = pn >= 5; const int hb = 2 * ((pn - 3) & 1);
            float lgs[2];
#pragma unroll
            for (int bj = 0; bj < 2; ++bj) { const float lg2 = LOG2_GAMMA_OF(hb + bj); lgs[bj] = isk ? -lg2 : lg2; }
            const float kmul = isk ? 0.08838834764831845f : 1.0f;
#pragma unroll
            for (int ai = 0; ai < 2; ++ai)
#pragma unroll
                for (int m = 0; m < 4; ++m) { const int ri = row0 + ai * HALF + m * 16; bf16_t* rowp = O + (size_t)ri * ldc + col0;
                    const int toff = (ri & 4095) * 64 + 4 * (4 * wc + fq); const f32x4 cs = *(const PG8_GAS f32x4*)(costab + toff), sn = *(const PG8_GAS f32x4*)(sintab + toff);
                    const float cpos = (float)(ri & 127);
#pragma unroll
                    for (int bj = 0; bj < 2; ++bj) { const float scl = sc[ai][m] * (kmul * ts[bj]) * __builtin_amdgcn_exp2f(lgs[bj] * cpos);
                        const f32x4 x1 = acc[ai][bj][m][0], x2 = acc[ai][bj][m][1];
                        const f32x4 v0 = (x1 * cs - x2 * sn) * scl, v1 = (x1 * sn + x2 * cs) * scl;
                        u32x4 w; w.x = cvt_pk_bf16(v0[0], v0[1]); w.y = cvt_pk_bf16(v0[2], v0[3]); w.z = cvt_pk_bf16(v1[0], v1[1]); w.w = cvt_pk_bf16(v1[2], v1[3]);
                        ST16(rowp + bj * HALF, w); } }
        }
    }
};
struct EpiNull {
    static constexpr bool PERM = true, AFTER_DRAIN = false, HAS_MID = false, I8 = false; static constexpr int MID_T = -1, NST = 0, PID = 0; static constexpr bool HAS_PRE = false; struct PreT {}; __device__ __forceinline__ PreT pre(const Unit&, int, int) const { return PreT{}; }
    float* sink;
    __device__ __forceinline__ void operator()(const f32x4 (&acc)[2][2][4][2], const Unit& u, int wr, int wc, int fr, int fq) const {
        f32x4 t = acc[0][0][0][0];
#pragma unroll
        for (int ai = 0; ai < 2; ++ai)
#pragma unroll
            for (int bj = 0; bj < 2; ++bj)
#pragma unroll
                for (int m = 0; m < 4; ++m)
#pragma unroll
                    for (int n = 0; n < 2; ++n) t += acc[ai][bj][m][n];
        if (t[0] + t[1] + t[2] + t[3] == 123456.789f) sink[0] = t[0];
    }
};

struct EpiGate2 {
    static constexpr bool PERM = true, AFTER_DRAIN = false, HAS_MID = true, I8 = false; static constexpr int MID_T = 6, NST = 0, PID = 0; static constexpr bool HAS_PRE = false; struct PreT {}; __device__ __forceinline__ PreT pre(const Unit&, int, int) const { return PreT{}; }
    bf16_t* O; int ldc; const bf16_t* ga; const bf16_t* gr; int ldg;
    static __device__ __forceinline__ f32x2 expneg2(unsigned w) { const f32x2 x = (f32x2){bfbits2f(w & 0xffffu), __uint_as_float(w & 0xffff0000u)} * -1.4426950408889634f; f32x2 e; e.x = __builtin_amdgcn_exp2f(x.x); e.y = __builtin_amdgcn_exp2f(x.y); return e; }
    static __device__ __forceinline__ f32x2 rcp2(f32x2 d) { f32x2 r; r.x = __builtin_amdgcn_rcpf(d.x); r.y = __builtin_amdgcn_rcpf(d.y); return r; }
    __device__ __forceinline__ void mid(f32x4 (&acc)[2][2][4][2], const Unit& u, int wr, int wc, int fr, int fq) const {
        int fro = fr; asm volatile("" : "+v"(fro));
        const int row0 = u.pm * BM + wr * 64 + fro, col0 = u.pn * BM + wc * 64 + 8 * fq;
        u32x4 da[8][2], dg[8][2];
#define G2_ISSUE(i) do { const size_t r_ = (size_t)(row0 + ((i) >> 2) * HALF + ((i) & 3) * 16); _Pragma("unroll") for (int bj = 0; bj < 2; ++bj) { \
            da[i][bj] = *(const PG8_GAS u32x4*)(ga + r_ * ldg + col0 + bj * 32); dg[i][bj] = *(const PG8_GAS u32x4*)(gr + r_ * ldg + col0 + bj * 32); } } while (0)
        G2_ISSUE(0); G2_ISSUE(1);
#pragma unroll
        for (int i = 0; i < 8; ++i) { const int ai = i >> 2, m = i & 3;
            if (i + 2 < 8) G2_ISSUE(i + 2);
            asm volatile("" ::: "memory");
#pragma unroll
            for (int bj = 0; bj < 2; ++bj) { const u32x4 a = da[i][bj], g = dg[i][bj];
                const unsigned aw[4] = {a.x, a.y, a.z, a.w}, gw_[4] = {g.x, g.y, g.z, g.w};
                f32x2 rho[4];
#pragma unroll
                for (int k = 0; k < 4; ++k) rho[k] = (expneg2(gw_[k]) + 1.0f) * rcp2(expneg2(aw[k]) + 1.0f);
                acc[ai][bj][m][0] = acc[ai][bj][m][0] * (f32x4){rho[0].x, rho[0].y, rho[1].x, rho[1].y};
                acc[ai][bj][m][1] = acc[ai][bj][m][1] * (f32x4){rho[2].x, rho[2].y, rho[3].x, rho[3].y}; }
        }
#undef G2_ISSUE
    }
    __device__ __forceinline__ void operator()(const f32x4 (&acc)[2][2][4][2], const Unit& u, int wr, int wc, int fr, int fq) const {
        const int row0 = u.pm * BM + wr * 64 + fr, col0 = u.pn * BM + wc * 64 + 8 * fq, odd = fr & 1;
        u32x4 dg[8][2];
#define G2_ISSUE(i) do { const size_t r_ = (size_t)(row0 + ((i) >> 2) * HALF + ((i) & 3) * 16); _Pragma("unroll") for (int bj = 0; bj < 2; ++bj) dg[i][bj] = *(const PG8_GAS u32x4*)(gr + r_ * ldg + col0 + bj * 32); } while (0)
        G2_ISSUE(0); G2_ISSUE(1); G2_ISSUE(2);
#pragma unroll
        for (int i = 0; i < 8; ++i) { const int ai = i >> 2, m = i & 3; const size_t r = (size_t)(row0 + ai * HALF + m * 16);
            if (i + 3 < 8) G2_ISSUE(i + 3);
            asm volatile("" ::: "memory");
            u32x4 w[2];
#pragma unroll
            for (int bj = 0; bj < 2; ++bj) { const u32x4 gv = dg[i][bj];
                const f32x4 v0 = acc[ai][bj][m][0], v1 = acc[ai][bj][m][1];
                const f32x2 s0 = rcp2(expneg2(gv.x) + 1.0f), s1 = rcp2(expneg2(gv.y) + 1.0f), s2 = rcp2(expneg2(gv.z) + 1.0f), s3 = rcp2(expneg2(gv.w) + 1.0f);
                const f32x2 o0 = (f32x2){v0[0], v0[1]} * s0, o1 = (f32x2){v0[2], v0[3]} * s1, o2 = (f32x2){v1[0], v1[1]} * s2, o3 = (f32x2){v1[2], v1[3]} * s3;
                w[bj].x = cvt_pk_bf16(o0.x, o0.y); w[bj].y = cvt_pk_bf16(o1.x, o1.y); w[bj].z = cvt_pk_bf16(o2.x, o2.y); w[bj].w = cvt_pk_bf16(o3.x, o3.y); }
            u32x4 dA, dB; pair_swap(w[0], w[1], odd, dA, dB);
            bf16_t* pA = O + (r - odd) * ldc + col0 + 32 * odd;
            *(PG8_GAS u32x4*)pA = dA; *(PG8_GAS u32x4*)(pA + ldc) = dB;
        }
#undef G2_ISSUE
    }
};
}

constexpr int NWAVES = 8;
constexpr int D = 1024, BATCH = 8, SEQ = 4096, DEPTH = 4;
constexpr int M = BATCH * SEQ, MH = M / 2;
constexpr int DIN = 5888, DFF = 2816, NUP = 2 * DFF;
constexpr int C_QA = 0, C_KA = 512, C_VA = 640, C_QR = 768, C_KR = 1280, C_VR = 1792, C_GR = 2816, C_GA = 3840, C_GT = 4864;
constexpr float EPS = 1e-6f;
#ifndef MK_ONE_LAUNCH
#define MK_ONE_LAUNCH 0
#endif
constexpr int PH_PER = 15;
constexpr int N_PHASES = 1 + DEPTH * PH_PER;

constexpr size_t MiB = 1u << 20;
constexpr size_t WS_CTL = 0, CTL_ZERO_BYTES = 1 * MiB;
constexpr size_t WS_BIAS = 1 * MiB;
constexpr size_t WS_AMX = 5 * MiB;
constexpr size_t WS_COS = 2 * MiB, WS_SIN = 3 * MiB;
constexpr size_t WS_STAT = 4 * MiB;
constexpr size_t WS_W = 6 * MiB;
constexpr size_t W_IN = 0, W_OA = W_IN + (size_t)DIN * D, W_OR = W_OA + (size_t)D * 512, W_O = W_OR + (size_t)D * D, W_UP = W_O + (size_t)D * D, W_DN = W_UP + (size_t)NUP * D, W_LAYER = W_DN + (size_t)D * DFF;
static_assert(W_LAYER * 2 == 33 * MiB, "weights per layer");
constexpr size_t W_IN8 = W_UP + (size_t)NUP * D / 2;
constexpr size_t WS_RA = WS_W + 4 * 33 * MiB;
constexpr size_t WS_RB = WS_RA + 184 * MiB;
constexpr size_t WS_XN = WS_RB;
constexpr size_t WS_XN1 = WS_XN + 32 * MiB;
constexpr size_t WS_AOA = WS_XN1 + 32 * MiB;
constexpr size_t WS_AOR = WS_AOA + 16 * MiB;
constexpr size_t WS_KV = WS_AOA + 48 * MiB;
constexpr size_t WS_MG = WS_KV;
constexpr size_t WS_G = WS_RA;
constexpr size_t WS_H = WS_AOA;
constexpr size_t WS_XQ = WS_KV + 32 * MiB;
constexpr size_t WS_XSLOT = WS_XQ + 32 * MiB;
constexpr size_t WS_QS = WS_XSLOT + 1 * MiB;
constexpr size_t WS_END = WS_QS + 1 * MiB;
static_assert((size_t)MH * DIN * 2 == 184 * MiB && (size_t)M * DFF * 2 <= 184 * MiB && (size_t)(M / 64) * 6 * DFF * 2 <= 48 * MiB && WS_END <= 512 * MiB, "ws map");
constexpr int CW_WAMAX = 131072;
constexpr int CW_BAR = 4096, CW_SEAM = 16384;

constexpr int RING_BYTES = 131072;
constexpr int LDS_BYTES = 147456;
constexpr int MISC_OFF = 143360;

#define GAS __attribute__((address_space(1)))
#define LAS __attribute__((address_space(3)))
typedef unsigned short bf16;
typedef unsigned v4u __attribute__((ext_vector_type(4)));
typedef float f32x4 __attribute__((ext_vector_type(4)));
typedef short bf16x8 __attribute__((ext_vector_type(8)));
typedef GAS unsigned gu32;
typedef GAS unsigned long long gu64;
#define RLX_AGENT __ATOMIC_RELAXED, __HIP_MEMORY_SCOPE_AGENT
#define LDS_WAIT() asm volatile("s_waitcnt lgkmcnt(0)" ::: "memory")
#define VM_WAIT() asm volatile("s_waitcnt vmcnt(0)" ::: "memory")
__device__ __forceinline__ unsigned long long rt() { return __builtin_amdgcn_s_memrealtime(); }
__device__ __forceinline__ unsigned f2bf(float f) { unsigned u = __builtin_bit_cast(unsigned, f); return (u + 0x7fffu + ((u >> 16) & 1u)) >> 16; }
typedef float pk2_f32x2_t __attribute__((ext_vector_type(2))); typedef __bf16 pk2_bf16x2_t __attribute__((ext_vector_type(2)));
__device__ __forceinline__ unsigned pk2(float lo, float hi) { const pk2_f32x2_t v = {lo, hi}; return __builtin_bit_cast(unsigned, __builtin_convertvector(v, pk2_bf16x2_t)); }

#define XB_TMO      128
#define XB_XCNT(j)  (256  + 64 * (j))
#define XB_XSUB(j)  (1280 + 64 * (j))
#define XB_XGEN(j)  (2304 + 64 * (j))
#define XB_TOP      3328
#define XB_TOPGEN   3392
#define XCD_BAR_WORDS 3456
#define XB_SPIN_CAP (1u << 18)

__device__ __forceinline__ unsigned xb_ld(unsigned* p)              { return __hip_atomic_load(p, __ATOMIC_RELAXED, __HIP_MEMORY_SCOPE_AGENT); }
__device__ __forceinline__ unsigned xb_add(unsigned* p, unsigned v) { return __hip_atomic_fetch_add(p, v, __ATOMIC_RELAXED, __HIP_MEMORY_SCOPE_AGENT); }
__device__ __forceinline__ unsigned xb_xcc_id() { return (unsigned)__builtin_amdgcn_s_getreg((3 << 11) | 20) & 0xFu; }
#define XB_SPIN(cond, bar) do { unsigned _sp = 0; while (cond) { __builtin_amdgcn_s_sleep(1); \
    if ((++_sp & 255u) == 0u) { if (xb_ld(&(bar)[XB_TMO])) break; if (_sp > XB_SPIN_CAP) { atomicAdd(&(bar)[XB_TMO], 1u); break; } } } } while (0)

struct XcdBarrier {
    unsigned* bar; unsigned x;
    volatile LAS unsigned* st;
};

__device__ __forceinline__ XcdBarrier xcd_barrier_post(unsigned* bar, volatile LAS unsigned* st) {
    XcdBarrier b; b.bar = bar; b.x = xb_xcc_id(); b.st = st;
    if (threadIdx.x == 0) (void)xb_add(&bar[XB_XCNT(b.x)], 1u);
    return b;
}
__device__ __forceinline__ void xcd_barrier_complete(unsigned* bar, unsigned x, unsigned& nloc, unsigned& nx) {
    const unsigned G = gridDim.x * gridDim.y * gridDim.z;
    unsigned sum, cnt, mine, sp = 0u;
    for (;;) {
        sum = 0u; cnt = 0u; mine = 0u;
#pragma unroll
        for (unsigned j = 0; j < 16; ++j) { const unsigned c = xb_ld(&bar[XB_XCNT(j)]); sum += c; cnt += (c > 0u) ? 1u : 0u; mine = (j == x) ? c : mine; }
        if (sum == G) break;
        __builtin_amdgcn_s_sleep(1);
        if ((++sp & 255u) == 0u) { if (xb_ld(&bar[XB_TMO])) break; if (sp > XB_SPIN_CAP) { atomicAdd(&bar[XB_TMO], 1u); break; } }
    }
    nloc = mine > 0u ? mine : 1u; nx = cnt > 0u ? cnt : 1u;
}

__device__ __forceinline__ void xcd_barrier(const XcdBarrier& b) {
    asm volatile("s_waitcnt vmcnt(0)" ::: "memory");
    __syncthreads();
    int tid0_ = threadIdx.x; asm volatile("" : "+v"(tid0_));
    if (tid0_ == 0) {
        unsigned* bar = b.bar;
        __builtin_amdgcn_s_waitcnt(0);
        unsigned nloc = b.st[0], nx = b.st[1];
        if (nloc == 0u) { xcd_barrier_complete(bar, b.x, nloc, nx); b.st[0] = nloc; b.st[1] = nx; }
        const unsigned old = xb_add(&bar[XB_XSUB(b.x)], 1u);
        const unsigned gen = old / nloc;
        if (old + 1u == (gen + 1u) * nloc) {
            __builtin_amdgcn_fence(__ATOMIC_RELEASE, "agent");
            asm volatile("s_waitcnt vmcnt(0)" ::: "memory");
            const unsigned og = xb_add(&bar[XB_TOP], 1u);
            const unsigned tg = og / nx;
            if (og + 1u == (tg + 1u) * nx) xb_add(&bar[XB_TOPGEN], 1u);
            else XB_SPIN(xb_ld(&bar[XB_TOPGEN]) == tg, bar);
            __builtin_amdgcn_fence(__ATOMIC_ACQUIRE, "agent");
            xb_add(&bar[XB_XGEN(b.x)], 1u);
            asm volatile("s_waitcnt vmcnt(0)" ::: "memory");
        } else {
            XB_SPIN(xb_ld(&bar[XB_XGEN(b.x)]) == gen, bar);
            __builtin_amdgcn_fence(__ATOMIC_ACQUIRE, "agent");
            asm volatile("s_waitcnt vmcnt(0)" ::: "memory");
        }
    }
    __syncthreads();
}
typedef unsigned u32x2 __attribute__((ext_vector_type(2)));
typedef unsigned short u16;
#define MFMA16(a, b, c) __builtin_amdgcn_mfma_f32_16x16x32_bf16((a), (b), (c), 0, 0, 0)
__device__ __forceinline__ float bf2f(unsigned b) { return __uint_as_float(b << 16); }
__device__ __forceinline__ float wave_sum(float v) {
#pragma unroll
    for (int o = 1; o < 64; o <<= 1) v += __shfl_xor(v, o);
    return v;
}
__device__ __forceinline__ float sigm(float x) { return __builtin_amdgcn_rcpf(1.0f + __builtin_amdgcn_exp2f(x * -1.4426950408889634f)); }
__device__ __forceinline__ float tanh_fast(float x) { const float e = __expf(-2.0f * fabsf(x)); const float t = (1.0f - e) / (1.0f + e); return x < 0.f ? -t : t; }
__device__ __forceinline__ float gelu_tanh(float x) { const float u = 0.7978845608028654f * (x + 0.044715f * x * x * x); return 0.5f * x * (1.0f + tanh_fast(u)); }

struct ColSel { int cnt, split, gap, rt_split, rt_gap; };
__device__ __forceinline__ int p0_row(int ro, int N, int rmode) {
    if (rmode == 1) { const int hv = ro >= (N >> 1), nn = hv ? ro - (N >> 1) : ro; ro = 256 * (nn >> 7) + 128 * hv + (nn & 127); }
    else if (rmode == 2 && ro >= C_QR && ro < C_VR) { const int jj = ro & 127; ro = (ro & ~127) + ((jj & 63) >> 2) * 8 + ((jj >> 6) << 2) + (jj & 3); }
    else if (rmode == 2 || rmode == 3) { const int x = ro & 255; ro = (ro & ~255) + 128 * ((x >> 5) & 1) + 32 * (x >> 6) + (x & 31); }
    return ro;
}
__device__ __forceinline__ int p0_rowc(int col, int N, int rmode, const ColSel cs) { int ro = p0_row(col, N, rmode); if ((ro >> 8) >= cs.rt_split) ro -= 256 * cs.rt_gap; return ro; }
__device__ __forceinline__ void p0_load_item(const float* W, int N, int item, int lane, const ColSel cs, f32x4 (&wv)[8]) {
    const int kb = item / cs.cnt, j = item % cs.cnt, nb = j + (j >= cs.split ? cs.gap : 0), k0 = 64 * kb;
    const float* base = W + (size_t)(k0 + (lane >> 3)) * N + 32 * nb + 4 * (lane & 7);
#pragma unroll
    for (int i = 0; i < 8; ++i) wv[i] = __builtin_nontemporal_load((const GAS f32x4*)(base + (size_t)(8 * i) * N));
}
__device__ __forceinline__ unsigned p0_pack8(const float (&q)[4]) {
    return __builtin_amdgcn_perm(__float_as_uint(q[1]), __float_as_uint(q[0]), 0x0c0c0400u) | __builtin_amdgcn_perm(__float_as_uint(q[3]), __float_as_uint(q[2]), 0x04000c0cu);
}
template <bool Q8>
__device__ __forceinline__ void p0_store_item(const f32x4 (&wv)[8], int K, int N, bf16* WT, int ldw, LAS float* scr, int item, int lane, int rmode, const float* gk, const unsigned* wamax, const ColSel cs) {
    const int kb = item / cs.cnt, j_ = item % cs.cnt, nb = j_ + (j_ >= cs.split ? cs.gap : 0), k0 = 64 * kb;
    float qsc = 1.0f;
    if (Q8) { const int blk = p0_rowc(32 * nb, N, rmode, cs) >> 5; qsc = 127.0f * __builtin_amdgcn_rcpf(fmaxf(__uint_as_float(((const GAS unsigned*)wamax)[blk]), 1e-20f)); }
#pragma unroll
    for (int i = 0; i < 8; ++i) { const int kk = 8 * i + (lane >> 3); const float gs = (gk ? ((const GAS float*)gk)[k0 + kk] : 1.0f) * qsc; LAS float* d = scr + kk * 33 + 4 * (lane & 7);
        d[0] = wv[i].x * gs; d[1] = wv[i].y * gs; d[2] = wv[i].z * gs; d[3] = wv[i].w * gs; }
    LDS_WAIT(); asm volatile("" ::: "memory");
    const int c = lane & 7;
#pragma unroll
    for (int j = 0; j < 4; ++j) { const int n = (lane >> 3) + 8 * j; const LAS float* s = scr + (8 * c) * 33 + n;
        const int ro = p0_rowc(32 * nb + n, N, rmode, cs);
        if (Q8) { const float qa[4] = {s[0 * 33] + 12582912.0f, s[1 * 33] + 12582912.0f, s[2 * 33] + 12582912.0f, s[3 * 33] + 12582912.0f}, qb[4] = {s[4 * 33] + 12582912.0f, s[5 * 33] + 12582912.0f, s[6 * 33] + 12582912.0f, s[7 * 33] + 12582912.0f};
            u32x2 o; o.x = p0_pack8(qa); o.y = p0_pack8(qb);
            *(GAS u32x2*)((signed char*)WT + (size_t)ro * ldw + k0 + 8 * c) = o; }
        else { v4u o; o.x = pk2(s[0 * 33], s[1 * 33]); o.y = pk2(s[2 * 33], s[3 * 33]); o.z = pk2(s[4 * 33], s[5 * 33]); o.w = pk2(s[6 * 33], s[7 * 33]);
            *(GAS v4u*)(WT + (size_t)ro * ldw + k0 + 8 * c) = o; } }
    LDS_WAIT(); asm volatile("" ::: "memory");
}
template <bool Q8>
__device__ __forceinline__ void p0_matrix_sel(const float* W, int K, int N, bf16* WT, int ldw, LAS float* scr, int gw, int NGW, int lane, int rmode, const float* gk, const unsigned* wamax, const ColSel cs) {
    const int nitems = (K / 64) * cs.cnt;
    f32x4 wa[8], wb[8];
    int it = gw;
    if (it < nitems) p0_load_item(W, N, it, lane, cs, wa);
    while (it < nitems) {
        const int it1 = it + NGW, it2 = it1 + NGW;
        if (it1 < nitems) p0_load_item(W, N, it1, lane, cs, wb);
        p0_store_item<Q8>(wa, K, N, WT, ldw, scr, it, lane, rmode, gk, wamax, cs);
        if (it1 >= nitems) break;
        if (it2 < nitems) p0_load_item(W, N, it2, lane, cs, wa);
        p0_store_item<Q8>(wb, K, N, WT, ldw, scr, it1, lane, rmode, gk, wamax, cs);
        it = it2;
    }
}
template <bool Q8>
__device__ __forceinline__ void p0_matrix(const float* W, int K, int N, bf16* WT, int ldw, LAS float* scr, int gw, int NGW, int lane, int rmode, const float* gk, const unsigned* wamax = nullptr) {
    p0_matrix_sel<Q8>(W, K, N, WT, ldw, scr, gw, NGW, lane, rmode, gk, wamax, ColSel{N / 32, N / 32, 0, 1 << 20, 0});
}
__device__ __forceinline__ void p0_amax_item(const f32x4 (&wv)[8], int N, int item, int lane, int rmode, const float* gk, unsigned* wamax, const ColSel cs) {
    const int kb = item / cs.cnt, j = item % cs.cnt, nb = j + (j >= cs.split ? cs.gap : 0), k0 = 64 * kb;
    float mx = 0.f;
#pragma unroll
    for (int i = 0; i < 8; ++i) { const float gs = fabsf(((const GAS float*)gk)[k0 + 8 * i + (lane >> 3)]); mx = fmaxf(mx, gs * fmaxf(fmaxf(fabsf(wv[i].x), fabsf(wv[i].y)), fmaxf(fabsf(wv[i].z), fabsf(wv[i].w)))); }
#pragma unroll
    for (int o = 1; o < 64; o <<= 1) mx = fmaxf(mx, __shfl_xor(mx, o));
    if (lane == 0) __hip_atomic_fetch_max((GAS unsigned*)wamax + (p0_rowc(32 * nb, N, rmode, cs) >> 5), __float_as_uint(mx), __ATOMIC_RELAXED, __HIP_MEMORY_SCOPE_AGENT);
}
__device__ __forceinline__ void p0_amax(const float* W, int K, int N, int gw, int NGW, int lane, int rmode, const float* gk, unsigned* wamax, const ColSel cs) {
    const int nitems = (K / 64) * cs.cnt;
    f32x4 wa[8], wb[8];
    int it = gw;
    if (it < nitems) p0_load_item(W, N, it, lane, cs, wa);
    while (it < nitems) {
        const int it1 = it + NGW, it2 = it1 + NGW;
        if (it1 < nitems) p0_load_item(W, N, it1, lane, cs, wb);
        p0_amax_item(wa, N, it, lane, rmode, gk, wamax, cs);
        if (it1 >= nitems) break;
        if (it2 < nitems) p0_load_item(W, N, it2, lane, cs, wa);
        p0_amax_item(wb, N, it1, lane, rmode, gk, wamax, cs);
        it = it2;
    }
}

__device__ __forceinline__ void rms_rows(const float* x, const float* g, bf16* xn, int gw, int NGW, int lane) {
    f32x4 gg[4];
#pragma unroll
    for (int j = 0; j < 4; ++j) gg[j] = *((const f32x4*)g + lane + 64 * j);
    for (int m = gw; m < MH; m += NGW) {
        const GAS f32x4* xr = (const GAS f32x4*)(x + (size_t)m * D) + lane;
        f32x4 v[4]; float s = 0.f;
#pragma unroll
        for (int j = 0; j < 4; ++j) { v[j] = xr[64 * j]; s += (v[j].x * v[j].x + v[j].y * v[j].y) + (v[j].z * v[j].z + v[j].w * v[j].w); }
        const float r = __builtin_amdgcn_rsqf(wave_sum(s) * (1.f / D) + EPS);
        GAS u32x2* o = (GAS u32x2*)(xn + (size_t)m * D) + lane;
#pragma unroll
        for (int j = 0; j < 4; ++j) { u32x2 w; w.x = pk2(v[j].x * r * gg[j].x, v[j].y * r * gg[j].y); w.y = pk2(v[j].z * r * gg[j].z, v[j].w * r * gg[j].w); o[64 * j] = w; }
    }
}
__device__ __forceinline__ void xg_rows(const float* x, bf16* xg, float* stat, signed char* xq, float* qs, float* amx, int gw, int NGW, int lane) {
    for (int m0 = gw * 4; m0 < MH; m0 += NGW * 4) {
        f32x4 v[4][4];
#pragma unroll
        for (int r = 0; r < 4; ++r) { const GAS f32x4* xr = (const GAS f32x4*)(x + (size_t)(m0 + r) * D) + lane;
#pragma unroll
            for (int j = 0; j < 4; ++j) v[r][j] = __builtin_nontemporal_load(xr + 64 * j); }
#pragma unroll
        for (int r = 0; r < 4; ++r) { float s = 0.f, mx = 0.f;
#pragma unroll
            for (int j = 0; j < 4; ++j) { s += (v[r][j].x * v[r][j].x + v[r][j].y * v[r][j].y) + (v[r][j].z * v[r][j].z + v[r][j].w * v[r][j].w);
                mx = fmaxf(mx, fmaxf(fmaxf(fabsf(v[r][j].x), fabsf(v[r][j].y)), fmaxf(fabsf(v[r][j].z), fabsf(v[r][j].w)))); }
            s = wave_sum(s);
#pragma unroll
            for (int o = 1; o < 64; o <<= 1) mx = fmaxf(mx, __shfl_xor(mx, o));
            const float B = fmaxf(mx, 1e-20f), s2 = 127.0f * __builtin_amdgcn_rcpf(B);
            GAS u32x2* o = (GAS u32x2*)(xg + (size_t)(m0 + r) * D) + lane;
            GAS unsigned* oq = (GAS unsigned*)(xq + (size_t)(m0 + r) * D) + lane;
#pragma unroll
            for (int j = 0; j < 4; ++j) { u32x2 w; w.x = pk2(v[r][j].x, v[r][j].y); w.y = pk2(v[r][j].z, v[r][j].w); o[64 * j] = w;
                if (PG_I8_P1) { const float qa[4] = {v[r][j].x * s2 + 12582912.0f, v[r][j].y * s2 + 12582912.0f, v[r][j].z * s2 + 12582912.0f, v[r][j].w * s2 + 12582912.0f}; oq[64 * j] = p0_pack8(qa); } }
            if (lane == 0) { *(GAS f32x4*)(stat + (size_t)(m0 + r) * 4) = (f32x4){s, 0.f, 0.f, 0.f}; *(GAS f32x4*)(amx + (size_t)(m0 + r) * 4) = (f32x4){mx, mx, mx, mx}; ((GAS float*)qs)[m0 + r] = B * (1.0f / 127.0f); } }
    }
}
__device__ __forceinline__ void resid_rows(const bf16* z, const float* xsrc, float* xdst, const float* gpost, const float* gnext, bf16* xn, int gw, int NGW, int lane) {
    for (int m = gw; m < MH; m += NGW) {
        const GAS u32x2* zr = (const GAS u32x2*)(z + (size_t)m * D) + lane;
        const GAS f32x4* xr = (const GAS f32x4*)(xsrc + (size_t)m * D) + lane;
        f32x4 v[4], xv[4]; float s = 0.f;
#pragma unroll
        for (int j = 0; j < 4; ++j) { const u32x2 zb = zr[64 * j]; v[j] = (f32x4){bf2f(zb.x & 0xffffu), bf2f(zb.x >> 16), bf2f(zb.y & 0xffffu), bf2f(zb.y >> 16)}; xv[j] = xr[64 * j]; s += (v[j].x * v[j].x + v[j].y * v[j].y) + (v[j].z * v[j].z + v[j].w * v[j].w); }
        const float r = __builtin_amdgcn_rsqf(wave_sum(s) * (1.f / D) + EPS);
        float s2 = 0.f;
        GAS f32x4* xo = (GAS f32x4*)(xdst + (size_t)m * D) + lane;
#pragma unroll
        for (int j = 0; j < 4; ++j) { const f32x4 gp = *((const f32x4*)gpost + lane + 64 * j); v[j] = xv[j] + v[j] * r * gp; xo[64 * j] = v[j];
            s2 += (v[j].x * v[j].x + v[j].y * v[j].y) + (v[j].z * v[j].z + v[j].w * v[j].w); }
        if (gnext) {
            const float r2 = __builtin_amdgcn_rsqf(wave_sum(s2) * (1.f / D) + EPS);
            GAS u32x2* o = (GAS u32x2*)(xn + (size_t)m * D) + lane;
#pragma unroll
            for (int j = 0; j < 4; ++j) { const f32x4 gn = *((const f32x4*)gnext + lane + 64 * j); u32x2 w; w.x = pk2(v[j].x * r2 * gn.x, v[j].y * r2 * gn.y); w.y = pk2(v[j].z * r2 * gn.z, v[j].w * r2 * gn.w); o[64 * j] = w; }
        }
    }
}
__device__ __forceinline__ void conv_phase(const bf16* U, bf16* G, const float* cw, const float* cb, int gt, int NGT) {
    constexpr int CG = DFF / 8, NIT = (MH / 32) * CG;
    for (int it = gt; it < NIT; it += NGT) {
        const int cg = it % CG, rg = it / CG, c0 = cg * 8, t0 = rg * 32;
        float w0[8], w1[8], w2[8], bb[8];
#pragma unroll
        for (int e = 0; e < 8; ++e) { w0[e] = cw[c0 + e]; w1[e] = cw[DFF + c0 + e]; w2[e] = cw[2 * DFF + c0 + e]; bb[e] = cb[c0 + e]; }
        float a2[8], a1[8];
        if ((t0 & (SEQ - 1)) == 0) {
#pragma unroll
            for (int e = 0; e < 8; ++e) { a2[e] = 0.f; a1[e] = 0.f; }
        } else {
            const v4u p2 = *(const GAS v4u*)(U + (size_t)(t0 - 2) * NUP + c0), p1 = *(const GAS v4u*)(U + (size_t)(t0 - 1) * NUP + c0);
            a2[0] = bf2f(p2.x & 0xffffu); a2[1] = bf2f(p2.x >> 16); a2[2] = bf2f(p2.y & 0xffffu); a2[3] = bf2f(p2.y >> 16); a2[4] = bf2f(p2.z & 0xffffu); a2[5] = bf2f(p2.z >> 16); a2[6] = bf2f(p2.w & 0xffffu); a2[7] = bf2f(p2.w >> 16);
            a1[0] = bf2f(p1.x & 0xffffu); a1[1] = bf2f(p1.x >> 16); a1[2] = bf2f(p1.y & 0xffffu); a1[3] = bf2f(p1.y >> 16); a1[4] = bf2f(p1.z & 0xffffu); a1[5] = bf2f(p1.z >> 16); a1[6] = bf2f(p1.w & 0xffffu); a1[7] = bf2f(p1.w >> 16);
        }
#pragma unroll 4
        for (int t = 0; t < 32; ++t) {
            const v4u pa = *(const GAS v4u*)(U + (size_t)(t0 + t) * NUP + c0), pv = *(const GAS v4u*)(U + (size_t)(t0 + t) * NUP + DFF + c0);
            float a0[8], vv[8], o[8];
            a0[0] = bf2f(pa.x & 0xffffu); a0[1] = bf2f(pa.x >> 16); a0[2] = bf2f(pa.y & 0xffffu); a0[3] = bf2f(pa.y >> 16); a0[4] = bf2f(pa.z & 0xffffu); a0[5] = bf2f(pa.z >> 16); a0[6] = bf2f(pa.w & 0xffffu); a0[7] = bf2f(pa.w >> 16);
            vv[0] = bf2f(pv.x & 0xffffu); vv[1] = bf2f(pv.x >> 16); vv[2] = bf2f(pv.y & 0xffffu); vv[3] = bf2f(pv.y >> 16); vv[4] = bf2f(pv.z & 0xffffu); vv[5] = bf2f(pv.z >> 16); vv[6] = bf2f(pv.w & 0xffffu); vv[7] = bf2f(pv.w >> 16);
#pragma unroll
            for (int e = 0; e < 8; ++e) { const float ac = bb[e] + w0[e] * a2[e] + w1[e] * a1[e] + w2[e] * a0[e]; o[e] = gelu_tanh(ac) * vv[e]; a2[e] = a1[e]; a1[e] = a0[e]; }
            v4u w; w.x = pk2(o[0], o[1]); w.y = pk2(o[2], o[3]); w.z = pk2(o[4], o[5]); w.w = pk2(o[6], o[7]);
            *(GAS v4u*)(G + (size_t)(t0 + t) * DFF + c0) = w;
        }
    }
}
__device__ __forceinline__ void ld8(const bf16* p, float (&o)[8]) { const v4u v = *(const GAS v4u*)p; o[0] = bf2f(v.x & 0xffffu); o[1] = bf2f(v.x >> 16); o[2] = bf2f(v.y & 0xffffu); o[3] = bf2f(v.y >> 16); o[4] = bf2f(v.z & 0xffffu); o[5] = bf2f(v.z >> 16); o[6] = bf2f(v.w & 0xffffu); o[7] = bf2f(v.w >> 16); }
__device__ __forceinline__ void up8(const v4u v, float (&o)[8]) { o[0] = bf2f(v.x & 0xffffu); o[1] = bf2f(v.x >> 16); o[2] = bf2f(v.y & 0xffffu); o[3] = bf2f(v.y >> 16); o[4] = bf2f(v.z & 0xffffu); o[5] = bf2f(v.z >> 16); o[6] = bf2f(v.w & 0xffffu); o[7] = bf2f(v.w >> 16); }
__device__ __forceinline__ void conv_fixup(const bf16* H, bf16* G, const float* cw, const float* cb, int pm, int tid) {
    if (tid >= DFF / 8) return;
    asm volatile("" : "+s"(pm));
    const int c0 = 8 * tid;
    v4u ld[4][6];
#pragma unroll
    for (int g = 0; g < 4; ++g) { const int grp = 4 * pm + g; const bool seq0 = ((grp * 64) & (SEQ - 1)) == 0; const int gp = seq0 ? grp : grp - 1;
        ld[g][0] = *(const GAS v4u*)(H + (size_t)(gp * 6 + 0) * DFF + c0);  ld[g][1] = *(const GAS v4u*)(H + (size_t)(gp * 6 + 1) * DFF + c0);
        ld[g][2] = *(const GAS v4u*)(H + (size_t)(grp * 6 + 2) * DFF + c0); ld[g][3] = *(const GAS v4u*)(H + (size_t)(grp * 6 + 3) * DFF + c0);
        ld[g][4] = *(const GAS v4u*)(H + (size_t)(grp * 6 + 4) * DFF + c0); ld[g][5] = *(const GAS v4u*)(H + (size_t)(grp * 6 + 5) * DFF + c0); }
    float w0[8], w1[8], w2[8], bb[8];
#pragma unroll
    for (int h = 0; h < 2; ++h) { const f32x4 a = *(const GAS f32x4*)(cw + c0 + 4 * h), b = *(const GAS f32x4*)(cw + DFF + c0 + 4 * h), c = *(const GAS f32x4*)(cw + 2 * DFF + c0 + 4 * h), d = *(const GAS f32x4*)(cb + c0 + 4 * h);
#pragma unroll
        for (int i = 0; i < 4; ++i) { w0[4 * h + i] = a[i]; w1[4 * h + i] = b[i]; w2[4 * h + i] = c[i]; bb[4 * h + i] = d[i]; } }
#pragma unroll
    for (int g = 0; g < 4; ++g) { const int grp = 4 * pm + g; const float pz = (((grp * 64) & (SEQ - 1)) == 0) ? 0.f : 1.f;
        float p62[8], p63[8], a0[8], a1[8], v0[8], v1[8], o0[8], o1[8];
        up8(ld[g][0], p62); up8(ld[g][1], p63); up8(ld[g][2], a0); up8(ld[g][3], a1); up8(ld[g][4], v0); up8(ld[g][5], v1);
#pragma unroll
        for (int e = 0; e < 8; ++e) { const float q62 = p62[e] * pz, q63 = p63[e] * pz;
            o0[e] = pg8::gelu_tanh_f(bb[e] + w0[e] * q62 + w1[e] * q63 + w2[e] * a0[e]) * v0[e];
            o1[e] = pg8::gelu_tanh_f(bb[e] + w0[e] * q63 + w1[e] * a0[e] + w2[e] * a1[e]) * v1[e]; }
        v4u x; x.x = pk2(o0[0], o0[1]); x.y = pk2(o0[2], o0[3]); x.z = pk2(o0[4], o0[5]); x.w = pk2(o0[6], o0[7]); *(GAS v4u*)(G + (size_t)(grp * 64) * DFF + c0) = x;
        v4u y; y.x = pk2(o1[0], o1[1]); y.y = pk2(o1[2], o1[3]); y.z = pk2(o1[4], o1[5]); y.w = pk2(o1[6], o1[7]); *(GAS v4u*)(G + (size_t)(grp * 64 + 1) * DFF + c0) = y; }
}
__device__ __forceinline__ void scan_phase(bf16* KV, int gt, int NGT) {
    constexpr int NIT = 16 * (256 * 128 / 4);
    for (int it = gt; it < NIT; it += NGT) {
        const int p = it / 8192, idx = it % 8192, h = p & 3;
        const float gc = GAMMA128_OF(h);
        GAS u32x2* base = (GAS u32x2*)(KV + (size_t)p * 32 * 32768) + idx;
        u32x2 ld[32];
#pragma unroll
        for (int n = 0; n < 32; ++n) ld[n] = base[(size_t)n * 8192];
        float s0 = 0.f, s1 = 0.f, s2 = 0.f, s3 = 0.f;
#pragma unroll
        for (int n = 0; n < 32; ++n) {
            u32x2 w; w.x = pk2(s0, s1); w.y = pk2(s2, s3); base[(size_t)n * 8192] = w;
            s0 = gc * s0 + bf2f(ld[n].x & 0xffffu); s1 = gc * s1 + bf2f(ld[n].x >> 16); s2 = gc * s2 + bf2f(ld[n].y & 0xffffu); s3 = gc * s3 + bf2f(ld[n].y >> 16);
        }
    }
}

__device__ __forceinline__ void attn_unit(LAS unsigned char* lds, const bf16* proj, bf16* aoa, const float* biastab, const float* sinks_l, int unit, int tid, int wave, int lane) {
    constexpr int KST = 144, VST = 136, K_OFF = 0, V_OFF = 256 * KST, B_OFF = V_OFF + 256 * VST;
    const int kh = unit & 1, n = (unit >> 1) & 31, bb = unit >> 6;
    const int rb = bb * SEQ + 128 * n;
#pragma unroll
    for (int it = tid; it < 2048; it += 512) {
        const int j = it >> 3, ch = it & 7;
        v4u kv = (v4u){0u, 0u, 0u, 0u}, vv = (v4u){0u, 0u, 0u, 0u};
        if (n > 0 || j >= 128) { const bf16* src = proj + (size_t)(rb - 128 + j) * DIN; kv = *(const GAS v4u*)(src + C_KA + kh * 64 + ch * 8); vv = *(const GAS v4u*)(src + C_VA + kh * 64 + ch * 8); }
        *(LAS v4u*)(lds + K_OFF + j * KST + ch * 16) = kv;
        *(LAS u32x2*)(lds + V_OFF + j * VST + ch * 16) = (u32x2){vv.x, vv.y};
        *(LAS u32x2*)(lds + V_OFF + j * VST + ch * 16 + 8) = (u32x2){vv.z, vv.w};
    }
    { LAS float* bl = (LAS float*)(lds + B_OFF); bl[tid] = biastab[(kh * 4 + (tid >> 7)) * 128 + (tid & 127)]; }
    __syncthreads();
    const int g = wave >> 1, qh = wave & 1, head = kh * 4 + g;
    const float sink = sinks_l[head];
    const int c = lane & 15, q = lane >> 4;
    const LAS float* bl = (const LAS float*)(lds + B_OFF) + g * 128;
    for (int qs = 0; qs < 4; ++qs) {
        const int i0 = 64 * qh + 16 * qs, i = i0 + c;
        const bf16* qsrc = proj + (size_t)(rb + i) * DIN + C_QA + head * 64 + 8 * q;
        const bf16x8 qf0 = *(const GAS bf16x8*)(qsrc), qf1 = *(const GAS bf16x8*)(qsrc + 32);
        f32x4 s[9];
#pragma unroll
        for (int kt = 0; kt < 9; ++kt) {
            const LAS unsigned char* kp = lds + K_OFF + (i0 + 16 * kt + c) * KST + 16 * q;
            const bf16x8 k0 = *(const LAS bf16x8*)kp, k1 = *(const LAS bf16x8*)(kp + 64);
            f32x4 a = (f32x4){0.f, 0.f, 0.f, 0.f};
            a = MFMA16(k0, qf0, a); a = MFMA16(k1, qf1, a); s[kt] = a;
        }
        float mx = -3.0e38f;
#pragma unroll
        for (int kt = 0; kt < 9; ++kt)
#pragma unroll
            for (int r = 0; r < 4; ++r) {
                const int j = i0 + 16 * kt + 4 * q + r, dist = 128 + i - j;
                const bool ok = (dist >= 0) && (dist < 128) && (n > 0 || j >= 128);
                const float v = ok ? s[kt][r] * 0.125f + bl[dist & 127] : -1.0e30f;
                s[kt][r] = v; mx = fmaxf(mx, v);
            }
        mx = fmaxf(mx, __shfl_xor(mx, 16)); mx = fmaxf(mx, __shfl_xor(mx, 32)); mx = fmaxf(mx, sink);
        float sum = 0.f;
#pragma unroll
        for (int kt = 0; kt < 9; ++kt)
#pragma unroll
            for (int r = 0; r < 4; ++r) { const float p = __expf(s[kt][r] - mx); s[kt][r] = p; sum += p; }
        sum += __shfl_xor(sum, 16); sum += __shfl_xor(sum, 32);
        const float inv = __builtin_amdgcn_rcpf(sum + __expf(sink - mx));
        f32x4 o[4];
#pragma unroll
        for (int dt = 0; dt < 4; ++dt) o[dt] = (f32x4){0.f, 0.f, 0.f, 0.f};
#pragma unroll
        for (int p = 0; p < 5; ++p) {
            const f32x4 ta = s[2 * p], tb = (2 * p + 1 < 9) ? s[2 * p + 1 < 9 ? 2 * p + 1 : 8] : (f32x4){0.f, 0.f, 0.f, 0.f};
            v4u pw; pw.x = pk2(ta[0], ta[1]); pw.y = pk2(ta[2], ta[3]); pw.z = pk2(tb[0], tb[1]); pw.w = pk2(tb[2], tb[3]);
            const bf16x8 pb = __builtin_bit_cast(bf16x8, pw);
#pragma unroll
            for (int dt = 0; dt < 4; ++dt) {
                bf16x8 va;
#pragma unroll
                for (int j = 0; j < 8; ++j) { int key = i0 + 32 * p + (j < 4 ? 4 * q + j : 16 + 4 * q + (j - 4)); key = key > 255 ? 255 : key;
                    va[j] = (short)*(const LAS u16*)(lds + V_OFF + key * VST + (16 * dt + c) * 2); }
                o[dt] = MFMA16(va, pb, o[dt]);
            }
        }
        bf16* orow = aoa + (size_t)(rb + i) * 1536 + head * 64 + 4 * q;
#pragma unroll
        for (int dt = 0; dt < 4; ++dt) { u32x2 w; w.x = pk2(o[dt][0] * inv, o[dt][1] * inv); w.y = pk2(o[dt][2] * inv, o[dt][3] * inv); *(GAS u32x2*)(orow + 16 * dt) = w; }
    }
    __syncthreads();
}

__device__ __forceinline__ void stage_copy(LAS unsigned char* img, const bf16* src, int s, int i8) {
    const v4u x1 = *(const GAS v4u*)(src), x2 = *(const GAS v4u*)(src + 64);
    *(LAS v4u*)(img + s * 272 + i8 * 16) = x1; *(LAS v4u*)(img + s * 272 + 128 + i8 * 16) = x2;
}
__device__ __forceinline__ void stage_v(LAS unsigned char* img, const bf16* proj, int rb, int h, int tid) {
#pragma unroll
    for (int it = tid; it < 4096; it += 512) { const int s = it >> 5, ch = it & 31;
        const v4u v = *(const GAS v4u*)(proj + (size_t)(rb + s) * DIN + C_VR + h * 256 + 8 * ch);
        *(LAS u32x2*)(img + s * 520 + ch * 16) = (u32x2){v.x, v.y}; *(LAS u32x2*)(img + s * 520 + ch * 16 + 8) = (u32x2){v.z, v.w}; }
}
__device__ __forceinline__ void kv_unit(LAS unsigned char* lds, const bf16* proj, bf16* kvbuf, int unit, int tid, int wave, int lane) {
    constexpr int KZ_OFF = 0, V_OFF = 128 * 272;
    const int n = unit & 31, h = (unit >> 5) & 3, bb = unit >> 7;
    const int rb = bb * SEQ + 128 * n;
    const float lg = __logf(1.0f - exp2f(-5.0f - (float)h)), g127 = __expf(127.0f * lg);
#pragma unroll
    for (int it = tid; it < 1024; it += 512) { const int s = it >> 3, i8 = it & 7; stage_copy(lds + KZ_OFF, proj + (size_t)(rb + s) * DIN + C_KR + h * 128 + 8 * i8, s, i8); }
    stage_v(lds + V_OFF, proj, rb, h, tid);
    __syncthreads();
    const int c = lane & 15, q = lane >> 4;
    f32x4 acc[2][8];
#pragma unroll
    for (int ei = 0; ei < 2; ++ei)
#pragma unroll
        for (int dt = 0; dt < 8; ++dt) acc[ei][dt] = (f32x4){0.f, 0.f, 0.f, 0.f};
#pragma unroll
    for (int ks = 0; ks < 4; ++ks) {
        bf16x8 bfr[2];
#pragma unroll
        for (int ei = 0; ei < 2; ++ei)
#pragma unroll
            for (int j = 0; j < 8; ++j) bfr[ei][j] = (short)*(const LAS u16*)(lds + V_OFF + (32 * ks + 8 * q + j) * 520 + (16 * (2 * wave + ei) + c) * 2);
#pragma unroll
        for (int dt = 0; dt < 8; ++dt) {
            bf16x8 af;
#pragma unroll
            for (int j = 0; j < 8; ++j) af[j] = (short)*(const LAS u16*)(lds + KZ_OFF + (32 * ks + 8 * q + j) * 272 + (16 * dt + c) * 2);
#pragma unroll
            for (int ei = 0; ei < 2; ++ei) acc[ei][dt] = MFMA16(af, bfr[ei], acc[ei][dt]);
        }
    }
#pragma unroll
    for (int ei = 0; ei < 2; ++ei) { const int e = 16 * (2 * wave + ei) + c; bf16* dst = kvbuf + ((size_t)unit * 256 + e) * 128 + 4 * q;
#pragma unroll
        for (int dt = 0; dt < 8; ++dt) { u32x2 w; w.x = pk2(acc[ei][dt][0] * g127, acc[ei][dt][1] * g127); w.y = pk2(acc[ei][dt][2] * g127, acc[ei][dt][3] * g127); *(GAS u32x2*)(dst + 16 * dt) = w; } }
    __syncthreads();
}
__device__ __forceinline__ void ret_unit(LAS unsigned char* lds, const bf16* proj, const bf16* kvbuf, bf16* aor, const float* rnorm_l, int unit, int tid, int wave, int lane) {
    constexpr int Q_OFF = 0, K_OFF = 128 * 272, V_OFF = 2 * 128 * 272;
    const int n = unit & 31, h = (unit >> 5) & 3, bb = unit >> 7;
    const int rb = bb * SEQ + 128 * n;
    const float lg = __logf(1.0f - exp2f(-5.0f - (float)h));
#pragma unroll
    for (int it = tid; it < 2048; it += 512) { const int which = it >> 10, s = (it >> 3) & 127, i8 = it & 7;
        stage_copy(lds + (which ? K_OFF : Q_OFF), proj + (size_t)(rb + s) * DIN + (which ? C_KR : C_QR) + h * 128 + 8 * i8, s, i8); }
    stage_v(lds + V_OFF, proj, rb, h, tid);
    __syncthreads();
    const int c = lane & 15, q = lane >> 4, cl = 16 * wave + c;
    bf16x8 qf[4];
#pragma unroll
    for (int ks = 0; ks < 4; ++ks) qf[ks] = *(const LAS bf16x8*)(lds + Q_OFF + cl * 272 + (32 * ks + 8 * q) * 2);
    f32x4 sT[8];
#pragma unroll
    for (int st = 0; st < 8; ++st) {
        f32x4 a = (f32x4){0.f, 0.f, 0.f, 0.f};
        if (st <= wave) {
#pragma unroll
            for (int ks = 0; ks < 4; ++ks) { const bf16x8 kf = *(const LAS bf16x8*)(lds + K_OFF + (16 * st + c) * 272 + (32 * ks + 8 * q) * 2); a = MFMA16(kf, qf[ks], a); }
#pragma unroll
            for (int r = 0; r < 4; ++r) { const int s = 16 * st + 4 * q + r; a[r] = (cl >= s) ? a[r] : 0.f; }
        }
        sT[st] = a;
    }
    f32x4 o[16];
    const bf16* stp = kvbuf + (size_t)unit * 256 * 128 + (size_t)c * 128 + 8 * q;
#pragma unroll
    for (int et = 0; et < 16; ++et) {
        f32x4 a = (f32x4){0.f, 0.f, 0.f, 0.f};
#pragma unroll
        for (int ks = 0; ks < 4; ++ks) { const bf16x8 sf = *(const GAS bf16x8*)(stp + (size_t)et * 16 * 128 + 32 * ks); a = MFMA16(sf, qf[ks], a); }
        o[et] = a;
    }
    const float xi = __expf(lg);
#pragma unroll
    for (int et = 0; et < 16; ++et) o[et] = o[et] * xi;
#pragma unroll
    for (int p = 0; p < 4; ++p) {
        if (2 * p <= wave) {
            const f32x4 ta = sT[2 * p], tb = sT[2 * p + 1];
            v4u pw; pw.x = pk2(ta[0], ta[1]); pw.y = pk2(ta[2], ta[3]); pw.z = pk2(tb[0], tb[1]); pw.w = pk2(tb[2], tb[3]);
            const bf16x8 pb = __builtin_bit_cast(bf16x8, pw);
#pragma unroll
            for (int et = 0; et < 16; ++et) {
                bf16x8 va;
#pragma unroll
                for (int j = 0; j < 8; ++j) { const int s = 32 * p + (j < 4 ? 4 * q + j : 16 + 4 * q + (j - 4)); va[j] = (short)*(const LAS u16*)(lds + V_OFF + s * 520 + (16 * et + c) * 2); }
                o[et] = MFMA16(va, pb, o[et]);
            }
        }
    }
    float sm = 0.f;
#pragma unroll
    for (int et = 0; et < 16; ++et) sm += (o[et][0] + o[et][1]) + (o[et][2] + o[et][3]);
    sm += __shfl_xor(sm, 16); sm += __shfl_xor(sm, 32);
    const float mu = sm * (1.0f / 256.0f);
    float vs = 0.f;
#pragma unroll
    for (int et = 0; et < 16; ++et) { const f32x4 d = o[et] - mu; vs += (d[0] * d[0] + d[1] * d[1]) + (d[2] * d[2] + d[3] * d[3]); }
    vs += __shfl_xor(vs, 16); vs += __shfl_xor(vs, 32);
    const float rs = __builtin_amdgcn_rsqf(vs * (1.0f / 256.0f) + EPS);
    const size_t tok = (size_t)(rb + cl);
    const bf16* grow = proj + tok * DIN + C_GR + h * 256 + 4 * q;
    bf16* orow = aor + tok * 1536 + 512 + h * 256 + 4 * q;
    const float* gn = rnorm_l + h * 256 + 4 * q;
#pragma unroll
    for (int et = 0; et < 16; ++et) {
        const u32x2 gv = *(const GAS u32x2*)(grow + 16 * et); const f32x4 gg = *(const GAS f32x4*)(gn + 16 * et);
        const float g0 = bf2f(gv.x & 0xffffu), g1 = bf2f(gv.x >> 16), g2 = bf2f(gv.y & 0xffffu), g3 = bf2f(gv.y >> 16);
        const float y0 = (o[et][0] - mu) * rs * gg.x * g0 * sigm(g0), y1 = (o[et][1] - mu) * rs * gg.y * g1 * sigm(g1), y2 = (o[et][2] - mu) * rs * gg.z * g2 * sigm(g2), y3 = (o[et][3] - mu) * rs * gg.w * g3 * sigm(g3);
        u32x2 w; w.x = pk2(y0, y1); w.y = pk2(y2, y3); *(GAS u32x2*)(orow + 16 * et) = w;
    }
    __syncthreads();
}

__device__ __forceinline__ void ret_dma(LAS unsigned char* buf, int type, const bf16* proj, const bf16* kvbuf, int unit, int wave, int lane) {
    const int n = unit & 31, h = (unit >> 5) & 3, bb = unit >> 7, rb = bb * SEQ + 128 * n;
    asm volatile("" : "+v"(lane));
#pragma unroll
    for (int i = 0; i < 4; ++i) {
        const int ins = wave * 4 + i, P = ins * 64 + lane;
        const char* src;
        if (type < 2) { const int r = P >> 4, ch = (P & 15) ^ (r & 15); src = (const char*)(proj + (size_t)(rb + r) * DIN + (type == 0 ? C_QR : C_KR) + h * 128) + ch * 16; }
        else if (type < 4) { const int r = (P >> 4) + 128 * (type - 2), ch = (P & 15) ^ (r & 15); src = (const char*)(kvbuf + ((size_t)unit * 256 + r) * 128) + ch * 16; }
        else { const int r = (P >> 5) + 64 * (type & 1), cp = P & 31, ch = (((cp >> 1) ^ (r & 7)) << 1) | (cp & 1); src = (const char*)(proj + (size_t)(rb + r) * DIN + (type < 6 ? C_VR : C_GR) + h * 256) + ch * 16; }
        __builtin_amdgcn_global_load_lds((const unsigned*)src, (LAS unsigned*)(buf + ins * 1024), 16, 0, 0);
    }
}
typedef short v4i16_t __attribute__((ext_vector_type(4)));
__device__ __forceinline__ bf16x8 tr_pair(const LAS unsigned char* p0, const LAS unsigned char* p1) {
    const v4i16_t lo = __builtin_amdgcn_ds_read_tr16_b64_v4i16((LAS v4i16_t*)p0), hi = __builtin_amdgcn_ds_read_tr16_b64_v4i16((LAS v4i16_t*)p1);
    return (bf16x8){lo[0], lo[1], lo[2], lo[3], hi[0], hi[1], hi[2], hi[3]};
}
__device__ __forceinline__ void ret_phase(LAS unsigned char* lds, const bf16* proj, const bf16* kvbuf, bf16* ao, const float* rnorm_l, int bx, int G, int wave, int lane) {
    const int nu = (512 - bx + G - 1) / G, nsteps = 8 * nu;
    { LAS float* gl = (LAS float*)(lds + RING_BYTES); const int t = wave * 64 + lane; gl[t] = ((const GAS float*)rnorm_l)[t]; gl[t + 512] = ((const GAS float*)rnorm_l)[t + 512]; }
    if (nsteps <= 0) return;
    const int c = lane & 15, q = lane >> 4, cl = 16 * wave + c;
    f32x4 sT[8], o[16]; bf16x8 qf[4];
#pragma unroll
    for (int i = 0; i < 8; ++i) sT[i] = (f32x4){0.f, 0.f, 0.f, 0.f};
#pragma unroll
    for (int i = 0; i < 16; ++i) o[i] = (f32x4){0.f, 0.f, 0.f, 0.f};
#pragma unroll
    for (int i = 0; i < 4; ++i) qf[i] = (bf16x8){0, 0, 0, 0, 0, 0, 0, 0};
    float mu = 0.f, rs = 0.f; int last_store = -100;
#pragma unroll
    for (int k0 = 0; k0 < 3; ++k0) if (k0 < nsteps) ret_dma(lds + k0 * 32768, k0 & 7, proj, kvbuf, bx + (k0 >> 3) * G, wave, lane);
    for (int k = 0; k < nsteps; ++k) {
        const int unit = bx + (k >> 3) * G, type = k & 7;
        const LAS unsigned char* buf = lds + (k & 3) * 32768;
        if (k + 3 < nsteps) ret_dma(lds + ((k + 3) & 3) * 32768, (k + 3) & 7, proj, kvbuf, bx + ((k + 3) >> 3) * G, wave, lane);
        const int later = nsteps - 1 - k;
        if (later >= 3) { if ((unsigned)(k - last_store - 1) < 3u) asm volatile("s_waitcnt vmcnt(26)" ::: "memory");     else asm volatile("s_waitcnt vmcnt(12)" ::: "memory"); }
        else if (later == 2) asm volatile("s_waitcnt vmcnt(8)" ::: "memory");
        else if (later == 1) asm volatile("s_waitcnt vmcnt(4)" ::: "memory"); else asm volatile("s_waitcnt vmcnt(0)" ::: "memory");
        __builtin_amdgcn_s_barrier(); asm volatile("" ::: "memory");
        const int h = (unit >> 5) & 3;
        int co = c; asm volatile("" : "+v"(co));
        const int xq = (q ^ co) << 4;
        const LAS unsigned char* lb = buf + co * 256;
        if (type == 0) {
#pragma unroll
            for (int ks = 0; ks < 4; ++ks) qf[ks] = *(const LAS bf16x8*)(lb + wave * 4096 + (xq ^ (ks << 6)));
        } else if (type == 1) {
#pragma unroll
            for (int st = 0; st < 8; ++st) {
                f32x4 a = (f32x4){0.f, 0.f, 0.f, 0.f};
                if (st <= wave) {
#pragma unroll
                    for (int ks = 0; ks < 4; ++ks) { const bf16x8 kf = *(const LAS bf16x8*)(lb + st * 4096 + (xq ^ (ks << 6))); a = MFMA16(kf, qf[ks], a); }
#pragma unroll
                    for (int rr = 0; rr < 4; ++rr) { const int s = 16 * st + 4 * q + rr; a[rr] = (cl >= s) ? a[rr] : 0.f; }
                }
                sT[st] = a;
            }
        } else if (type < 4) {
            const float gam = GAMMA_OF(h);
#pragma unroll
            for (int e8 = 0; e8 < 8; ++e8) {
                f32x4 a = (f32x4){0.f, 0.f, 0.f, 0.f};
#pragma unroll
                for (int ks = 0; ks < 4; ++ks) { const bf16x8 sf = *(const LAS bf16x8*)(lb + e8 * 4096 + (xq ^ (ks << 6))); a = MFMA16(sf, qf[ks], a); }
                o[e8] = a * gam;
            }
            if (type == 2) {
#pragma unroll
                for (int e8 = 0; e8 < 8; ++e8) o[8 + e8] = o[e8];
            }
        } else if (type < 6) {
            const int x0 = (4 * q + (co >> 2)) & 7;
            const LAS unsigned char* vb = buf + (4 * q + (co >> 2)) * 512 + (co & 3) * 8;
            const int pbase = (type & 1) * 2;
#pragma unroll
            for (int pp = 0; pp < 2; ++pp) {
                if (2 * (pbase + pp) <= wave) {
                    const f32x4 ta = sT[2 * pp], tb = sT[2 * pp + 1];
                    v4u pw; pw.x = pk2(ta[0], ta[1]); pw.y = pk2(ta[2], ta[3]); pw.z = pk2(tb[0], tb[1]); pw.w = pk2(tb[2], tb[3]);
                    const bf16x8 pb = __builtin_bit_cast(bf16x8, pw);
#pragma unroll
                    for (int r = 0; r < 16; ++r) { const int et = r ^ 8, po = (((et & 7) ^ x0) << 5) + ((et & 8) << 5);
                        const bf16x8 va = tr_pair(vb + pp * 32 * 512 + po, vb + pp * 32 * 512 + 16 * 512 + po); o[r] = MFMA16(va, pb, o[r]); }
                }
            }
            if (type == 4) {
#pragma unroll
                for (int i = 0; i < 4; ++i) sT[i] = sT[4 + i];
            } else {
                float sm = 0.f;
#pragma unroll
                for (int r = 0; r < 16; ++r) sm += (o[r][0] + o[r][1]) + (o[r][2] + o[r][3]);
                sm += __shfl_xor(sm, 16); sm += __shfl_xor(sm, 32);
                mu = sm * (1.0f / 256.0f);
                float vs = 0.f;
#pragma unroll
                for (int r = 0; r < 16; ++r) { const f32x4 d = o[r] - mu; vs += (d[0] * d[0] + d[1] * d[1]) + (d[2] * d[2] + d[3] * d[3]); }
                vs += __shfl_xor(vs, 16); vs += __shfl_xor(vs, 32);
                rs = __builtin_amdgcn_rsqf(vs * (1.0f / 256.0f) + EPS);
            }
        } else if ((type == 6) == (wave < 4)) {
            const int n = unit & 31, bb = unit >> 7; const size_t tok = (size_t)(bb * SEQ + 128 * n + cl);
            bf16* orow = ao + tok * 1536 + 512 + h * 256 + 4 * q;
            const LAS unsigned char* gb = buf + (cl & 63) * 512 + 8 * q;
            const LAS float* gl = (const LAS float*)(lds + RING_BYTES) + h * 256 + 4 * q;
            const int xr = cl & 7; const float murs = mu * rs;
#pragma unroll
            for (int r = 0; r < 16; ++r) { const int et = r ^ 8;
                const u32x2 gv = *(const LAS u32x2*)(gb + ((((et & 7) ^ xr) | (et & 8)) << 5)); const f32x4 gg = *(const LAS f32x4*)(gl + 16 * et);
                typedef float f2_t __attribute__((ext_vector_type(2)));
                const f2_t ga = (f2_t){bf2f(gv.x & 0xffffu), __uint_as_float(gv.x & 0xffff0000u)}, gb_ = (f2_t){bf2f(gv.y & 0xffffu), __uint_as_float(gv.y & 0xffff0000u)};
                const f2_t xa = ga * -1.4426950408889634f, xb = gb_ * -1.4426950408889634f;
                f2_t ea, eb; ea.x = __builtin_amdgcn_exp2f(xa.x); ea.y = __builtin_amdgcn_exp2f(xa.y); eb.x = __builtin_amdgcn_exp2f(xb.x); eb.y = __builtin_amdgcn_exp2f(xb.y);
                const f2_t da = ea + 1.0f, db = eb + 1.0f; f2_t sa, sb; sa.x = __builtin_amdgcn_rcpf(da.x); sa.y = __builtin_amdgcn_rcpf(da.y); sb.x = __builtin_amdgcn_rcpf(db.x); sb.y = __builtin_amdgcn_rcpf(db.y);
                const f2_t ta = ((f2_t){o[r][0], o[r][1]} * rs - murs) * (f2_t){gg.x, gg.y} * ga * sa, tb = ((f2_t){o[r][2], o[r][3]} * rs - murs) * (f2_t){gg.z, gg.w} * gb_ * sb;
                const float y0 = ta.x, y1 = ta.y, y2 = tb.x, y3 = tb.y;
                u32x2 w; w.x = pk2(y0, y1); w.y = pk2(y2, y3); *(GAS u32x2*)(orow + 16 * et) = w;
            }
            last_store = k;
        }
        asm volatile("s_waitcnt lgkmcnt(0)" ::: "memory"); __builtin_amdgcn_s_barrier(); asm volatile("" ::: "memory");
    }
}

__device__ __forceinline__ void mix_dma(LAS unsigned char* buf, int k, const bf16* proj, int bx, int wave, int lane) {
    asm volatile("" : "+v"(lane));
    if (k == 0) {
        const int kh = bx & 1, n = (bx >> 1) & 31, bb = bx >> 6, rb = bb * SEQ + 128 * n;
#pragma unroll
        for (int i = 0; i < 8; ++i) {
            const int ins = wave * 8 + i, P = (ins * 64 + lane) & 2047, r = P >> 3, cp = P & 7, isv = ins >> 5;
            const int ch = isv ? ((((cp >> 1) ^ ((r >> 1) & 3)) << 1) | (cp & 1)) : (cp ^ (r & 7));
            const int grow = (n == 0 && r < 128) ? rb + r : rb - 128 + r;
            const char* src = (const char*)(proj + (size_t)grow * DIN + (isv ? C_VA : C_KA) + kh * 64) + ch * 16;
            __builtin_amdgcn_global_load_lds((const unsigned*)src, (LAS unsigned*)(buf + ins * 1024), 16, 0, 0);
        }
    } else {
        const int unit = bx + 256 * ((k - 1) >> 1), half = (k - 1) & 1;
        const int n = unit & 31, h = (unit >> 5) & 3, bb = unit >> 7, rb = bb * SEQ + 128 * n + 64 * half;
#pragma unroll
        for (int i = 0; i < 6; ++i) {
            const int ins = wave * 6 + i; const char* src;
            if (ins < 16) { const int P = ins * 64 + lane, r = P >> 4, cp = P & 15, ch = (((cp >> 1) ^ (r & 7)) << 1) | (cp & 1); src = (const char*)(proj + (size_t)(rb + r) * DIN + C_KR + h * 128) + ch * 16; }
            else { const int P = (ins - 16) * 64 + lane, r = P >> 5, cp = P & 31, ch = (((cp >> 1) ^ (r & 7)) << 1) | (cp & 1); src = (const char*)(proj + (size_t)(rb + r) * DIN + C_VR + h * 256) + ch * 16; }
            __builtin_amdgcn_global_load_lds((const unsigned*)src, (LAS unsigned*)(buf + ins * 1024), 16, 0, 0);
        }
    }
}
__device__ __forceinline__ void mix_phase(LAS unsigned char* lds, const bf16* proj, bf16* ao, bf16* kvbuf, const float* biastab, const float* sinks_l, int bx, int wave, int lane) {
    { LAS float* bl = (LAS float*)(lds + RING_BYTES + 4096); const int khh = bx & 1;
      for (int t = wave * 64 + lane; t < 640; t += 512) { const int h4 = t / 160, x = t % 160 - 16; bl[t] = (x >= 0 && x < 128) ? ((const GAS float*)biastab)[(khh * 4 + h4) * 128 + (127 - x)] * 1.4426950408889634f : 0.f; } }
    const int c = lane & 15, q = lane >> 4;
    mix_dma(lds, 0, proj, bx, wave, lane);
    {
        const int kh = bx & 1, an = (bx >> 1) & 31, abb = bx >> 6, arb = abb * SEQ + 128 * an;
        const int g = wave >> 1, qh = wave & 1, head = kh * 4 + g;
        bf16x8 qf[4][2];
#pragma unroll
        for (int qs = 0; qs < 4; ++qs) { const bf16* qsrc = proj + (size_t)(arb + 64 * qh + 16 * qs + c) * DIN + C_QA + head * 64 + 8 * q;
            qf[qs][0] = *(const GAS bf16x8*)(qsrc); qf[qs][1] = *(const GAS bf16x8*)(qsrc + 32); }
        const float sink = ((const GAS float*)sinks_l)[head];
        mix_dma(lds + 65536, 1, proj, bx, wave, lane); asm volatile("s_waitcnt vmcnt(6)" ::: "memory");
        __builtin_amdgcn_s_barrier(); asm volatile("" ::: "memory");
        int co = c; asm volatile("" : "+v"(co));
        const LAS unsigned char* buf = lds;
        const int db = 128 + co - 4 * q;
        const LAS float* tb = (const LAS float*)(lds + RING_BYTES + 4096) + g * 160 + (143 - db);
        const float sink2 = sink * 1.4426950408889634f;
        const int kx0 = (q ^ (co & 7)) << 4, kx1 = kx0 ^ 64;
        const LAS unsigned char* Kb = buf + co * 128;
        const LAS unsigned char* Vb = buf + 32768 + ((co & 1) << 4);
        const int vph = (co >> 1) & 1;
#pragma unroll 1
        for (int qs = 0; qs < 4; ++qs) {
            const int i0 = 64 * qh + 16 * qs, i = i0 + c;
            const bf16x8 q0 = qs == 0 ? qf[0][0] : qs == 1 ? qf[1][0] : qs == 2 ? qf[2][0] : qf[3][0], q1 = qs == 0 ? qf[0][1] : qs == 1 ? qf[1][1] : qs == 2 ? qf[2][1] : qf[3][1];
            f32x4 s[9];
#pragma unroll
            for (int kt = 0; kt < 9; ++kt) {
                const LAS unsigned char* kp = Kb + (i0 + 16 * kt) * 128;
                f32x4 a = (f32x4){0.f, 0.f, 0.f, 0.f};
                a = MFMA16(*(const LAS bf16x8*)(kp + kx0), q0, a); a = MFMA16(*(const LAS bf16x8*)(kp + kx1), q1, a); s[kt] = a;
            }
            float mx = -3.0e38f;
#pragma unroll
            for (int kt = 0; kt < 9; ++kt)
#pragma unroll
                for (int r = 0; r < 4; ++r) { const int K = 16 * kt + r;
                    float v = s[kt][r] * (0.125f * 1.4426950408889634f) + tb[K];
                    if (kt == 0) v = (K > db - 128) ? v : -1.0e30f;
                    if (kt == 8) v = (K <= db) ? v : -1.0e30f;
                    s[kt][r] = v; }
            if (an == 0) {
#pragma unroll
                for (int kt = 0; kt < 9; ++kt)
#pragma unroll
                    for (int r = 0; r < 4; ++r) s[kt][r] = (i0 + 16 * kt + 4 * q + r >= 128) ? s[kt][r] : -1.0e30f;
            }
#pragma unroll
            for (int kt = 0; kt < 9; ++kt) mx = fmaxf(fmaxf(mx, fmaxf(s[kt][0], s[kt][1])), fmaxf(s[kt][2], s[kt][3]));
            mx = fmaxf(mx, __shfl_xor(mx, 16)); mx = fmaxf(mx, __shfl_xor(mx, 32)); mx = fmaxf(mx, sink2);
            float sum = 0.f;
#pragma unroll
            for (int kt = 0; kt < 9; ++kt)
#pragma unroll
                for (int r = 0; r < 4; ++r) { const float pe = __builtin_amdgcn_exp2f(s[kt][r] - mx); s[kt][r] = pe; sum += pe; }
            sum += __shfl_xor(sum, 16); sum += __shfl_xor(sum, 32);
            const float inv = __builtin_amdgcn_rcpf(sum + __builtin_amdgcn_exp2f(sink2 - mx));
            f32x4 o[4];
#pragma unroll
            for (int dt = 0; dt < 4; ++dt) o[dt] = (f32x4){0.f, 0.f, 0.f, 0.f};
#pragma unroll
            for (int p = 0; p < 5; ++p) {
                const f32x4 ta = s[2 * p], tb = (2 * p + 1 < 9) ? s[2 * p + 1 < 9 ? 2 * p + 1 : 8] : (f32x4){0.f, 0.f, 0.f, 0.f};
                v4u pw; pw.x = pk2(ta[0], ta[1]); pw.y = pk2(ta[2], ta[3]); pw.z = pk2(tb[0], tb[1]); pw.w = pk2(tb[2], tb[3]);
                const bf16x8 pb = __builtin_bit_cast(bf16x8, pw);
                int r0 = i0 + 32 * p + 4 * q + (co >> 2), r1 = r0 + 16; r1 = r1 > 255 ? 255 : r1;
                const LAS unsigned char* v0 = Vb + r0 * 128; const LAS unsigned char* v1 = Vb + r1 * 128;
                const int x0 = (r0 >> 1) & 3, x1 = (r1 >> 1) & 3;
#pragma unroll
                for (int dt = 0; dt < 4; ++dt) { const int pr = 2 * (dt >> 1) + vph; const bf16x8 va = tr_pair(v0 + ((pr ^ x0) << 5) + 8 * (dt & 1), v1 + ((pr ^ x1) << 5) + 8 * (dt & 1)); o[dt] = MFMA16(va, pb, o[dt]); }
            }
            bf16* orow = ao + (size_t)(arb + i) * 1536 + head * 64 + 8 * q;
#pragma unroll
            for (int j = 0; j < 2; ++j) { const f32x4 a0 = o[2 * j] * inv, a1 = o[2 * j + 1] * inv; v4u w; w.x = pk2(a0[0], a0[1]); w.y = pk2(a0[2], a0[3]); w.z = pk2(a1[0], a1[1]); w.w = pk2(a1[2], a1[3]); *(GAS v4u*)(orow + 32 * j) = w; }
        }
        asm volatile("s_waitcnt lgkmcnt(0)" ::: "memory"); __builtin_amdgcn_s_barrier(); asm volatile("" ::: "memory");
    }
    f32x4 acc[2][8];
#pragma unroll
    for (int ei = 0; ei < 2; ++ei)
#pragma unroll
        for (int dt = 0; dt < 8; ++dt) acc[ei][dt] = (f32x4){0.f, 0.f, 0.f, 0.f};
    for (int k = 1; k < 5; ++k) {
        const LAS unsigned char* buf = lds + (k & 1) * 65536;
        if (k + 1 < 5) { mix_dma(lds + ((k + 1) & 1) * 65536, k + 1, proj, bx, wave, lane);
            if (k & 1) asm volatile("s_waitcnt vmcnt(12)" ::: "memory");     else asm volatile("s_waitcnt vmcnt(6)" ::: "memory"); }
        else asm volatile("s_waitcnt vmcnt(0)" ::: "memory");
        if (k > 1) { __builtin_amdgcn_s_barrier(); asm volatile("" ::: "memory"); }
        else { __builtin_amdgcn_s_barrier(); asm volatile("" ::: "memory"); }
        int co = c; asm volatile("" : "+v"(co));
        const int unit = bx + 256 * ((k - 1) >> 1), half = (k - 1) & 1, h = (unit >> 5) & 3;
        const int rl = 4 * q + (co >> 2), x0 = rl & 7;
        const LAS unsigned char* kb = buf + rl * 256 + ((co & 1) << 4);
        const LAS unsigned char* vb = buf + 16384 + rl * 512 + (co & 3) * 8;
        const int ph = (co >> 1) & 1;
#pragma unroll
        for (int ks = 0; ks < 2; ++ks) {
            bf16x8 bfr[2];
#pragma unroll
            for (int ei = 0; ei < 2; ++ei) { const int et = 2 * wave + ei, po = (((et & 7) ^ x0) << 5) + ((et & 8) << 5); bfr[ei] = tr_pair(vb + ks * 32 * 512 + po, vb + ks * 32 * 512 + 16 * 512 + po); }
#pragma unroll
            for (int dt = 0; dt < 8; ++dt) { const int po = (((2 * (dt >> 1) + ph) ^ x0) << 5) + 8 * (dt & 1); const bf16x8 af = tr_pair(kb + ks * 32 * 256 + po, kb + ks * 32 * 256 + 16 * 256 + po);
#pragma unroll
                for (int ei = 0; ei < 2; ++ei) acc[ei][dt] = MFMA16(af, bfr[ei], acc[ei][dt]); }
        }
        if (half == 1) {
            const float g127 = GAMMA127_OF(h);
#pragma unroll
            for (int ei = 0; ei < 2; ++ei) { const int e = 16 * (2 * wave + ei) + c; bf16* dst = kvbuf + ((size_t)unit * 256 + e) * 128 + 8 * q;
#pragma unroll
                for (int j = 0; j < 4; ++j) { const f32x4 a0 = acc[ei][2 * j] * g127, a1 = acc[ei][2 * j + 1] * g127;
                    v4u w; w.x = pk2(a0[0], a0[1]); w.y = pk2(a0[2], a0[3]); w.z = pk2(a1[0], a1[1]); w.w = pk2(a1[2], a1[3]); *(GAS v4u*)(dst + 32 * j) = w;
                    acc[ei][2 * j] = (f32x4){0.f, 0.f, 0.f, 0.f}; acc[ei][2 * j + 1] = (f32x4){0.f, 0.f, 0.f, 0.f}; } }
        }
        asm volatile("s_waitcnt lgkmcnt(0)" ::: "memory"); __builtin_amdgcn_s_barrier(); asm volatile("" ::: "memory");
    }
}

struct Args { const float* in[16]; float* out; unsigned char* ws; int ph_lo, ph_hi; };
__global__ void __launch_bounds__(NWAVES * 64, 2) skel_fwd(Args args) {
    extern __shared__ __attribute__((aligned(16))) unsigned char lds_raw[];
    LAS unsigned char* lds = (LAS unsigned char*)lds_raw;
    volatile LAS unsigned* MISC = (volatile LAS unsigned*)(lds + MISC_OFF);
    const int G = 256, bx = blockIdx.x; __builtin_assume(bx >= 0 && bx < 256);
    const int NGW = G * NWAVES, NGT = G * NWAVES * 64;
#define PH_IDS int tid = threadIdx.x; asm volatile("" : "+v"(tid)); const int lane = tid & 63, wave = __builtin_amdgcn_readfirstlane(tid >> 6), gw = bx * NWAVES + wave, gt = bx * (NWAVES * 64) + tid; int bxp = bx; asm volatile("" : "+s"(bxp)); (void)lane; (void)wave; (void)gw; (void)gt; (void)bxp;
    unsigned char* ws = args.ws;
    gu32* ctl = (gu32*)(ws + WS_CTL);
#if MK_ONE_LAUNCH
    constexpr int lo = 0, hi = N_PHASES;
#else
    const int lo = args.ph_lo, hi = args.ph_hi;
#endif
    if (threadIdx.x < 64) MISC[threadIdx.x] = 0u;
#ifdef PROBE_EPI
    if (threadIdx.x == 0) { ((volatile LAS unsigned long long*)(lds + MISC_OFF + 1024))[0] = 0ull; ((volatile LAS unsigned long long*)(lds + MISC_OFF + 1024))[1] = 0ull; }
#endif
    if (threadIdx.x == 0) { LAS unsigned long long* pt = (LAS unsigned long long*)(lds + MISC_OFF + 512);
#pragma unroll
        for (int i = 0; i < 16; ++i) pt[i] = (unsigned long long)args.in[i];
        pt[16] = (unsigned long long)args.out; pt[17] = (unsigned long long)args.ws; }
    __syncthreads();
    if (hi - lo > 1) (void)xcd_barrier_post((unsigned*)(ctl + CW_BAR), MISC + 8);
#define BAR_NOW() do { XcdBarrier b_; b_.bar = (unsigned*)((gu32*)((unsigned char*)ldptr(17) + WS_CTL) + CW_BAR); b_.x = xb_xcc_id(); b_.st = (volatile LAS unsigned*)(lds + MISC_OFF) + 8; xcd_barrier(b_); } while (0)
#ifndef PHMASK
#define PHMASK 0xFFFF
#endif
#define PHM(b) ((PHMASK >> (b)) & 1)
#ifndef REPMASK
#define REPMASK 0
#endif
#define REP(b) for (int rep_ = 0; rep_ <= ((REPMASK >> (b)) & 1); ++rep_)
#define IN(k) (lo <= (k) && (k) < hi)
#ifdef PROBE_PH
    unsigned long long tprev = __builtin_amdgcn_s_memrealtime(), psum = 0ull;
#define SEAM(k) do { if ((k) + 1 < hi) BAR_NOW(); { const unsigned long long now_ = __builtin_amdgcn_s_memrealtime(); const int ty_ = (k) == 0 ? 0 : ((k) - 1) % PH_PER + 1;     if (ty_ == PROBE_PH) psum += now_ - tprev; tprev = now_; } } while (0)
#else
#define SEAM(k) do { if ((k) + 1 < hi) BAR_NOW(); } while (0)
#endif

    auto ldptr = [&](int i) -> unsigned long long { unsigned ao_ = (unsigned)(MISC_OFF + 512 + 8 * i); asm volatile("" : "+v"(ao_));
        const unsigned long long v = *(const volatile LAS unsigned long long*)(lds + ao_);
        return ((unsigned long long)(unsigned)__builtin_amdgcn_readfirstlane((int)(v >> 32)) << 32) | (unsigned)__builtin_amdgcn_readfirstlane((int)(unsigned)v); };
#define INP(i) ((const float*)ldptr(i))
#define PH_BASE unsigned char* wq = (unsigned char*)ldptr(17);
#define WSP(T, off) ((T*)(wq + (off)))
#define RS_FILL(S_, statp, pmvar, qsp) int pmvar = -1; { pg8::Unit u0_; (void)(S_).next(0, u0_); { pmvar = u0_.pm; int t_ = threadIdx.x; asm volatile("" : "+v"(t_)); if (t_ < 256) { const pg8::f32x4 sv_ = *(const GAS pg8::f32x4*)((statp) + (size_t)(u0_.pm * 256 + t_) * 4); ((LAS float*)(lds + RING_BYTES + 8192))[t_] = __builtin_amdgcn_rsqf(((sv_[0] + sv_[1]) + (sv_[2] + sv_[3])) * (1.0f / 1024.0f) + EPS) * ((qsp) ? ((const GAS float*)(qsp))[u0_.pm * 256 + t_] : 1.0f); } } } __syncthreads();
#define RS_FILLQ(S_, statp, qsp) { pg8::Unit u0_; (void)(S_).next(0, u0_); { int t_ = threadIdx.x; asm volatile("" : "+v"(t_)); const int r_ = u0_.pm * 256 + (t_ & 255); const pg8::f32x4 sv_ = *(const GAS pg8::f32x4*)((statp) + (size_t)r_ * 4); ((LAS float*)(lds + RING_BYTES + 8192))[t_] = __builtin_amdgcn_rsqf(((sv_[0] + sv_[1]) + (sv_[2] + sv_[3])) * (1.0f / 1024.0f) + EPS) * (((qsp) && t_ >= 256) ? ((const GAS float*)(qsp))[r_] : 1.0f); } } __syncthreads();
#define RS_FILL2(S_, statp, pmvar, qsp) int pmvar = -1; { pg8::Unit u0_; (void)(S_).next(0, u0_); { pmvar = u0_.pm; int t_ = threadIdx.x; asm volatile("" : "+v"(t_)); const int pr_ = u0_.pm + 8 * (t_ >> 8); if (pr_ < M / 256) { const pg8::f32x4 sv_ = *(const GAS pg8::f32x4*)((statp) + (size_t)(pr_ * 256 + (t_ & 255)) * 4); ((LAS float*)(lds + RING_BYTES + 8192))[t_] = __builtin_amdgcn_rsqf(((sv_[0] + sv_[1]) + (sv_[2] + sv_[3])) * (1.0f / 1024.0f) + EPS) * ((qsp) ? ((const GAS float*)(qsp))[pr_ * 256 + (t_ & 255)] : 1.0f); } } } __syncthreads();

#define SEL_IN8 ColSel{88, 24, 96, 3, 12}
#define SEL_INB ColSel{96, 0, 24, 1 << 20, 0}
#define WAMAX_P(L_, mi) ((unsigned*)(WSP(unsigned, WS_CTL) + CW_WAMAX + (L_) * 512 + (mi) * 256))
#define CONVERT_A(L_, gwv, ngwv) { LAS float* scr = (LAS float*)(lds + wave * 16384); bf16* wl = WSP(bf16, WS_W) + (size_t)(L_) * W_LAYER; \
        if (PG_I8_P1) p0_amax(INP(2) + (size_t)(L_) * D * DIN, D, DIN, (gwv), (ngwv), lane, 2, INP(1) + (L_) * D, WAMAX_P(L_, 0), SEL_IN8); \
        if (PG_I8_UP) p0_amax(INP(11) + (size_t)(L_) * D * NUP, D, NUP, (gwv), (ngwv), lane, 1, INP(10) + (L_) * D, WAMAX_P(L_, 1), ColSel{NUP / 32, NUP / 32, 0, 1 << 20, 0}); \
        p0_matrix<false>(INP(6) + (size_t)(L_) * 512 * D, 512, D, wl + W_OA, 1536, scr, (gwv), (ngwv), lane, 3, nullptr); \
        p0_matrix<false>(INP(7) + (size_t)(L_) * D * D, D, D, wl + W_OA + 512, 1536, scr, (gwv), (ngwv), lane, 3, nullptr); \
        p0_matrix<false>(INP(14) + (size_t)(L_) * DFF * D, DFF, D, wl + W_DN, DFF, scr, (gwv), (ngwv), lane, 3, nullptr); }
#define CONVERT_B(L_, gwv, ngwv) { LAS float* scr = (LAS float*)(lds + wave * 16384); bf16* wl = WSP(bf16, WS_W) + (size_t)(L_) * W_LAYER; \
        if (PG_I8_P1) { p0_matrix_sel<true>(INP(2) + (size_t)(L_) * D * DIN, D, DIN, wl + W_IN8, D, scr, (gwv), (ngwv), lane, 2, INP(1) + (L_) * D, WAMAX_P(L_, 0), SEL_IN8); \
                        p0_matrix_sel<false>(INP(2) + (size_t)(L_) * D * DIN, D, DIN, wl + W_IN, D, scr, (gwv), (ngwv), lane, 2, INP(1) + (L_) * D, nullptr, SEL_INB); } \
        else p0_matrix<false>(INP(2) + (size_t)(L_) * D * DIN, D, DIN, wl + W_IN, D, scr, (gwv), (ngwv), lane, 2, INP(1) + (L_) * D); \
        if (PG_I8_UP) p0_matrix<true>(INP(11) + (size_t)(L_) * D * NUP, D, NUP, wl + W_UP, D, scr, (gwv), (ngwv), lane, 1, INP(10) + (L_) * D, WAMAX_P(L_, 1)); \
        else p0_matrix<false>(INP(11) + (size_t)(L_) * D * NUP, D, NUP, wl + W_UP, D, scr, (gwv), (ngwv), lane, 1, INP(10) + (L_) * D); \
        p0_matrix<false>(INP(8) + (size_t)(L_) * D * D, D, D, wl + W_O, D, scr, (gwv), (ngwv), lane, 3, nullptr); }
    if (PHM(0) && IN(0)) { PH_IDS PH_BASE
        CONVERT_A(0, gw, NGW)
        float* biastab = WSP(float, WS_BIAS); float* costab = WSP(float, WS_COS); float* sintab = WSP(float, WS_SIN);
        for (int t = gt; t < 1024; t += NGT) { const int head = t >> 7, dist = t & 127;
            int bucket = dist; if (dist >= 16) { bucket = 16 + (int)(log2f((float)dist * (1.0f / 16.0f)) * (16.0f / 3.0f)); bucket = bucket > 31 ? 31 : bucket; }
            ((GAS float*)biastab)[t] = ((const GAS float*)INP(4))[bucket * 8 + head]; }
        for (int t = gt; t < SEQ * 64; t += NGT) { const int pos = t >> 6, i = t & 63;
            const float fr = exp2f(-(float)i * (13.287712379549449f / 64.0f)); const float ang = (float)pos * fr;
            const double kk = rint((double)ang * 0.15915494309189535); const float rr = (float)((double)ang - kk * 6.283185307179586);
            ((GAS float*)costab)[t] = __cosf(rr); ((GAS float*)sintab)[t] = __sinf(rr); }
        xg_rows(INP(0), WSP(bf16, WS_XN), WSP(float, WS_STAT), WSP(signed char, WS_XQ), WSP(float, WS_QS), WSP(float, WS_AMX), gw, NGW, lane);
        xg_rows(INP(0) + (size_t)MH * D, WSP(bf16, WS_XN1), WSP(float, WS_STAT + 256 * 1024), WSP(signed char, WS_XQ) + (size_t)MH * D, WSP(float, WS_QS) + MH, WSP(float, WS_AMX) + (size_t)MH * 4, gw, NGW, lane);
        if (PG_I8_P1 || PG_I8_UP) BAR_NOW();
        CONVERT_B(0, gw, NGW)
        SEAM(0);
    }

    for (int l = 0; l < DEPTH; ++l) {
        const int pl = 1 + l * PH_PER;
#define WL (WSP(bf16, WS_W) + (size_t)l * W_LAYER)
#define XNP WSP(bf16, (hf ? WS_XN1 : WS_XN))
#define STAT_MIX WSP(float, WS_STAT + (size_t)hf * 256 * 1024)
#define STAT_FFN WSP(float, WS_STAT + (size_t)(2 + hf) * 256 * 1024)
#define AMX_MIX (WSP(float, WS_AMX) + (size_t)hf * MH * 4)
#define AMX_FFN (WSP(float, WS_AMX + 512 * 1024) + (size_t)hf * MH * 4)
        for (int hf = 0; hf < 2; ++hf) {
            const int pb = pl + hf * 6;
            const int einst = (l * 2 + hf) * 2;
#ifdef PROBE_XBAR
            if (IN(pb + 0)) { for (int xb_ = 0; xb_ < PROBE_XBAR; ++xb_) BAR_NOW(); }
#endif
            if (PHM(2) && IN(pb + 0)) { PH_BASE
                const float* qsh = PG_I8_P1 ? WSP(float, WS_QS) + (size_t)hf * MH : nullptr;
                if (PG_I8_P1) {
                    pg8::StaticOrder S; S.init(MH, 12 * 256, G, bx);
                    RS_FILLQ(S, STAT_MIX, qsh)
                    { pg8::Gemm g{XNP, WL + W_IN + (size_t)3 * 256 * D, MH, 12 * 256, D};
                      pg8::EpiBf16Rs<false, 0, 3, 0> E{WSP(bf16, WS_RA), DIN, WSP(float, WS_COS), WSP(float, WS_SIN), nullptr};
                      pg8::gemm_phase<pg8::EpiBf16Rs<false, 0, 3, 0>, pg8::StaticOrder, PG_ALIGN_P1, PG_SP2_P1>(lds, g, S, E); }
                    { pg8::StaticOrder S2; S2.init(MH, 11 * 256, G, bx);
                      pg8::Gemm g{(const bf16*)(WSP(signed char, WS_XQ) + (size_t)hf * MH * D), WL + W_IN8, MH, 11 * 256, D / 2};
                      pg8::EpiBf16Rs<true, 3, 12, 256> E{WSP(bf16, WS_RA), DIN, WSP(float, WS_COS), WSP(float, WS_SIN), WAMAX_P(l, 0)};
                      pg8::gemm_phase<pg8::EpiBf16Rs<true, 3, 12, 256>, pg8::StaticOrder, PG_ALIGN_P1, PG_SP2_P1>(lds, g, S2, E); }
                } else {
                    pg8::Gemm g{XNP, WL + W_IN, MH, DIN, D}; pg8::StaticOrder S; S.init(MH, DIN, G, bx);
                    RS_FILLQ(S, STAT_MIX, qsh)
                    pg8::EpiBf16Rs<false, 0, 0, 0> E{WSP(bf16, WS_RA), DIN, WSP(float, WS_COS), WSP(float, WS_SIN), nullptr};
                    pg8::gemm_phase<pg8::EpiBf16Rs<false, 0, 0, 0>, pg8::StaticOrder, PG_ALIGN_P1, PG_SP2_P1>(lds, g, S, E);
                }
                { int bxo = bx; asm volatile("" : "+s"(bxo));
                  if (l + 1 < DEPTH && bxo >= 192) { PH_IDS if (hf == 0) CONVERT_A(l + 1, (bxo - 192) * NWAVES + wave, 512) else CONVERT_B(l + 1, (bxo - 192) * NWAVES + wave, 512) } }
                SEAM(pb + 0);
            }
            if (PHM(3) && IN(pb + 1)) { PH_IDS PH_BASE
                mix_phase(lds, WSP(bf16, WS_RA), WSP(bf16, WS_AOA), WSP(bf16, WS_KV), WSP(float, WS_BIAS), INP(3) + l * 8, bxp, wave, lane);
                SEAM(pb + 1);
            }
            if (PHM(4) && IN(pb + 2)) { PH_IDS PH_BASE scan_phase(WSP(bf16, WS_KV), gt, NGT); SEAM(pb + 2); }
            if (PHM(5) && IN(pb + 3)) { PH_IDS PH_BASE
                ret_phase(lds, WSP(bf16, WS_RA), WSP(bf16, WS_KV), WSP(bf16, WS_AOA), INP(5) + l * 1024, bxp, G, wave, lane);
                SEAM(pb + 3);
            }
            if (PHM(6) && IN(pb + 4)) { PH_BASE
                pg8::Gemm g{WSP(bf16, WS_AOA), WL + W_OA, MH, D, 1536}; pg8::StaticOrder S; S.init(MH, D, G, bx);
                pg8::EpiGate2 E{WSP(bf16, WS_MG), D, WSP(bf16, WS_RA) + C_GA, WSP(bf16, WS_RA) + C_GT, DIN};
                pg8::gemm_phase<pg8::EpiGate2, pg8::StaticOrder, true, true>(lds, g, S, E);
                SEAM(pb + 4);
            }
            if (PHM(7) && IN(pb + 5)) { PH_BASE
                pg8::Gemm g{WSP(bf16, WS_MG), WL + W_O, MH, D, D}; pg8::StaticOrder S; S.init(MH, D, G, bx);
                pg8::PanelRms st{WSP(unsigned, WS_XSLOT), (unsigned*)(WSP(unsigned, WS_CTL) + CW_SEAM + (size_t)einst * 4096), WSP(unsigned, WS_CTL), EPS, 0x700u, AMX_MIX, WSP(float, WS_QS) + (size_t)hf * MH};
                pg8::EpiRmsRes<PG_I8_UP> E{XNP, nullptr, D, INP(9) + l * D, STAT_FFN, WSP(signed char, WS_XQ) + (size_t)hf * MH * D, AMX_FFN, st};
                pg8::gemm_phase<pg8::EpiRmsRes<PG_I8_UP>, pg8::StaticOrder, false, true>(lds, g, S, E);
                if (hf == 1) SEAM(pb + 5);
            }
        }
        if (PHM(9) && IN(pl + 12)) { PH_BASE
            pg8::Gemm g{PG_I8_UP ? (const bf16*)WSP(signed char, WS_XQ) : WSP(bf16, WS_XN), WL + W_UP, M, NUP, PG_I8_UP ? D / 2 : D}; pg8::StaticOrder S; S.init(M, NUP, G, bx);
            const float* qsf = PG_I8_UP ? WSP(float, WS_QS) : nullptr;
            RS_FILL2(S, WSP(float, WS_STAT + 2 * 256 * 1024), pmc, qsf)
#ifdef STAGGER_UP
            {
                const unsigned long long t0_ = __builtin_amdgcn_s_memrealtime(); const unsigned long long dl_ = (unsigned long long)(((bx >> 3) & 3) * STAGGER_UP);
                while (__builtin_amdgcn_s_memrealtime() - t0_ < dl_) __builtin_amdgcn_s_sleep(4);
            }
#endif
            pg8::EpiConv E{WSP(bf16, WS_G), WSP(bf16, WS_H), INP(12) + (size_t)l * 3 * DFF, INP(13) + (size_t)l * DFF, DFF, WSP(float, WS_STAT + 2 * 256 * 1024), EPS, pmc, qsf, WAMAX_P(l, 1)};
            pg8::gemm_phase<pg8::EpiConv, pg8::StaticOrder, PG_ALIGN_UP, true>(lds, g, S, E);
            SEAM(pl + 12);
        }
        for (int hf = 0; hf < 2; ++hf) {
            const int einst = (l * 2 + hf) * 2;
            if (PHM(11) && IN(pl + 13 + hf)) { PH_BASE
                bf16* Gh = WSP(bf16, WS_G) + (size_t)hf * MH * DFF; bf16* Hh = WSP(bf16, WS_H) + (size_t)hf * (MH / 64) * 6 * DFF;
                pg8::Gemm g{Gh, WL + W_DN, MH, D, DFF}; pg8::StaticOrder S; S.init(MH, D, G, bx);
                { pg8::Unit u0; int tf_ = threadIdx.x; asm volatile("" : "+v"(tf_)); (void)S.next(0, u0); conv_fixup(Hh, Gh, INP(12) + (size_t)l * 3 * DFF, INP(13) + (size_t)l * DFF, u0.pm, tf_); }
                asm volatile("s_waitcnt vmcnt(0)" ::: "memory"); __syncthreads();
                pg8::PanelRms st{WSP(unsigned, WS_XSLOT + 512 * 1024), (unsigned*)(WSP(unsigned, WS_CTL) + CW_SEAM + (size_t)(einst + 1) * 4096), WSP(unsigned, WS_CTL), EPS, 0x780u, AMX_FFN, WSP(float, WS_QS) + (size_t)hf * MH};
                pg8::EpiRmsRes<PG_I8_P1> E{XNP, (l + 1 < DEPTH) ? nullptr : (float*)ldptr(16) + (size_t)hf * MH * D, D, INP(15) + l * D, STAT_MIX, WSP(signed char, WS_XQ) + (size_t)hf * MH * D, AMX_MIX, st};
                pg8::gemm_phase<pg8::EpiRmsRes<PG_I8_P1>, pg8::StaticOrder, false, true>(lds, g, S, E);
                if (hf == 1) SEAM(pl + 13 + hf);
            }
        }
    }
#ifdef PROBE_EPI
    if (bx == 0 && threadIdx.x == 0) { const unsigned long long ps_ = ((volatile LAS unsigned long long*)(lds + MISC_OFF + 1024))[PROBE_EPI_MODE]; const unsigned long long t0_ = __builtin_amdgcn_s_memrealtime(); while (__builtin_amdgcn_s_memrealtime() - t0_ < (unsigned long long)PROBE_AMP * ps_) __builtin_amdgcn_s_sleep(8); }
#endif
#ifdef PROBE_PH
    if (bx == 0) { const unsigned long long t0_ = __builtin_amdgcn_s_memrealtime(); while (__builtin_amdgcn_s_memrealtime() - t0_ < (unsigned long long)PROBE_AMP * psum) __builtin_amdgcn_s_sleep(8); }
#endif
#undef IN
#undef SEAM
}

extern "C" void kernel_launch(void* const* d_in, const int* in_sizes, int n_in, void* d_out, int out_size, void* d_ws, size_t ws_size, hipStream_t stream) {
    static int grid = 0;
    if (grid == 0) {
        if (n_in != 16 || in_sizes[0] != M * D || out_size != M * D || ws_size < WS_END) { fprintf(stderr, "kernel_launch: unexpected shapes / workspace (n_in %d, ws %zu < %zu)\n", n_in, ws_size, (size_t)WS_END); grid = -1; return; }
        int dev = 0, cus = 0, per_cu = 0;
        if (hipGetDevice(&dev) != hipSuccess || hipDeviceGetAttribute(&cus, hipDeviceAttributeMultiprocessorCount, dev) != hipSuccess) { grid = -1; return; }
        if (hipFuncSetAttribute((const void*)skel_fwd, hipFuncAttributeMaxDynamicSharedMemorySize, LDS_BYTES) != hipSuccess) { fprintf(stderr, "kernel_launch: hipFuncSetAttribute failed\n"); grid = -1; return; }
        if (hipOccupancyMaxActiveBlocksPerMultiprocessor(&per_cu, (const void*)skel_fwd, NWAVES * 64, LDS_BYTES) != hipSuccess || per_cu < 1) fprintf(stderr, "kernel_launch: occupancy query reports %d\n", per_cu);
        (void)hipGetLastError();
        grid = cus;
        if (grid != 256) { fprintf(stderr, "kernel_launch: this kernel needs exactly 256 CUs (one 256x256 unit per workgroup in the fused-norm GEMM phases), got %d\n", grid); grid = -1; return; }
    }
    if (grid < 0) return;
    (void)hipMemsetAsync((char*)d_ws + WS_CTL, 0, CTL_ZERO_BYTES, stream);
    Args a{};
    for (int i = 0; i < 16; ++i) a.in[i] = (const float*)d_in[i];
    a.out = (float*)d_out; a.ws = (unsigned char*)d_ws;
#if MK_ONE_LAUNCH
    a.ph_lo = 0; a.ph_hi = N_PHASES;
    hipLaunchKernelGGL(skel_fwd, dim3(grid), dim3(NWAVES * 64), LDS_BYTES, stream, a);
#else
    for (int p = 0; p < N_PHASES; ++p) { a.ph_lo = p; a.ph_hi = p + 1; hipLaunchKernelGGL(skel_fwd, dim3(grid), dim3(NWAVES * 64), LDS_BYTES, stream, a); }
#endif
}
```
